# Optimizing an MI355X kernel written in HIP

```python
import math
import jax
import jax.numpy as jnp
from jax import lax
import numpy as np

D_MODEL = 1024
BATCH = 2
SEQ = 8192
DEPTH = 4

S5_WIDTH = D_MODEL // 2
S5_GROUP = 16
S5_GROUPS = S5_WIDTH // S5_GROUP
S5_STATE = 64
DT_MIN = 1e-3
DT_MAX = 1e-1
ML_WIDTH = D_MODEL
ML_HEADS = 4
ML_HEAD_DIM = ML_WIDTH // ML_HEADS
ML_CONV = 4
ML_CHUNK = 128
D_FF = 11 * D_MODEL // 4
NORM_EPS = 1e-6
IN_COLS = S5_WIDTH + 3 * ML_WIDTH + 2 * ML_HEADS + 2 * D_MODEL

kernel_name = 'hybrid_s5_mlstm_macaron'


def rmsnorm(x, g):
    xf = x.astype(jnp.float32)
    y = xf * lax.rsqrt(jnp.mean(xf * xf, axis=-1, keepdims=True) + NORM_EPS)
    return (y * g.astype(jnp.float32)).astype(x.dtype)


def swiglu(h, wg, wu, wd):
    return (jax.nn.silu(h @ wg) * (h @ wu)) @ wd


def _complex_affine_combine(e1, e2):
    a1r, a1i, b1r, b1i = e1
    a2r, a2i, b2r, b2i = e2
    return (a2r * a1r - a2i * a1i,
            a2r * a1i + a2i * a1r,
            a2r * b1r - a2i * b1i + b2r,
            a2r * b1i + a2i * b1r + b2i)


def s5_branch(u, lam_re, lam_im, log_dt, b_re, b_im, c_re, c_im, d_skip, glu_v, glu_g):
    f32 = jnp.float32
    bsz, L, _ = u.shape
    uf = u.astype(f32).reshape(bsz, L, S5_GROUPS, S5_GROUP)
    dt = jnp.exp(log_dt.astype(f32))[:, None]
    lr = jnp.minimum(lam_re.astype(f32), -1e-4)
    li = lam_im.astype(f32)
    mag = jnp.exp(lr * dt)
    ab_re = mag * jnp.cos(li * dt)
    ab_im = mag * jnp.sin(li * dt)
    den = lr * lr + li * li
    q_re = ((ab_re - 1.0) * lr + ab_im * li) / den
    q_im = (ab_im * lr - (ab_re - 1.0) * li) / den
    br = b_re.astype(f32)
    bi = b_im.astype(f32)
    bb_re = q_re[..., None] * br - q_im[..., None] * bi
    bb_im = q_re[..., None] * bi + q_im[..., None] * br
    bu_re = jnp.einsum('blgp,gnp->blgn', uf, bb_re)
    bu_im = jnp.einsum('blgp,gnp->blgn', uf, bb_im)
    a_re = jnp.broadcast_to(ab_re, bu_re.shape)
    a_im = jnp.broadcast_to(ab_im, bu_im.shape)
    _, _, s_re, s_im = lax.associative_scan(_complex_affine_combine, (a_re, a_im, bu_re, bu_im), axis=1)
    y = (jnp.einsum('blgn,gpn->blgp', s_re, c_re.astype(f32))
         - jnp.einsum('blgn,gpn->blgp', s_im, c_im.astype(f32)))
    y = y.reshape(bsz, L, S5_WIDTH) + d_skip.astype(f32) * u.astype(f32)
    z = jax.nn.gelu(y).astype(u.dtype)
    return (z @ glu_v) * jax.nn.sigmoid(z @ glu_g)


def causal_conv(x, w, b):
    K = w.shape[0]
    L = x.shape[1]
    xp = jnp.pad(x, ((0, 0), (K - 1, 0), (0, 0)))
    y = b
    for j in range(K):
        y = y + w[j] * xp[:, j:j + L]
    return y


def mlstm_chunkwise(q, k, v, i_pre, f_pre):
    bsz, H, L, d = q.shape
    nc = L // ML_CHUNK

    def to_chunks(t):
        return jnp.moveaxis(t.reshape((bsz, H, nc, ML_CHUNK) + t.shape[3:]), 2, 0)

    qc, kc, vc = to_chunks(q), to_chunks(k), to_chunks(v)
    ic = to_chunks(i_pre)
    lfc = to_chunks(jax.nn.log_sigmoid(f_pre))
    causal = jnp.tril(jnp.ones((ML_CHUNK, ML_CHUNK), dtype=bool))

    def step(carry, inp):
        C, n, m = carry
        qb, kb, vb, ib, lfb = inp
        b = jnp.cumsum(lfb, axis=-1)
        dmat = b[..., :, None] - b[..., None, :] + ib[..., None, :]
        dmat = jnp.where(causal, dmat, -jnp.inf)
        inter = b + m[..., None]
        m_t = jnp.maximum(inter, jnp.max(dmat, axis=-1))
        w_inter = jnp.exp(inter - m_t)
        s = jnp.einsum('bhtd,bhsd->bhts', qb, kb) * jnp.exp(dmat - m_t[..., None])
        num = (w_inter[..., None] * jnp.einsum('bhtd,bhde->bhte', qb, C)
               + jnp.einsum('bhts,bhse->bhte', s, vb))
        den = w_inter * jnp.einsum('bhtd,bhd->bht', qb, n) + jnp.sum(s, axis=-1)
        h = num / jnp.maximum(jnp.abs(den), jnp.exp(-m_t))[..., None]
        g = b[..., -1]
        decay = g[..., None] - b + ib
        m_new = jnp.maximum(g + m, jnp.max(decay, axis=-1))
        w_old = jnp.exp(g + m - m_new)
        kw = kb * jnp.exp(decay - m_new[..., None])[..., None]
        C_new = w_old[..., None, None] * C + jnp.einsum('bhsd,bhse->bhde', kw, vb)
        n_new = w_old[..., None] * n + jnp.sum(kw, axis=2)
        return (C_new, n_new, m_new), h

    init = (jnp.zeros((bsz, H, d, d), jnp.float32),
            jnp.zeros((bsz, H, d), jnp.float32),
            jnp.zeros((bsz, H), jnp.float32))
    _, hs = lax.scan(step, init, (qc, kc, vc, ic, lfc))
    return jnp.moveaxis(hs, 0, 2).reshape(bsz, H, L, d)


def mlstm_branch(x_ml, v, o, if_pre, conv_w, conv_b, w_q, w_k, norm_g, skip):
    f32 = jnp.float32
    bsz, L, _ = x_ml.shape
    xc = jax.nn.silu(causal_conv(x_ml, conv_w, conv_b))
    xh = xc.reshape(bsz, L, ML_HEADS, ML_HEAD_DIM)
    q = jnp.einsum('blhd,hde->bhle', xh, w_q).astype(f32) * (ML_HEAD_DIM ** -0.5)
    k = jnp.einsum('blhd,hde->bhle', xh, w_k).astype(f32)
    vh = v.reshape(bsz, L, ML_HEADS, ML_HEAD_DIM).transpose(0, 2, 1, 3).astype(f32)
    gif = if_pre.astype(f32)
    i_pre = gif[..., :ML_HEADS].transpose(0, 2, 1)
    f_pre = gif[..., ML_HEADS:].transpose(0, 2, 1)
    h_tilde = mlstm_chunkwise(q, k, vh, i_pre, f_pre).transpose(0, 2, 1, 3)
    og = jax.nn.sigmoid(o.astype(f32)).reshape(bsz, L, ML_HEADS, ML_HEAD_DIM)
    hc = og * h_tilde
    hn = hc * lax.rsqrt(jnp.mean(hc * hc, axis=-1, keepdims=True) + NORM_EPS)
    out = hn.reshape(bsz, L, ML_WIDTH) * norm_g.astype(f32) + skip.astype(f32) * xc.astype(f32)
    return out.astype(x_ml.dtype)


def hybrid_mixer(h, w_in, b_if, lam_re, lam_im, log_dt, b_re, b_im, c_re, c_im, d_skip, glu_v, glu_g,
                 conv_w, conv_b, w_q, w_k, ml_norm, ml_skip, w_br_s5, w_br_ml, w_out):
    o0 = S5_WIDTH
    o1 = o0 + ML_WIDTH
    o2 = o1 + ML_WIDTH
    o3 = o2 + ML_WIDTH
    o4 = o3 + 2 * ML_HEADS
    proj = h @ w_in
    y_s5 = s5_branch(proj[..., :o0], lam_re, lam_im, log_dt, b_re, b_im, c_re, c_im, d_skip, glu_v, glu_g)
    y_ml = mlstm_branch(proj[..., o0:o1], proj[..., o1:o2], proj[..., o2:o3], proj[..., o3:o4] + b_if,
                        conv_w, conv_b, w_q, w_k, ml_norm, ml_skip)
    gates = jax.nn.sigmoid(proj[..., o4:].astype(jnp.float32))
    mix = (gates[..., :D_MODEL] * (y_s5 @ w_br_s5).astype(jnp.float32)
           + gates[..., D_MODEL:] * (y_ml @ w_br_ml).astype(jnp.float32))
    return mix.astype(h.dtype) @ w_out


def setup_inputs(seed: int = 0) -> dict:
    key = jax.random.key(seed)
    ks = iter(jax.random.split(key, 48))
    f32 = jnp.float32

    def nrm(shape, scale):
        return scale * jax.random.normal(next(ks), shape, f32)

    def gain(shape):
        return 1.0 + nrm(shape, 0.02)

    res_scale = (2.0 * DEPTH) ** -0.5
    n_idx = jnp.arange(S5_STATE, dtype=f32)
    x = nrm((BATCH, SEQ, D_MODEL), 1.0)
    ffn1_norm = gain((DEPTH, D_MODEL))
    ffn1_wg = nrm((DEPTH, D_MODEL, D_FF), D_MODEL ** -0.5)
    ffn1_wu = nrm((DEPTH, D_MODEL, D_FF), D_MODEL ** -0.5)
    ffn1_wd = nrm((DEPTH, D_FF, D_MODEL), res_scale * D_FF ** -0.5)
    mix_norm = gain((DEPTH, D_MODEL))
    w_in = nrm((DEPTH, D_MODEL, IN_COLS), D_MODEL ** -0.5)
    b_if = jnp.concatenate([nrm((DEPTH, ML_HEADS), 0.1),
                            jnp.linspace(3.0, 6.0, ML_HEADS, dtype=f32)[None, :] + nrm((DEPTH, ML_HEADS), 0.1)],
                           axis=-1)
    s5_lam_re = -0.5 + nrm((DEPTH, S5_GROUPS, S5_STATE), 0.01)
    s5_lam_im = jnp.pi * n_idx + nrm((DEPTH, S5_GROUPS, S5_STATE), 0.01)
    s5_log_dt = jax.random.uniform(next(ks), (DEPTH, S5_GROUPS), f32,
                                   minval=math.log(DT_MIN), maxval=math.log(DT_MAX))
    s5_b_re = nrm((DEPTH, S5_GROUPS, S5_STATE, S5_GROUP), (2.0 * S5_GROUP) ** -0.5)
    s5_b_im = nrm((DEPTH, S5_GROUPS, S5_STATE, S5_GROUP), (2.0 * S5_GROUP) ** -0.5)
    s5_c_re = nrm((DEPTH, S5_GROUPS, S5_GROUP, S5_STATE), S5_STATE ** -0.5)
    s5_c_im = nrm((DEPTH, S5_GROUPS, S5_GROUP, S5_STATE), S5_STATE ** -0.5)
    s5_d = nrm((DEPTH, S5_WIDTH), 1.0)
    s5_glu_v = nrm((DEPTH, S5_WIDTH, S5_WIDTH), S5_WIDTH ** -0.5)
    s5_glu_g = nrm((DEPTH, S5_WIDTH, S5_WIDTH), S5_WIDTH ** -0.5)
    ml_conv_w = nrm((DEPTH, ML_CONV, ML_WIDTH), ML_CONV ** -0.5)
    ml_conv_b = nrm((DEPTH, ML_WIDTH), 0.02)
    ml_wq = nrm((DEPTH, ML_HEADS, ML_HEAD_DIM, ML_HEAD_DIM), ML_HEAD_DIM ** -0.5)
    ml_wk = nrm((DEPTH, ML_HEADS, ML_HEAD_DIM, ML_HEAD_DIM), ML_HEAD_DIM ** -0.5)
    ml_norm = gain((DEPTH, ML_WIDTH))
    ml_skip = gain((DEPTH, ML_WIDTH))
    w_br_s5 = nrm((DEPTH, S5_WIDTH, D_MODEL), S5_WIDTH ** -0.5)
    w_br_ml = nrm((DEPTH, ML_WIDTH, D_MODEL), ML_WIDTH ** -0.5)
    w_out = nrm((DEPTH, D_MODEL, D_MODEL), res_scale * D_MODEL ** -0.5)
    ffn2_norm = gain((DEPTH, D_MODEL))
    ffn2_wg = nrm((DEPTH, D_MODEL, D_FF), D_MODEL ** -0.5)
    ffn2_wu = nrm((DEPTH, D_MODEL, D_FF), D_MODEL ** -0.5)
    ffn2_wd = nrm((DEPTH, D_FF, D_MODEL), res_scale * D_FF ** -0.5)
    final_norm = gain((D_MODEL,))
    return {'x': x, 'ffn1_norm': ffn1_norm, 'ffn1_wg': ffn1_wg, 'ffn1_wu': ffn1_wu, 'ffn1_wd': ffn1_wd,
            'mix_norm': mix_norm, 'w_in': w_in, 'b_if': b_if,
            's5_lam_re': s5_lam_re, 's5_lam_im': s5_lam_im, 's5_log_dt': s5_log_dt,
            's5_b_re': s5_b_re, 's5_b_im': s5_b_im, 's5_c_re': s5_c_re, 's5_c_im': s5_c_im,
            's5_d': s5_d, 's5_glu_v': s5_glu_v, 's5_glu_g': s5_glu_g,
            'ml_conv_w': ml_conv_w, 'ml_conv_b': ml_conv_b, 'ml_wq': ml_wq, 'ml_wk': ml_wk,
            'ml_norm': ml_norm, 'ml_skip': ml_skip,
            'w_br_s5': w_br_s5, 'w_br_ml': w_br_ml, 'w_out': w_out,
            'ffn2_norm': ffn2_norm, 'ffn2_wg': ffn2_wg, 'ffn2_wu': ffn2_wu, 'ffn2_wd': ffn2_wd,
            'final_norm': final_norm}


def reference(x, ffn1_norm, ffn1_wg, ffn1_wu, ffn1_wd, mix_norm, w_in, b_if,
              s5_lam_re, s5_lam_im, s5_log_dt, s5_b_re, s5_b_im, s5_c_re, s5_c_im,
              s5_d, s5_glu_v, s5_glu_g, ml_conv_w, ml_conv_b, ml_wq, ml_wk, ml_norm, ml_skip,
              w_br_s5, w_br_ml, w_out, ffn2_norm, ffn2_wg, ffn2_wu, ffn2_wd, final_norm):
    for l in range(DEPTH):
        x = x + 0.5 * swiglu(rmsnorm(x, ffn1_norm[l]), ffn1_wg[l], ffn1_wu[l], ffn1_wd[l])
        x = x + hybrid_mixer(rmsnorm(x, mix_norm[l]), w_in[l], b_if[l],
                             s5_lam_re[l], s5_lam_im[l], s5_log_dt[l], s5_b_re[l], s5_b_im[l],
                             s5_c_re[l], s5_c_im[l], s5_d[l], s5_glu_v[l], s5_glu_g[l],
                             ml_conv_w[l], ml_conv_b[l], ml_wq[l], ml_wk[l], ml_norm[l], ml_skip[l],
                             w_br_s5[l], w_br_ml[l], w_out[l])
        x = x + 0.5 * swiglu(rmsnorm(x, ffn2_norm[l]), ffn2_wg[l], ffn2_wu[l], ffn2_wd[l])
    return rmsnorm(x, final_norm)
```

```cpp
#include <hip/hip_runtime.h>
#include <hip/hip_cooperative_groups.h>
#include <cstdio>
namespace cg = cooperative_groups;

#define LAS __attribute__((address_space(3)))
typedef unsigned short bf16_t;
typedef short bf16x8 __attribute__((ext_vector_type(8)));
typedef short s16x4 __attribute__((ext_vector_type(4)));
typedef float f32x4 __attribute__((ext_vector_type(4)));
typedef float f32x2 __attribute__((ext_vector_type(2)));
typedef unsigned u32x4 __attribute__((ext_vector_type(4)));
typedef unsigned u32x2 __attribute__((ext_vector_type(2)));

constexpr int MTOK = 16384, DM = 1024, FF = 2816, NPROJ = 5632, SEQ = 8192, INC = 5640;
constexpr float EPS = 1e-6f;
constexpr int LDS_BYTES = 147456;
#ifndef STOP_PHASE
#define STOP_PHASE 99
#define REP_A 1
#define REP_G 1
#define REP_B 1
#define REP_C 1
#define REP_D 1
#endif
constexpr int VEC_OFF = 131072;

constexpr size_t W_GU1 = 0;
constexpr size_t W_D1 = W_GU1 + (size_t)5632 * 1024 * 2;
constexpr size_t W_IN = W_D1 + (size_t)1024 * 2816 * 2;
constexpr size_t W_GLU = W_IN + (size_t)5632 * 1024 * 2;
constexpr size_t W_QK = W_GLU + (size_t)1024 * 512 * 2;
constexpr size_t W_BS5 = W_QK + (size_t)2048 * 256 * 2;
constexpr size_t W_BML = W_BS5 + (size_t)1024 * 1024 * 2;
constexpr size_t W_OUT = W_BML + (size_t)1024 * 1024 * 2;
constexpr size_t W_GU2 = W_OUT + (size_t)1024 * 1024 * 2;
constexpr size_t W_D2 = W_GU2 + (size_t)5632 * 1024 * 2;
constexpr size_t W_END = W_D2 + (size_t)1024 * 2816 * 2;
constexpr size_t O_BIG = W_END;
constexpr size_t O_XN = O_BIG + (size_t)MTOK * NPROJ * 2;
constexpr size_t O_XC = O_XN + (size_t)MTOK * 1024 * 2;
constexpr size_t O_Q = O_XC + (size_t)MTOK * 1024 * 2;
constexpr size_t O_K = O_Q + (size_t)MTOK * 1024 * 2;
constexpr size_t O_Z = O_K + (size_t)MTOK * 1024 * 2;
constexpr size_t O_YS5 = O_Z + (size_t)MTOK * 512 * 2;
constexpr size_t O_CST = O_YS5 + (size_t)MTOK * 1024 * 2;
constexpr size_t O_IF = O_CST + (size_t)512 * 65536 * 2;
constexpr size_t O_S5END = O_IF + (size_t)MTOK * 8 * 4;
constexpr size_t O_G = O_S5END + (size_t)64 * 64 * 64 * 8;
constexpr size_t O_MLOC = O_G + 2048;
constexpr size_t O_MST = O_MLOC + 2048;
constexpr size_t O_NLOC = O_MST + 2048;
constexpr size_t O_NST = O_NLOC + (size_t)512 * 256 * 4;
constexpr size_t O_BAR = O_NST + (size_t)512 * 256 * 4;
constexpr size_t WS_END = O_BAR + 16384;

struct KP { const float* in[32]; float* out; unsigned char* ws; };

typedef __bf16 bf16v2_t __attribute__((ext_vector_type(2)));
__device__ __forceinline__ unsigned cvt_pk_bf16(float lo, float hi) { const f32x2 v = {lo, hi}; const bf16v2_t b = __builtin_convertvector(v, bf16v2_t); return __builtin_bit_cast(unsigned, b); }
__device__ __forceinline__ float bflo(unsigned u) { return __uint_as_float(u << 16); }
__device__ __forceinline__ float bfhi(unsigned u) { return __uint_as_float(u & 0xffff0000u); }
__device__ __forceinline__ float sigmoidf_(float x) { return __builtin_amdgcn_rcpf(1.0f + __expf(-x)); }
__device__ __forceinline__ float siluf_(float x) { return x * __builtin_amdgcn_rcpf(1.0f + __expf(-x)); }
__device__ __forceinline__ float gelu_tanh(float y) { const float v = 0.7978845608028654f * (y + 0.044715f * y * y * y); const float th = 1.0f - 2.0f * __builtin_amdgcn_rcpf(1.0f + __expf(2.0f * v)); return 0.5f * y * (1.0f + th); }
__device__ __forceinline__ float logsigmoidf_(float x) { return fminf(x, 0.f) - log1pf(__expf(-fabsf(x))); }
__device__ __forceinline__ float wave_sum(float v) {
#pragma unroll
    for (int o = 1; o < 64; o <<= 1) v += __shfl_xor(v, o);
    return v;
}
__device__ __forceinline__ int opaque_tid() { int t = threadIdx.x; asm volatile("" : "+v"(t)); return t; }
#define WAVE_LDS_SYNC() asm volatile("s_waitcnt lgkmcnt(0)" ::: "memory")
__device__ __forceinline__ void sincos_acc(float x, float& s, float& c) {
    const float k = rintf(x * 0.63661977236758134f);
    float r = fmaf(-k, 1.5703125f, x); r = fmaf(-k, 4.837512969970703125e-4f, r); r = fmaf(-k, 7.54978995489188216e-8f, r);
    const float r2 = r * r;
    const float sp = r + r * r2 * (-1.6666654611e-1f + r2 * (8.3321608736e-3f + r2 * (-1.9515295891e-4f)));
    const float cp = 1.0f - 0.5f * r2 + r2 * r2 * (4.166664568298827e-2f + r2 * (-1.388731625493765e-3f + r2 * 2.443315711809948e-5f));
    const int q = ((int)k) & 3;
    s = (q == 0) ? sp : (q == 1) ? cp : (q == 2) ? -sp : -cp;
    c = (q == 0) ? cp : (q == 1) ? -sp : (q == 2) ? -cp : sp;
}

namespace pg8 {
constexpr int BM = 256, BK = 64, HALF = 128, HTB = HALF * BK * 2, STAGE_BYTES = 8 * HTB, NXCD = 8, WGM = 8;
__host__ __device__ __forceinline__ int lds_byte(int r, int c) { const int st = (r >> 4) * 2 + (c >> 5), rr = r & 15, cc = c & 31, ob = rr * 64 + cc * 2; return st * 1024 + (ob ^ (((ob >> 9) & 1) << 5)); }
__host__ __device__ __forceinline__ void stage_rc(int b, int& R, int& C) { const int st = b / 1024, sb = b % 1024, swz = sb ^ (((sb >> 9) & 1) << 5); R = (st >> 1) * 16 + swz / 64; C = (st & 1) * 32 + (swz % 64) / 2; }
__host__ __device__ __forceinline__ int perm32(int rho) { const int n = rho >> 4, i = rho & 15; return 8 * (i >> 2) + 4 * n + (i & 3); }
struct Unit { int pm, pn; };
struct Gemm { const bf16_t* A; const bf16_t* Bt; int M, N, K, lda, ldb, ahead; const bf16_t* A2; const bf16_t* Bt2; int K2; int pairmode; };
struct StaticOrder {
    int nM, nN, nwg, G, c;
    __device__ void init(int M, int N, int G_, int c_) { nM = M / BM; nN = N / BM; nwg = nM * nN; G = G_; c = c_; }
    __device__ bool next(int i, Unit& u) const {
        const long L = (long)i * G + c; if (L >= nwg) return false;
        int wgid = (int)L; { const int q = nwg / NXCD, r = nwg % NXCD, xcd = wgid % NXCD, off = wgid / NXCD; wgid = (xcd < r ? xcd * (q + 1) : r * (q + 1) + (xcd - r) * q) + off; }
        const int nig = WGM * nN, gid = wgid / nig, fm = gid * WGM, gsz = (nM - fm) < WGM ? (nM - fm) : WGM;
        u.pm = fm + ((wgid % nig) % gsz); u.pn = (wgid % nig) / gsz; return true;
    }
};

template <class Epi>
__device__ __forceinline__ void gemm_phase(LAS unsigned char* lds, const Gemm g, const Epi& E) {
    StaticOrder S; S.init(g.M, g.N, (int)gridDim.x, (int)blockIdx.x);
    const int tid = opaque_tid(), wid = __builtin_amdgcn_readfirstlane(tid >> 6), lane = tid & 63, wr = wid >> 2, wc = wid & 3, fr = lane & 15, fq = lane >> 4;
    const int K = g.K; int nt = K / BK; int seg = 0;
    unsigned voffA[2], voffB[2];
#pragma unroll
    for (int i = 0; i < 2; ++i) { int R, C; stage_rc(tid * 16 + i * 8192, R, C); const int Rb = Epi::PERM ? ((R & ~31) + perm32(R & 31)) : R;
        voffA[i] = (unsigned)(R * g.lda + C) * 2u; voffB[i] = (unsigned)(Rb * g.ldb + C) * 2u; }
    const size_t kstep = (size_t)(BK * 2);
    const size_t hstepA = (size_t)HALF * g.lda * 2, hstepB = (size_t)HALF * g.ldb * 2;
    const size_t tstepA = 2 * hstepA, tstepB = 2 * hstepB;
    const unsigned ldsw = (unsigned)wid * 1024u;
    const int aoff = lds_byte(wr * 64 + fr, fq * 8), boff = lds_byte(wc * 32 + fr, fq * 8);
#define PG8_SA(b, h) (((b) * 2 + (h)) * HTB)
#define PG8_SB(b, h) ((4 + (b) * 2 + (h)) * HTB)
#define PG8_STAGE(bufoff, gbase, voff) do { _Pragma("unroll") for (int _i = 0; _i < 2; ++_i) \
        __builtin_amdgcn_global_load_lds((const unsigned*)((const char*)(gbase) + (voff)[_i]), (LAS unsigned*)(lds + (bufoff) + ldsw + _i * 8192), 16, 0, 0); } while (0)
#define PG8_LDA(dst, b, h) do { _Pragma("unroll") for (int m = 0; m < 4; ++m) _Pragma("unroll") for (int k = 0; k < 2; ++k) dst[m][k] = *(const LAS bf16x8*)(lds + PG8_SA(b, h) + aoff + m * 2048 + k * 1024); } while (0)
#define PG8_LDB(dst, b, h) do { _Pragma("unroll") for (int n = 0; n < 2; ++n) _Pragma("unroll") for (int k = 0; k < 2; ++k) dst[n][k] = *(const LAS bf16x8*)(lds + PG8_SB(b, h) + boff + n * 2048 + k * 1024); } while (0)
#define PG8_MMA(ai, bj, At, Bt) do { __builtin_amdgcn_s_setprio(1); _Pragma("unroll") for (int m = 0; m < 4; ++m) _Pragma("unroll") for (int n = 0; n < 2; ++n) _Pragma("unroll") for (int k = 0; k < 2; ++k) \
        acc[ai][bj][m][n] = __builtin_amdgcn_mfma_f32_16x16x32_bf16(Bt[n][k], At[m][k], acc[ai][bj][m][n], 0, 0, 0); __builtin_amdgcn_s_setprio(0); } while (0)
#define PG8_WAIT_V(n) asm volatile("s_waitcnt vmcnt(" #n ")" ::: "memory")
#define PG8_WAIT_L(n) asm volatile("s_waitcnt lgkmcnt(" #n ")" ::: "memory")
#define PG8_BAR __builtin_amdgcn_s_barrier()
#define PG8_SCHED __builtin_amdgcn_sched_barrier(0)
    auto nextu = [&](int i, Unit& u) -> bool { if (g.pairmode) { if (i >= 2) return false; u.pm = (int)blockIdx.x >> 2; u.pn = ((int)blockIdx.x & 3) + 4 * i; return true; } return S.next(i, u); };
    Unit cur, nxt; int ui = 0;
    if (!nextu(0, cur)) return;
    f32x4 acc[2][2][4][2];
#pragma unroll
    for (int a = 0; a < 2; ++a)
#pragma unroll
        for (int b = 0; b < 2; ++b)
#pragma unroll
            for (int m = 0; m < 4; ++m)
#pragma unroll
                for (int n = 0; n < 2; ++n) acc[a][b][m][n] = (f32x4){0.f, 0.f, 0.f, 0.f};
    bf16x8 At[4][2], B0[2][2], B1[2][2];
    const char* cA = (const char*)g.A + (size_t)cur.pm * tstepA + (size_t)((cur.pn & 3) * g.ahead) * 2; const char* cB = (const char*)g.Bt + (size_t)cur.pn * tstepB;
    PG8_STAGE(PG8_SB(0, 0), cB, voffB); PG8_STAGE(PG8_SA(0, 0), cA, voffA); PG8_STAGE(PG8_SB(0, 1), cB + hstepB, voffB); PG8_STAGE(PG8_SA(0, 1), cA + hstepA, voffA);
    if (wr == 1) PG8_BAR;
    PG8_WAIT_V(4); PG8_BAR;
    PG8_STAGE(PG8_SB(1, 0), cB + kstep, voffB); PG8_STAGE(PG8_SA(1, 0), cA + kstep, voffA); PG8_STAGE(PG8_SB(1, 1), cB + hstepB + kstep, voffB);
    PG8_WAIT_V(6); PG8_BAR;
    for (;;) {
        bool has_next; const char* nA; const char* nB;
        if (Epi::DUAL && seg == 0) { has_next = true; nxt = cur; nA = (const char*)g.A2 + (size_t)cur.pm * tstepA; nB = (const char*)g.Bt2 + (size_t)cur.pn * tstepB; }
        else { has_next = nextu(ui + 1, nxt);
            nA = has_next ? (const char*)g.A + (size_t)nxt.pm * tstepA + (size_t)((nxt.pn & 3) * g.ahead) * 2 : cA; nB = has_next ? (const char*)g.Bt + (size_t)nxt.pn * tstepB : cB; }
        for (int t = 0; t < nt; t += 2) {
            const bool last = (t == nt - 2);
            const char* a1 = cA + (size_t)(t + 1) * kstep;
            const char* a2 = last ? nA : cA + (size_t)(t + 2) * kstep; const char* b2 = last ? nB : cB + (size_t)(t + 2) * kstep;
            const char* a3 = a2 + kstep; const char* b3 = b2 + kstep;
            PG8_LDB(B0, 0, 0); PG8_SCHED; PG8_LDA(At, 0, 0); PG8_STAGE(PG8_SA(1, 1), a1 + hstepA, voffA);
            PG8_WAIT_L(8); PG8_BAR; PG8_WAIT_L(0); PG8_MMA(0, 0, At, B0); PG8_BAR; PG8_SCHED;
            PG8_LDB(B1, 0, 1); PG8_STAGE(PG8_SB(0, 0), b2, voffB);
            PG8_BAR; PG8_WAIT_L(0); PG8_MMA(0, 1, At, B1); PG8_BAR;
            PG8_LDA(At, 0, 1); PG8_STAGE(PG8_SA(0, 0), a2, voffA);
            PG8_BAR; PG8_WAIT_L(0); PG8_MMA(1, 0, At, B0); PG8_BAR; PG8_SCHED;
            PG8_STAGE(PG8_SB(0, 1), b2 + hstepB, voffB);
            PG8_WAIT_V(6); PG8_BAR; PG8_MMA(1, 1, At, B1); PG8_BAR;
            PG8_LDB(B0, 1, 0); PG8_SCHED; PG8_LDA(At, 1, 0); PG8_STAGE(PG8_SA(0, 1), a2 + hstepA, voffA);
            PG8_WAIT_L(8); PG8_BAR; PG8_WAIT_L(0); PG8_MMA(0, 0, At, B0); PG8_BAR; PG8_SCHED;
            PG8_LDB(B1, 1, 1); PG8_STAGE(PG8_SB(1, 0), b3, voffB);
            PG8_BAR; PG8_WAIT_L(0); PG8_MMA(0, 1, At, B1); PG8_BAR;
            PG8_LDA(At, 1, 1); PG8_STAGE(PG8_SA(1, 0), a3, voffA);
            PG8_BAR; PG8_WAIT_L(0); PG8_MMA(1, 0, At, B0); PG8_BAR; PG8_SCHED;
            PG8_STAGE(PG8_SB(1, 1), b3 + hstepB, voffB);
            PG8_WAIT_V(6); PG8_BAR; PG8_MMA(1, 1, At, B1); PG8_BAR;
        }
        if constexpr (Epi::DUAL) { if (seg == 0) { E.mid(acc, cur, wr, wc, fr, fq); seg = 1; cA = nA; cB = nB; nt = g.K2 / BK; continue; } }
        E(acc, cur, wr, wc, fr, fq);
        if (Epi::DUAL) { seg = 0; nt = K / BK; }
        if (!has_next) break;
#pragma unroll
        for (int a = 0; a < 2; ++a)
#pragma unroll
            for (int b = 0; b < 2; ++b)
#pragma unroll
                for (int m = 0; m < 4; ++m)
#pragma unroll
                    for (int n = 0; n < 2; ++n) acc[a][b][m][n] = (f32x4){0.f, 0.f, 0.f, 0.f};
        cur = nxt; cA = nA; cB = nB; ++ui;
    }
    PG8_WAIT_V(0);
    if (wr == 0) PG8_BAR;
    PG8_BAR;
#undef PG8_SA
#undef PG8_SB
#undef PG8_STAGE
#undef PG8_LDA
#undef PG8_LDB
#undef PG8_MMA
#undef PG8_WAIT_V
#undef PG8_WAIT_L
#undef PG8_BAR
#undef PG8_SCHED
}

template <int ACT> struct EpiGated {
    static constexpr bool DUAL = false;
    static constexpr bool PERM = true;
    bf16_t* O; int ldo;
    __device__ __forceinline__ void operator()(const f32x4 (&acc)[2][2][4][2], const Unit& u, int wr, int wc, int fr, int fq) const {
        const int row0 = u.pm * BM + wr * 64 + fr, col0 = u.pn * 128 + wc * 32 + 8 * fq;
#pragma unroll
        for (int ai = 0; ai < 2; ++ai)
#pragma unroll
            for (int m = 0; m < 4; ++m) {
                bf16_t* rowp = O + (size_t)(row0 + ai * HALF + m * 16) * ldo + col0;
                float r[8];
#pragma unroll
                for (int n = 0; n < 2; ++n)
#pragma unroll
                    for (int j = 0; j < 4; ++j) { const float a0 = acc[ai][0][m][n][j], a1 = acc[ai][1][m][n][j]; r[n * 4 + j] = ACT == 0 ? siluf_(a0) * a1 : a0 * sigmoidf_(a1); }
                u32x4 o; o.x = cvt_pk_bf16(r[0], r[1]); o.y = cvt_pk_bf16(r[2], r[3]); o.z = cvt_pk_bf16(r[4], r[5]); o.w = cvt_pk_bf16(r[6], r[7]);
                *(u32x4*)rowp = o;
            }
    }
};
struct EpiResid {
    static constexpr bool DUAL = false;
    static constexpr bool PERM = false;
    const float* xin; float* xout; float scale;
    __device__ __forceinline__ void operator()(const f32x4 (&acc)[2][2][4][2], const Unit& u, int wr, int wc, int fr, int fq) const {
        const int row0 = u.pm * BM + wr * 64 + fr, col0 = u.pn * BM + wc * 32 + 4 * fq;
#pragma unroll
        for (int ai = 0; ai < 2; ++ai) {
            f32x4 xv[4][2][2];
#pragma unroll
            for (int m = 0; m < 4; ++m) { const size_t ro = (size_t)(row0 + ai * HALF + m * 16) * DM + col0;
#pragma unroll
                for (int bj = 0; bj < 2; ++bj)
#pragma unroll
                    for (int n = 0; n < 2; ++n) xv[m][bj][n] = *(const f32x4*)(xin + ro + bj * HALF + n * 16); }
            asm volatile("" ::: "memory");
#pragma unroll
            for (int m = 0; m < 4; ++m) { const size_t ro = (size_t)(row0 + ai * HALF + m * 16) * DM + col0;
#pragma unroll
                for (int bj = 0; bj < 2; ++bj)
#pragma unroll
                    for (int n = 0; n < 2; ++n) *(f32x4*)(xout + ro + bj * HALF + n * 16) = xv[m][bj][n] + scale * acc[ai][bj][m][n]; }
            asm volatile("" ::: "memory");
        }
    }
};
struct EpiBf16 {
    static constexpr bool DUAL = false;
    static constexpr bool PERM = true;
    bf16_t* O; bf16_t* O2; int ldo, split; float scale1;
    __device__ __forceinline__ void operator()(const f32x4 (&acc)[2][2][4][2], const Unit& u, int wr, int wc, int fr, int fq) const {
        const int row0 = u.pm * BM + wr * 64 + fr; int pn = u.pn; bf16_t* base = O; float sc = scale1;
        if (pn >= split) { pn -= split; base = O2; sc = 1.0f; }
        const int col0 = pn * BM + wc * 32 + 8 * fq;
#pragma unroll
        for (int ai = 0; ai < 2; ++ai)
#pragma unroll
            for (int m = 0; m < 4; ++m) { bf16_t* rowp = base + (size_t)(row0 + ai * HALF + m * 16) * ldo + col0;
#pragma unroll
                for (int bj = 0; bj < 2; ++bj) { const f32x4 v0 = acc[ai][bj][m][0] * sc, v1 = acc[ai][bj][m][1] * sc;
                    u32x4 o; o.x = cvt_pk_bf16(v0[0], v0[1]); o.y = cvt_pk_bf16(v0[2], v0[3]); o.z = cvt_pk_bf16(v1[0], v1[1]); o.w = cvt_pk_bf16(v1[2], v1[3]);
                    *(u32x4*)(rowp + bj * HALF) = o; } }
    }
};
template <int SECOND> struct EpiMerge {
    static constexpr bool DUAL = false;
    static constexpr bool PERM = true;
    const bf16_t* gate; float* mixacc; bf16_t* mix;
    __device__ __forceinline__ void operator()(const f32x4 (&acc)[2][2][4][2], const Unit& u, int wr, int wc, int fr, int fq) const {
        const int row0 = u.pm * BM + wr * 64 + fr, col0 = u.pn * BM + wc * 32 + 8 * fq;
#pragma unroll
        for (int ai = 0; ai < 2; ++ai)
#pragma unroll
            for (int mp = 0; mp < 2; ++mp) {
                u32x4 gv[2][2]; f32x4 pv[2][2][2];
#pragma unroll
                for (int mi = 0; mi < 2; ++mi)
#pragma unroll
                    for (int bj = 0; bj < 2; ++bj) { const size_t row = (size_t)(row0 + ai * HALF + (mp * 2 + mi) * 16); const int col = col0 + bj * HALF;
                        gv[mi][bj] = *(const u32x4*)(gate + row * NPROJ + col);
                        if (SECOND == 1) { pv[mi][bj][0] = *(const f32x4*)(mixacc + row * DM + col); pv[mi][bj][1] = *(const f32x4*)(mixacc + row * DM + col + 4); } }
                asm volatile("" ::: "memory");
#pragma unroll
                for (int mi = 0; mi < 2; ++mi)
#pragma unroll
                    for (int bj = 0; bj < 2; ++bj) { const int m = mp * 2 + mi; const size_t row = (size_t)(row0 + ai * HALF + m * 16); const int col = col0 + bj * HALF; const u32x4 g4 = gv[mi][bj];
                        float r[8];
                        r[0] = sigmoidf_(bflo(g4.x)) * acc[ai][bj][m][0][0]; r[1] = sigmoidf_(bfhi(g4.x)) * acc[ai][bj][m][0][1];
                        r[2] = sigmoidf_(bflo(g4.y)) * acc[ai][bj][m][0][2]; r[3] = sigmoidf_(bfhi(g4.y)) * acc[ai][bj][m][0][3];
                        r[4] = sigmoidf_(bflo(g4.z)) * acc[ai][bj][m][1][0]; r[5] = sigmoidf_(bfhi(g4.z)) * acc[ai][bj][m][1][1];
                        r[6] = sigmoidf_(bflo(g4.w)) * acc[ai][bj][m][1][2]; r[7] = sigmoidf_(bfhi(g4.w)) * acc[ai][bj][m][1][3];
                        if (SECOND == 0) { float* mp_ = mixacc + row * DM + col; *(f32x4*)mp_ = (f32x4){r[0], r[1], r[2], r[3]}; *(f32x4*)(mp_ + 4) = (f32x4){r[4], r[5], r[6], r[7]}; }
                        else { const f32x4 p0 = pv[mi][bj][0], p1 = pv[mi][bj][1];
                            u32x4 o; o.x = cvt_pk_bf16(r[0] + p0[0], r[1] + p0[1]); o.y = cvt_pk_bf16(r[2] + p0[2], r[3] + p0[3]); o.z = cvt_pk_bf16(r[4] + p1[0], r[5] + p1[1]); o.w = cvt_pk_bf16(r[6] + p1[2], r[7] + p1[3]);
                            *(u32x4*)(mix + row * DM + col) = o; } }
                asm volatile("" ::: "memory");
            }
    }
};
struct EpiMergeDual {
    static constexpr bool PERM = true, DUAL = true;
    const bf16_t* gate1; const bf16_t* gate2; bf16_t* mix;
    static __device__ __forceinline__ float em(float g) { return fminf(__expf(-g), 1e30f); }
    __device__ __forceinline__ void mid(f32x4 (&acc)[2][2][4][2], const Unit& u, int wr, int wc, int fr, int fq) const {
        const int row0 = u.pm * BM + wr * 64 + fr, col0 = u.pn * BM + wc * 32 + 8 * fq;
#pragma unroll
        for (int ai = 0; ai < 2; ++ai)
#pragma unroll
            for (int mp = 0; mp < 2; ++mp) {
                u32x4 g1v[2][2], g2v[2][2];
#pragma unroll
                for (int mi = 0; mi < 2; ++mi)
#pragma unroll
                    for (int bj = 0; bj < 2; ++bj) { const size_t row = (size_t)(row0 + ai * HALF + (mp * 2 + mi) * 16); const int col = col0 + bj * HALF;
                        g1v[mi][bj] = *(const u32x4*)(gate1 + row * NPROJ + col); g2v[mi][bj] = *(const u32x4*)(gate2 + row * NPROJ + col); }
#pragma unroll
                for (int mi = 0; mi < 2; ++mi)
#pragma unroll
                    for (int bj = 0; bj < 2; ++bj) { const int m = mp * 2 + mi; const u32x4 a = g1v[mi][bj], b = g2v[mi][bj];
                        const float ga[8] = {bflo(a.x), bfhi(a.x), bflo(a.y), bfhi(a.y), bflo(a.z), bfhi(a.z), bflo(a.w), bfhi(a.w)};
                        const float gb[8] = {bflo(b.x), bfhi(b.x), bflo(b.y), bfhi(b.y), bflo(b.z), bfhi(b.z), bflo(b.w), bfhi(b.w)};
#pragma unroll
                        for (int j = 0; j < 8; ++j) acc[ai][bj][m][j >> 2][j & 3] *= (1.0f + em(gb[j])) * __builtin_amdgcn_rcpf(1.0f + em(ga[j])); }
            }
    }
    __device__ __forceinline__ void operator()(const f32x4 (&acc)[2][2][4][2], const Unit& u, int wr, int wc, int fr, int fq) const {
        const int row0 = u.pm * BM + wr * 64 + fr, col0 = u.pn * BM + wc * 32 + 8 * fq;
#pragma unroll
        for (int ai = 0; ai < 2; ++ai)
#pragma unroll
            for (int mp = 0; mp < 2; ++mp) {
                u32x4 g2v[2][2];
#pragma unroll
                for (int mi = 0; mi < 2; ++mi)
#pragma unroll
                    for (int bj = 0; bj < 2; ++bj) { const size_t row = (size_t)(row0 + ai * HALF + (mp * 2 + mi) * 16); const int col = col0 + bj * HALF;
                        g2v[mi][bj] = *(const u32x4*)(gate2 + row * NPROJ + col); }
#pragma unroll
                for (int mi = 0; mi < 2; ++mi)
#pragma unroll
                    for (int bj = 0; bj < 2; ++bj) { const int m = mp * 2 + mi; const size_t row = (size_t)(row0 + ai * HALF + m * 16); const int col = col0 + bj * HALF; const u32x4 b = g2v[mi][bj];
                        const float gb[8] = {bflo(b.x), bfhi(b.x), bflo(b.y), bfhi(b.y), bflo(b.z), bfhi(b.z), bflo(b.w), bfhi(b.w)};
                        float r[8];
#pragma unroll
                        for (int j = 0; j < 8; ++j) r[j] = acc[ai][bj][m][j >> 2][j & 3] * __builtin_amdgcn_rcpf(1.0f + em(gb[j]));
                        u32x4 o; o.x = cvt_pk_bf16(r[0], r[1]); o.y = cvt_pk_bf16(r[2], r[3]); o.z = cvt_pk_bf16(r[4], r[5]); o.w = cvt_pk_bf16(r[6], r[7]);
                        *(u32x4*)(mix + row * DM + col) = o; }
            }
    }
};
}

__device__ __forceinline__ void tr_job(const float* W, int K, int ld, int c0, int NC, bf16_t* WT, int rowbase, int rs, LAS float* scr, int gw, int nw, int lane, int ldw = 0) {
    if (ldw == 0) ldw = K;
    const int nblk = NC / 32, nitems = (K / 64) * nblk;
    for (int item = gw; item < nitems; item += nw) {
        const int kb = item / nblk, nb = item % nblk, k0 = 64 * kb, n0 = 32 * nb;
        float wv[32];
#pragma unroll
        for (int i = 0; i < 32; ++i) { const int kk = 2 * i + (lane >> 5); wv[i] = W[(size_t)(k0 + kk) * ld + c0 + n0 + (lane & 31)]; }
#pragma unroll
        for (int i = 0; i < 32; ++i) { const int kk = 2 * i + (lane >> 5); scr[kk * 33 + (lane & 31)] = wv[i]; }
        WAVE_LDS_SYNC();
        const int c = lane & 7;
#pragma unroll
        for (int j = 0; j < 4; ++j) { const int n = (lane >> 3) + 8 * j; const LAS float* s = scr + (8 * c) * 33 + n;
            u32x4 o; o.x = cvt_pk_bf16(s[0 * 33], s[1 * 33]); o.y = cvt_pk_bf16(s[2 * 33], s[3 * 33]); o.z = cvt_pk_bf16(s[4 * 33], s[5 * 33]); o.w = cvt_pk_bf16(s[6 * 33], s[7 * 33]);
            const int nn = n0 + n, drow = rowbase + (nn >> 7) * rs + (nn & 127);
            *(u32x4*)(WT + (size_t)drow * ldw + k0 + 8 * c) = o; }
        WAVE_LDS_SYNC();
    }
}
__device__ __forceinline__ void convert_phase(const KP& p, int l, LAS unsigned char* lds) {
    const int tid = opaque_tid(); const int wid = tid >> 6, lane = tid & 63, nw = gridDim.x * 8;
    int gw = blockIdx.x * 8 + wid;
    LAS float* scr = (LAS float*)(lds + wid * 8448);
    unsigned char* ws = p.ws;
    const size_t ffw = (size_t)l * 1024 * 2816;
#define ROT(n) gw = (gw + (n)) % nw
    tr_job(p.in[2] + ffw, 1024, 2816, 0, 2816, (bf16_t*)(ws + W_GU1), 0, 256, scr, gw, nw, lane);
    tr_job(p.in[3] + ffw, 1024, 2816, 0, 2816, (bf16_t*)(ws + W_GU1), 128, 256, scr, gw, nw, lane);
    tr_job(p.in[4] + ffw, 2816, 1024, 0, 1024, (bf16_t*)(ws + W_D1), 0, 128, scr, gw, nw, lane);
    tr_job(p.in[6] + (size_t)l * 1024 * INC, 1024, INC, 0, 3584, (bf16_t*)(ws + W_IN), 0, 128, scr, gw, nw, lane);
    tr_job(p.in[6] + (size_t)l * 1024 * INC, 1024, INC, 3592, 2048, (bf16_t*)(ws + W_IN), 3584, 128, scr, gw, nw, lane);
    tr_job(p.in[28] + ffw, 1024, 2816, 0, 2816, (bf16_t*)(ws + W_GU2), 0, 256, scr, gw, nw, lane);
    tr_job(p.in[29] + ffw, 1024, 2816, 0, 2816, (bf16_t*)(ws + W_GU2), 128, 256, scr, gw, nw, lane);
    tr_job(p.in[30] + ffw, 2816, 1024, 0, 1024, (bf16_t*)(ws + W_D2), 0, 128, scr, gw, nw, lane);
    ROT(768);
    tr_job(p.in[16] + (size_t)l * 512 * 512, 512, 512, 0, 512, (bf16_t*)(ws + W_GLU), 0, 256, scr, gw, nw, lane);
    ROT(128);
    tr_job(p.in[17] + (size_t)l * 512 * 512, 512, 512, 0, 512, (bf16_t*)(ws + W_GLU), 128, 256, scr, gw, nw, lane);
    ROT(128);
    tr_job(p.in[24] + (size_t)l * 512 * 1024, 512, 1024, 0, 1024, (bf16_t*)(ws + W_BS5), 0, 128, scr, gw, nw, lane, 1024);
    ROT(256);
    tr_job(p.in[25] + (size_t)l * 1024 * 1024, 1024, 1024, 0, 1024, (bf16_t*)(ws + W_BML), 0, 128, scr, gw, nw, lane);
    ROT(512);
    tr_job(p.in[26] + (size_t)l * 1024 * 1024, 1024, 1024, 0, 1024, (bf16_t*)(ws + W_OUT), 0, 128, scr, gw, nw, lane);
    ROT(512);
    for (int h = 0; h < 4; ++h) {
        tr_job(p.in[20] + ((size_t)l * 4 + h) * 65536, 256, 256, 0, 256, (bf16_t*)(ws + W_QK), h * 256, 128, scr, gw, nw, lane);
        ROT(32);
        tr_job(p.in[21] + ((size_t)l * 4 + h) * 65536, 256, 256, 0, 256, (bf16_t*)(ws + W_QK), 1024 + h * 256, 128, scr, gw, nw, lane);
        ROT(32);
    }
#undef ROT
}

template <bool WITH_IF>
__device__ __forceinline__ void rmsnorm_phase(const float* x, const float* gain, bf16_t* xn, const float* win_l, const float* bif, float* ifbuf, LAS unsigned char* lds) {
    const int tid = opaque_tid(); const int wid = tid >> 6, lane = tid & 63;
    LAS float* ifw = (LAS float*)lds;
    if (WITH_IF) {
        for (int k = tid; k < 1024; k += 512) { const f32x4 a = *(const f32x4*)(win_l + (size_t)k * INC + 3584), b = *(const f32x4*)(win_l + (size_t)k * INC + 3588);
            *(LAS f32x4*)(ifw + k * 8) = a; *(LAS f32x4*)(ifw + k * 8 + 4) = b; }
        __syncthreads();
    }
    f32x4 gv[4];
#pragma unroll
    for (int i = 0; i < 4; ++i) gv[i] = *(const f32x4*)(gain + 4 * (lane + 64 * i));
    const int nw = gridDim.x * 8;
    for (int row0 = blockIdx.x * 8 + wid; row0 < MTOK; row0 += 4 * nw) {
        f32x4 v[4][4];
#pragma unroll
        for (int q = 0; q < 4; ++q) { const int row = (row0 + q * nw < MTOK) ? row0 + q * nw : row0;
#pragma unroll
            for (int i = 0; i < 4; ++i) v[q][i] = *(const f32x4*)(x + (size_t)row * DM + 4 * (lane + 64 * i)); }
        asm volatile("" ::: "memory");
#pragma unroll
        for (int q = 0; q < 4; ++q) { const int row = row0 + q * nw;
            float ss = 0.f;
#pragma unroll
            for (int i = 0; i < 4; ++i) ss += (v[q][i].x * v[q][i].x + v[q][i].y * v[q][i].y) + (v[q][i].z * v[q][i].z + v[q][i].w * v[q][i].w);
            ss = wave_sum(ss);
            const float r = rsqrtf(ss * (1.0f / DM) + EPS);
            float ga[8];
            if (WITH_IF) {
#pragma unroll
                for (int j = 0; j < 8; ++j) ga[j] = 0.f;
            }
            if (row < MTOK) {
#pragma unroll
                for (int i = 0; i < 4; ++i) { const f32x4 y = v[q][i] * r * gv[i];
                    u32x2 o; o.x = cvt_pk_bf16(y.x, y.y); o.y = cvt_pk_bf16(y.z, y.w);
                    *(u32x2*)(xn + (size_t)row * DM + 4 * (lane + 64 * i)) = o;
                    if (WITH_IF) {
#pragma unroll
                        for (int e = 0; e < 4; ++e) { const int k = 4 * (lane + 64 * i) + e; const f32x4 a = *(LAS f32x4*)(ifw + k * 8), b = *(LAS f32x4*)(ifw + k * 8 + 4); const float xv = y[e];
                            ga[0] += xv * a.x; ga[1] += xv * a.y; ga[2] += xv * a.z; ga[3] += xv * a.w; ga[4] += xv * b.x; ga[5] += xv * b.y; ga[6] += xv * b.z; ga[7] += xv * b.w; }
                        asm volatile("" ::: "memory");
                    }
                }
                if (WITH_IF) {
#pragma unroll
                    for (int j = 0; j < 8; ++j) ga[j] = wave_sum(ga[j]);
                    if (lane == 0) { *(f32x4*)(ifbuf + (size_t)row * 8) = (f32x4){ga[0] + bif[0], ga[1] + bif[1], ga[2] + bif[2], ga[3] + bif[3]};
                        *(f32x4*)(ifbuf + (size_t)row * 8 + 4) = (f32x4){ga[4] + bif[4], ga[5] + bif[5], ga[6] + bif[6], ga[7] + bif[7]}; }
                }
            }
        }
    }
}
__device__ __forceinline__ void final_norm_phase(float* x, const float* gain) {
    const int tid = opaque_tid(); const int wid = tid >> 6, lane = tid & 63;
    f32x4 gv[4];
#pragma unroll
    for (int i = 0; i < 4; ++i) gv[i] = *(const f32x4*)(gain + 4 * (lane + 64 * i));
    for (int row = blockIdx.x * 8 + wid; row < MTOK; row += gridDim.x * 8) {
        float* xr = x + (size_t)row * DM;
        f32x4 v[4]; float ss = 0.f;
#pragma unroll
        for (int i = 0; i < 4; ++i) { v[i] = *(const f32x4*)(xr + 4 * (lane + 64 * i)); ss += (v[i].x * v[i].x + v[i].y * v[i].y) + (v[i].z * v[i].z + v[i].w * v[i].w); }
        ss = wave_sum(ss);
        const float r = rsqrtf(ss * (1.0f / DM) + EPS);
#pragma unroll
        for (int i = 0; i < 4; ++i) *(f32x4*)(xr + 4 * (lane + 64 * i)) = v[i] * r * gv[i];
    }
}

__device__ __forceinline__ void conv_phase(const KP& p, int l) {
    const bf16_t* proj = (const bf16_t*)(p.ws + O_BIG); bf16_t* xc = (bf16_t*)(p.ws + O_XC);
    const int gt = blockIdx.x * 512 + opaque_tid(), c8 = gt & 127;
    const float* cw = p.in[18] + (size_t)l * 4 * 1024 + c8 * 8; const float* cb = p.in[19] + (size_t)l * 1024 + c8 * 8;
    float w[4][8], bias[8];
#pragma unroll
    for (int j = 0; j < 4; ++j) { const f32x4 a = *(const f32x4*)(cw + j * 1024), b = *(const f32x4*)(cw + j * 1024 + 4); w[j][0] = a.x; w[j][1] = a.y; w[j][2] = a.z; w[j][3] = a.w; w[j][4] = b.x; w[j][5] = b.y; w[j][6] = b.z; w[j][7] = b.w; }
    { const f32x4 a = *(const f32x4*)cb, b = *(const f32x4*)(cb + 4); bias[0] = a.x; bias[1] = a.y; bias[2] = a.z; bias[3] = a.w; bias[4] = b.x; bias[5] = b.y; bias[6] = b.z; bias[7] = b.w; }
    const int nthr = gridDim.x * 512;
    for (int idx0 = gt; idx0 < MTOK * 128; idx0 += 4 * nthr) {
        u32x4 v[4][4];
#pragma unroll
        for (int q = 0; q < 4; ++q) { const int idx = idx0 + q * nthr; const int t = idx >> 7, pos = t & (SEQ - 1);
#pragma unroll
            for (int j = 0; j < 4; ++j) { v[q][j] = (u32x4){0u, 0u, 0u, 0u}; if (idx < MTOK * 128 && pos - 3 + j >= 0) v[q][j] = *(const u32x4*)(proj + (size_t)(t - 3 + j) * NPROJ + 512 + c8 * 8); } }
        asm volatile("" ::: "memory");
#pragma unroll
        for (int q = 0; q < 4; ++q) { const int idx = idx0 + q * nthr; const int t = idx >> 7;
            float y[8];
#pragma unroll
            for (int e = 0; e < 8; ++e) y[e] = bias[e];
#pragma unroll
            for (int j = 0; j < 4; ++j) { const u32x4 vv = v[q][j];
                y[0] += w[j][0] * bflo(vv.x); y[1] += w[j][1] * bfhi(vv.x); y[2] += w[j][2] * bflo(vv.y); y[3] += w[j][3] * bfhi(vv.y);
                y[4] += w[j][4] * bflo(vv.z); y[5] += w[j][5] * bfhi(vv.z); y[6] += w[j][6] * bflo(vv.w); y[7] += w[j][7] * bfhi(vv.w); }
            u32x4 o; o.x = cvt_pk_bf16(siluf_(y[0]), siluf_(y[1])); o.y = cvt_pk_bf16(siluf_(y[2]), siluf_(y[3])); o.z = cvt_pk_bf16(siluf_(y[4]), siluf_(y[5])); o.w = cvt_pk_bf16(siluf_(y[6]), siluf_(y[7]));
            if (idx < MTOK * 128) *(u32x4*)(xc + (size_t)t * DM + c8 * 8) = o; }
    }
}

__device__ __forceinline__ void conv_slice(const KP& p, int l, int pm, int head) {
    const bf16_t* proj = (const bf16_t*)(p.ws + O_BIG); bf16_t* xc = (bf16_t*)(p.ws + O_XC);
    const int tid = opaque_tid(); const int c8 = head * 32 + (tid & 31), rsub = tid >> 5;
    const float* cw = p.in[18] + (size_t)l * 4 * 1024 + c8 * 8; const float* cb = p.in[19] + (size_t)l * 1024 + c8 * 8;
    float w[4][8], bias[8];
#pragma unroll
    for (int j = 0; j < 4; ++j) { const f32x4 a = *(const f32x4*)(cw + j * 1024), b = *(const f32x4*)(cw + j * 1024 + 4); w[j][0] = a.x; w[j][1] = a.y; w[j][2] = a.z; w[j][3] = a.w; w[j][4] = b.x; w[j][5] = b.y; w[j][6] = b.z; w[j][7] = b.w; }
    { const f32x4 a = *(const f32x4*)cb, b = *(const f32x4*)(cb + 4); bias[0] = a.x; bias[1] = a.y; bias[2] = a.z; bias[3] = a.w; bias[4] = b.x; bias[5] = b.y; bias[6] = b.z; bias[7] = b.w; }
    for (int j0 = 0; j0 < 16; j0 += 4) {
        u32x4 v[4][4];
#pragma unroll
        for (int q = 0; q < 4; ++q) { const int t = pm * 256 + rsub + 16 * (j0 + q), pos = t & (SEQ - 1);
#pragma unroll
            for (int j = 0; j < 4; ++j) { v[q][j] = (u32x4){0u, 0u, 0u, 0u}; if (pos - 3 + j >= 0) v[q][j] = *(const u32x4*)(proj + (size_t)(t - 3 + j) * NPROJ + 512 + c8 * 8); } }
        asm volatile("" ::: "memory");
#pragma unroll
        for (int q = 0; q < 4; ++q) { const int t = pm * 256 + rsub + 16 * (j0 + q);
            float y[8];
#pragma unroll
            for (int e = 0; e < 8; ++e) y[e] = bias[e];
#pragma unroll
            for (int j = 0; j < 4; ++j) { const u32x4 vv = v[q][j];
                y[0] += w[j][0] * bflo(vv.x); y[1] += w[j][1] * bfhi(vv.x); y[2] += w[j][2] * bflo(vv.y); y[3] += w[j][3] * bfhi(vv.y);
                y[4] += w[j][4] * bflo(vv.z); y[5] += w[j][5] * bfhi(vv.z); y[6] += w[j][6] * bflo(vv.w); y[7] += w[j][7] * bfhi(vv.w); }
            u32x4 o; o.x = cvt_pk_bf16(siluf_(y[0]), siluf_(y[1])); o.y = cvt_pk_bf16(siluf_(y[2]), siluf_(y[3])); o.z = cvt_pk_bf16(siluf_(y[4]), siluf_(y[5])); o.w = cvt_pk_bf16(siluf_(y[6]), siluf_(y[7]));
            *(u32x4*)(xc + (size_t)t * DM + c8 * 8) = o; }
    }
}

template <bool PASSC>
__device__ __forceinline__ void s5_phase(const KP& p, int l, LAS unsigned char* lds) {
    const int tid = opaque_tid(); const int wid = tid >> 6, lane = tid & 63, fr = lane & 15, fq = lane >> 4;
    LAS float* buS = (LAS float*)(lds + wid * 12800);
    LAS unsigned char* sS = lds + wid * 12800 + 8448;
    const bf16_t* proj = (const bf16_t*)(p.ws + O_BIG); bf16_t* z = (bf16_t*)(p.ws + O_Z);
    f32x2* s5end = (f32x2*)(p.ws + O_S5END);
    for (int task = blockIdx.x * 8 + wid; task < 2048; task += gridDim.x * 8) {
        const int seq = task >> 5, c = task & 31, b = seq >> 5, g = seq & 31, n = lane, lg = l * 32 + g;
        const float dt = expf(p.in[10][lg]);
        float ar, ai;
        { const float lr = fminf(p.in[8][lg * 64 + n], -1e-4f), li = p.in[9][lg * 64 + n];
          const float mag = expf(lr * dt); float sn, cs; sincos_acc(li * dt, sn, cs); ar = mag * cs; ai = mag * sn; }
        bf16x8 bx[8];
#pragma unroll
        for (int q4 = 0; q4 < 4; ++q4) { const int n2 = q4 * 16 + fr;
            const float lr = fminf(p.in[8][lg * 64 + n2], -1e-4f), li = p.in[9][lg * 64 + n2];
            const float mag = expf(lr * dt); float sn, cs; sincos_acc(li * dt, sn, cs);
            const float a_r = mag * cs, a_i = mag * sn, den = lr * lr + li * li;
            float qr = ((a_r - 1.0f) * lr + a_i * li) / den, qi = (a_i * lr - (a_r - 1.0f) * li) / den;
            if (fq >= 2) { qr = 0.f; qi = 0.f; }
            const float* brp = p.in[11] + (size_t)(lg * 64 + n2) * 16 + (fq & 1) * 8; const float* bip = p.in[12] + (size_t)(lg * 64 + n2) * 16 + (fq & 1) * 8;
            const f32x4 br0 = *(const f32x4*)brp, br1 = *(const f32x4*)(brp + 4), bi0 = *(const f32x4*)bip, bi1 = *(const f32x4*)(bip + 4);
            const f32x4 re0 = qr * br0 - qi * bi0, re1 = qr * br1 - qi * bi1, im0 = qr * bi0 + qi * br0, im1 = qr * bi1 + qi * br1;
            u32x4 o; o.x = cvt_pk_bf16(re0.x, re0.y); o.y = cvt_pk_bf16(re0.z, re0.w); o.z = cvt_pk_bf16(re1.x, re1.y); o.w = cvt_pk_bf16(re1.z, re1.w);
            bx[q4] = __builtin_bit_cast(bf16x8, o);
            o.x = cvt_pk_bf16(im0.x, im0.y); o.y = cvt_pk_bf16(im0.z, im0.w); o.z = cvt_pk_bf16(im1.x, im1.y); o.w = cvt_pk_bf16(im1.z, im1.w);
            bx[4 + q4] = __builtin_bit_cast(bf16x8, o); }
        float sr = 0.f, si = 0.f;
        bf16x8 cm[4]; f32x4 d4 = (f32x4){0.f, 0.f, 0.f, 0.f};
        if (PASSC) {
            float xr = ar, xi = ai;
#pragma unroll
            for (int q = 0; q < 8; ++q) { const float t0 = xr * xr - xi * xi, t1 = 2.0f * xr * xi; xr = t0; xi = t1; }
            for (int c0 = 0; c0 < c; c0 += 16) {
                f32x2 ev[16];
#pragma unroll
                for (int j = 0; j < 16; ++j) { const int cc = (c0 + j < c) ? c0 + j : c - 1; ev[j] = s5end[(size_t)(seq * 32 + cc) * 64 + n]; }
#pragma unroll
                for (int j = 0; j < 16; ++j) { const bool on = c0 + j < c; const float t0 = sr * xr - si * xi + ev[j].x, t1 = sr * xi + si * xr + ev[j].y; sr = on ? t0 : sr; si = on ? t1 : si; }
            }
#pragma unroll
            for (int kb = 0; kb < 4; ++kb) { const float* src = (kb < 2 ? p.in[13] : p.in[14]) + (size_t)(lg * 16 + fr) * 64 + (kb & 1) * 32 + fq * 8;
                const f32x4 a = *(const f32x4*)src, bq = *(const f32x4*)(src + 4); const float sg = kb < 2 ? 1.0f : -1.0f;
                u32x4 o; o.x = cvt_pk_bf16(sg * a.x, sg * a.y); o.y = cvt_pk_bf16(sg * a.z, sg * a.w); o.z = cvt_pk_bf16(sg * bq.x, sg * bq.y); o.w = cvt_pk_bf16(sg * bq.z, sg * bq.w);
                cm[kb] = __builtin_bit_cast(bf16x8, o); }
            d4 = *(const f32x4*)(p.in[15] + (size_t)l * 512 + g * 16 + fq * 4);
        }
        const int tok0 = b * SEQ + c * 256;
        const bf16_t* urow0 = proj + (size_t)(tok0 + fr) * NPROJ + g * 16;
        u32x4 unext = *(const u32x4*)(urow0 + (fq & 1) * 8); u32x2 u4next = *(const u32x2*)(urow0 + fq * 4);
        for (int sub = 0; sub < 16; ++sub) {
            u32x4 uraw = unext; const u32x2 u4 = u4next;
            if (sub < 15) { const bf16_t* urow = urow0 + (size_t)(sub + 1) * 16 * NPROJ; unext = *(const u32x4*)(urow + (fq & 1) * 8); u4next = *(const u32x2*)(urow + fq * 4); }
            if (fq >= 2) uraw = (u32x4){0u, 0u, 0u, 0u};
            const bf16x8 yu = __builtin_bit_cast(bf16x8, uraw);
#pragma unroll
            for (int kb = 0; kb < 8; ++kb) { const f32x4 acc = __builtin_amdgcn_mfma_f32_16x16x32_bf16(bx[kb], yu, (f32x4){0.f, 0.f, 0.f, 0.f}, 0, 0, 0);
                *(LAS f32x4*)(buS + fr * 132 + kb * 16 + fq * 4) = acc; }
            WAVE_LDS_SYNC();
            float burv[16], buiv[16];
#pragma unroll
            for (int tt = 0; tt < 16; ++tt) { burv[tt] = buS[tt * 132 + n]; buiv[tt] = buS[tt * 132 + 64 + n]; }
#pragma unroll
            for (int tt = 0; tt < 16; ++tt) {
                const float bur = burv[tt], bui = buiv[tt];
                const float t0 = ar * sr - ai * si + bur, t1 = ar * si + ai * sr + bui; sr = t0; si = t1;
                if (PASSC) { const unsigned pk = cvt_pk_bf16(sr, si); *(LAS unsigned short*)(sS + tt * 272 + n * 2) = (unsigned short)(pk & 0xffffu); *(LAS unsigned short*)(sS + tt * 272 + 128 + n * 2) = (unsigned short)(pk >> 16); }
            }
            if (PASSC) {
                WAVE_LDS_SYNC();
                f32x4 acc = (f32x4){0.f, 0.f, 0.f, 0.f};
#pragma unroll
                for (int kb = 0; kb < 4; ++kb) { const bf16x8 yf = *(LAS bf16x8*)(sS + fr * 272 + (kb * 32 + fq * 8) * 2); acc = __builtin_amdgcn_mfma_f32_16x16x32_bf16(cm[kb], yf, acc, 0, 0, 0); }
                const f32x4 uv = (f32x4){bflo(u4.x), bfhi(u4.x), bflo(u4.y), bfhi(u4.y)};
                const f32x4 y = acc + d4 * uv;
                u32x2 o; o.x = cvt_pk_bf16(gelu_tanh(y.x), gelu_tanh(y.y)); o.y = cvt_pk_bf16(gelu_tanh(y.z), gelu_tanh(y.w));
                *(u32x2*)(z + (size_t)(tok0 + sub * 16 + fr) * 512 + g * 16 + fq * 4) = o;
            }
            WAVE_LDS_SYNC();
        }
        if (!PASSC) s5end[(size_t)(seq * 32 + c) * 64 + n] = (f32x2){sr, si};
    }
}

__device__ __forceinline__ float scan_sum128(float v, int tid, LAS float* tmp) {
    const int lane = tid & 63; float x = v;
#pragma unroll
    for (int o = 1; o < 64; o <<= 1) { const float y = __shfl_up(x, o); if (lane >= o) x += y; }
    if (tid == 63) tmp[0] = x;
    __syncthreads();
    if (tid >= 64 && tid < 128) x += tmp[0];
    return x;
}
__device__ __forceinline__ float scan_max128(float v, int tid, LAS float* tmp) {
    const int lane = tid & 63; float x = v;
#pragma unroll
    for (int o = 1; o < 64; o <<= 1) { const float y = __shfl_up(x, o); if (lane >= o) x = fmaxf(x, y); }
    if (tid == 63) tmp[1] = x;
    __syncthreads();
    if (tid >= 64 && tid < 128) x = fmaxf(x, tmp[1]);
    return x;
}
__device__ __forceinline__ bf16x8 tr_frag(LAS unsigned char* a0, int second_off) {
    const s16x4 lo = __builtin_amdgcn_ds_read_tr16_b64_v4i16((LAS s16x4*)a0);
    const s16x4 hi = __builtin_amdgcn_ds_read_tr16_b64_v4i16((LAS s16x4*)(a0 + second_off));
    return __builtin_shufflevector(lo, hi, 0, 1, 2, 3, 4, 5, 6, 7);
}
template <bool OWN> __device__ __forceinline__ void mlstm_s1_phase(const KP& p, LAS unsigned char* lds) {
    const int tid = opaque_tid(), wid = tid >> 6, lane = tid & 63, fr = lane & 15, fq = lane >> 4;
    const bf16_t* proj = (const bf16_t*)(p.ws + O_BIG); const bf16_t* kbuf = (const bf16_t*)(p.ws + O_K);
    const float* ifb = (const float*)(p.ws + O_IF); bf16_t* cst = (bf16_t*)(p.ws + O_CST);
    float* gout = (float*)(p.ws + O_G); float* mlout = (float*)(p.ws + O_MLOC); float* nloc = (float*)(p.ws + O_NLOC);
    LAS unsigned char* Ks = lds; LAS unsigned char* Vs = lds + 69632;
    LAS float* vlf = (LAS float*)(lds + VEC_OFF); LAS float* vi = vlf + 128; LAS float* vb = vlf + 256; LAS float* vdec = vlf + 384;
    const int own_pm = (int)blockIdx.x >> 2, own_bhc0 = (((own_pm >> 5) * 4 + ((int)blockIdx.x & 3)) * 64) + (own_pm & 31) * 2;
    for (int tk = OWN ? 0 : (int)blockIdx.x; tk < (OWN ? 4 : 1024); tk += OWN ? 1 : (int)gridDim.x) {
        const int task = OWN ? (((own_bhc0 + (tk >> 1)) << 1) | (tk & 1)) : tk;
        const int eh = task & 1, bhc = task >> 1, c = bhc & 63, bh = bhc >> 6, h = bh & 3, b = bh >> 2;
        const int tok0 = b * SEQ + c * 128;
        u32x4 kv[8], vv[4];
#pragma unroll
        for (int it = 0; it < 8; ++it) { const int id = it * 512 + tid, s = id >> 5, ch = id & 31; kv[it] = *(const u32x4*)(kbuf + (unsigned)(tok0 + s) * DM + h * 256 + ch * 8); }
#pragma unroll
        for (int it = 0; it < 4; ++it) { const int id = it * 512 + tid, s = id >> 4, ch = id & 15; vv[it] = *(const u32x4*)(proj + (unsigned)(tok0 + s) * NPROJ + 1536 + h * 256 + eh * 128 + ch * 8); }
        LAS float* tmp = vlf;
        float gi = 0.f, glf = 0.f;
        if (tid < 128) { gi = ifb[(size_t)(tok0 + tid) * 8 + h]; glf = logsigmoidf_(ifb[(size_t)(tok0 + tid) * 8 + 4 + h]); }
        const float bsum = scan_sum128(glf, tid, tmp);
        if (tid == 127) tmp[2] = bsum;
        __syncthreads();
        const float gg = tmp[2];
        float dec = -INFINITY;
        if (tid < 128) { dec = gg - bsum + gi; vdec[tid] = dec; }
        { float x = dec;
#pragma unroll
          for (int o = 1; o < 64; o <<= 1) x = fmaxf(x, __shfl_xor(x, o));
          if (lane == 0 && wid < 2) tmp[4 + wid] = x; }
        __syncthreads();
        const float mloc = fmaxf(tmp[4], tmp[5]);
        asm volatile("" ::: "memory");
#pragma unroll
        for (int it = 0; it < 8; ++it) { const int id = it * 512 + tid, s = id >> 5, ch = id & 31;
            const u32x4 v = kv[it]; const float w = __expf(vdec[s] - mloc);
            u32x4 o; o.x = cvt_pk_bf16(bflo(v.x) * w, bfhi(v.x) * w); o.y = cvt_pk_bf16(bflo(v.y) * w, bfhi(v.y) * w); o.z = cvt_pk_bf16(bflo(v.z) * w, bfhi(v.z) * w); o.w = cvt_pk_bf16(bflo(v.w) * w, bfhi(v.w) * w);
            *(LAS u32x4*)(Ks + s * 544 + ch * 16) = o; }
#pragma unroll
        for (int it = 0; it < 4; ++it) { const int id = it * 512 + tid, s = id >> 4, ch = id & 15;
            *(LAS u32x4*)(Vs + s * 288 + ch * 16) = vv[it]; }
        __syncthreads();
        f32x4 acc[2][8];
#pragma unroll
        for (int a = 0; a < 2; ++a)
#pragma unroll
            for (int e = 0; e < 8; ++e) acc[a][e] = (f32x4){0.f, 0.f, 0.f, 0.f};
#pragma unroll
        for (int kb = 0; kb < 4; ++kb) {
            bf16x8 X[2];
#pragma unroll
            for (int db = 0; db < 2; ++db) X[db] = tr_frag(Ks + (kb * 32 + fq * 4 + (fr >> 2)) * 544 + (32 * wid + db * 16 + (fr & 3) * 4) * 2, 16 * 544);
#pragma unroll
            for (int eb = 0; eb < 8; ++eb) { const bf16x8 Y = tr_frag(Vs + (kb * 32 + fq * 4 + (fr >> 2)) * 288 + (eb * 16 + (fr & 3) * 4) * 2, 16 * 288);
#pragma unroll
                for (int db = 0; db < 2; ++db) acc[db][eb] = __builtin_amdgcn_mfma_f32_16x16x32_bf16(X[db], Y, acc[db][eb], 0, 0, 0); }
        }
#pragma unroll
        for (int db = 0; db < 2; ++db)
#pragma unroll
            for (int eb = 0; eb < 8; ++eb) { u32x2 o; o.x = cvt_pk_bf16(acc[db][eb][0], acc[db][eb][1]); o.y = cvt_pk_bf16(acc[db][eb][2], acc[db][eb][3]);
                *(u32x2*)(cst + (size_t)bhc * 65536 + (size_t)(eh * 128 + eb * 16 + fr) * 256 + 32 * wid + db * 16 + fq * 4) = o; }
        if (eh == 0) {
            if (tid < 256) { float sn = 0.f;
                for (int s0 = 0; s0 < 128; s0 += 16) { unsigned short tv[16];
#pragma unroll
                    for (int j = 0; j < 16; ++j) tv[j] = *(LAS unsigned short*)(Ks + (s0 + j) * 544 + tid * 2);
#pragma unroll
                    for (int j = 0; j < 16; ++j) sn += bflo((unsigned)tv[j]); }
                nloc[(size_t)bhc * 256 + tid] = sn; }
            if (tid == 0) { gout[bhc] = gg; mlout[bhc] = mloc; }
        }
        __syncthreads();
    }
}
__device__ __forceinline__ void mlstm_s2_phase(const KP& p) {
    const int tid = opaque_tid();
    bf16_t* cst = (bf16_t*)(p.ws + O_CST);
    const float* gin = (const float*)(p.ws + O_G); const float* mlin = (const float*)(p.ws + O_MLOC); float* mst = (float*)(p.ws + O_MST);
    const float* nloc = (const float*)(p.ws + O_NLOC); float* nst = (float*)(p.ws + O_NST);
    for (int slot = blockIdx.x; slot < 256; slot += gridDim.x) {
        const int bh = slot >> 5, part = slot & 31; const size_t e0 = (size_t)(part * 512 + tid) * 4;
        float m = 0.f, C0 = 0.f, C1 = 0.f, C2 = 0.f, C3 = 0.f, nv = 0.f;
        const bool do_n = (part == 0) && (tid < 256);
        for (int c8 = 0; c8 < 64; c8 += 8) {
            u32x2 loc[8]; float nl[8];
#pragma unroll
            for (int j = 0; j < 8; ++j) { loc[j] = *(const u32x2*)(cst + (size_t)(bh * 64 + c8 + j) * 65536 + e0); nl[j] = do_n ? nloc[(size_t)(bh * 64 + c8 + j) * 256 + tid] : 0.f; }
#pragma unroll
            for (int j = 0; j < 8; ++j) { const int idx = bh * 64 + c8 + j;
                const float g = gin[idx], ml = mlin[idx]; const float mnew = fmaxf(g + m, ml); const float wo = __expf(g + m - mnew), wl = __expf(ml - mnew);
                u32x2 o; o.x = cvt_pk_bf16(C0, C1); o.y = cvt_pk_bf16(C2, C3);
                *(u32x2*)(cst + (size_t)idx * 65536 + e0) = o;
                C0 = wo * C0 + wl * bflo(loc[j].x); C1 = wo * C1 + wl * bfhi(loc[j].x); C2 = wo * C2 + wl * bflo(loc[j].y); C3 = wo * C3 + wl * bfhi(loc[j].y);
                if (do_n) { nst[(size_t)idx * 256 + tid] = nv; nv = wo * nv + wl * nl[j]; if (tid == 0) mst[idx] = m; }
                m = mnew; }
        }
    }
}
__device__ __forceinline__ void mlstm_s3_phase(const KP& p, int l, LAS unsigned char* lds) {
    const int tid = opaque_tid(), wid = tid >> 6, lane = tid & 63, fr = lane & 15, fq = lane >> 4;
    const bf16_t* proj = (const bf16_t*)(p.ws + O_BIG); const bf16_t* qbuf = (const bf16_t*)(p.ws + O_Q); const bf16_t* kbuf = (const bf16_t*)(p.ws + O_K);
    const bf16_t* xc = (const bf16_t*)(p.ws + O_XC); const float* ifb = (const float*)(p.ws + O_IF); const bf16_t* cst = (const bf16_t*)(p.ws + O_CST);
    const float* mst = (const float*)(p.ws + O_MST); const float* nst = (const float*)(p.ws + O_NST); bf16_t* yml = (bf16_t*)(p.ws + O_XN);
    const float* normg = p.in[22] + (unsigned)l * 1024; const float* skipg = p.in[23] + (unsigned)l * 1024;
    LAS unsigned char* Vh = lds;
    LAS unsigned char* Qs = lds + 36864;
    LAS unsigned char* Kt = lds + 55296;
    LAS unsigned char* CTs = lds + 73728;
    LAS unsigned char* Ss = lds + 92160;
    LAS float* vlf = (LAS float*)(lds + VEC_OFF); LAS float* va = vlf + 128; LAS float* vb = vlf + 256; LAS float* vM = vlf + 384; LAS float* nvec = vlf + 512;
    for (int task = blockIdx.x; task < 512; task += gridDim.x) {
        const int bhc = task, c = bhc & 63, bh = bhc >> 6, h = bh & 3, b = bh >> 2;
        const int tok0 = b * SEQ + c * 128;
        const float m0 = mst[bhc];
        float gi = 0.f, glf = 0.f;
        if (tid < 128) { gi = ifb[(unsigned)(tok0 + tid) * 8 + h]; glf = logsigmoidf_(ifb[(unsigned)(tok0 + tid) * 8 + 4 + h]); }
        if (tid < 256) nvec[tid] = nst[(unsigned)bhc * 256 + tid];
        const float bs = scan_sum128(glf, tid, vlf);
        const float av = (tid < 128) ? gi - bs : -INFINITY;
        const float mm = scan_max128(av, tid, vlf);
        if (tid < 128) { vb[tid] = bs; va[tid] = av; vM[tid] = fmaxf(m0, mm); }
        const int t = 16 * wid + fr;
        const unsigned tok = (unsigned)(tok0 + t);
        u32x2 hc0[8];
        float qn = 0.f, ss = 0.f, inv = 0.f, winter = 0.f;
#pragma unroll
        for (int eh = 0; eh < 2; ++eh) {
            f32x4 accS[8], accO[8];
#pragma unroll
            for (int i = 0; i < 8; ++i) { accS[i] = (f32x4){0.f, 0.f, 0.f, 0.f}; accO[i] = (f32x4){0.f, 0.f, 0.f, 0.f}; }
            u32x4 pq[2], pk[2], pc[2];
#define S3_LOAD(DB) do { _Pragma("unroll") for (int it = 0; it < 2; ++it) { const int id = it * 512 + tid, row = id >> 3, ch = id & 7; \
                    pq[it] = *(const u32x4*)(qbuf + (unsigned)(tok0 + row) * DM + h * 256 + (DB) * 64 + ch * 8); \
                    if (eh == 0) pk[it] = *(const u32x4*)(kbuf + (unsigned)(tok0 + row) * DM + h * 256 + (DB) * 64 + ch * 8); \
                    pc[it] = *(const u32x4*)(cst + (unsigned)bhc * 65536 + (unsigned)(eh * 128 + row) * 256 + (DB) * 64 + ch * 8); } } while (0)
            S3_LOAD(0);
            for (int db4 = 0; db4 < 4; ++db4) {
                __syncthreads();
#pragma unroll
                for (int it = 0; it < 2; ++it) { const int id = it * 512 + tid, row = id >> 3, ch = id & 7;
                    *(LAS u32x4*)(Qs + row * 144 + ch * 16) = pq[it];
                    if (eh == 0) *(LAS u32x4*)(Kt + row * 144 + ch * 16) = pk[it];
                    *(LAS u32x4*)(CTs + row * 144 + ch * 16) = pc[it]; }
                if (db4 < 3) S3_LOAD(db4 + 1);
                __syncthreads();
#pragma unroll
                for (int kk = 0; kk < 2; ++kk) {
                    const bf16x8 Qf = *(LAS bf16x8*)(Qs + (16 * wid + fr) * 144 + (kk * 32 + fq * 8) * 2);
                    if (eh == 0) {
                        const u32x4 qu = __builtin_bit_cast(u32x4, Qf); const LAS float* nvp = nvec + db4 * 64 + kk * 32 + fq * 8; const f32x4 n0 = *(LAS f32x4*)nvp, n1 = *(LAS f32x4*)(nvp + 4);
                        qn += bflo(qu.x) * n0.x + bfhi(qu.x) * n0.y + bflo(qu.y) * n0.z + bfhi(qu.y) * n0.w + bflo(qu.z) * n1.x + bfhi(qu.z) * n1.y + bflo(qu.w) * n1.z + bfhi(qu.w) * n1.w;
#pragma unroll
                        for (int sb = 0; sb < 8; ++sb) { if (sb <= wid) { const bf16x8 Kf = *(LAS bf16x8*)(Kt + (sb * 16 + fr) * 144 + (kk * 32 + fq * 8) * 2); accS[sb] = __builtin_amdgcn_mfma_f32_16x16x32_bf16(Kf, Qf, accS[sb], 0, 0, 0); } if ((sb & 3) == 3) { asm volatile("" ::: "memory"); __builtin_amdgcn_sched_barrier(0); } }
                    }
#pragma unroll
                    for (int eb = 0; eb < 8; ++eb) { const bf16x8 Cf = *(LAS bf16x8*)(CTs + (eb * 16 + fr) * 144 + (kk * 32 + fq * 8) * 2); accO[eb] = __builtin_amdgcn_mfma_f32_16x16x32_bf16(Cf, Qf, accO[eb], 0, 0, 0); if ((eb & 3) == 3) { asm volatile("" ::: "memory"); __builtin_amdgcn_sched_barrier(0); } }
                }
            }
            u32x4 vt[4];
#pragma unroll
            for (int it = 0; it < 4; ++it) { const int id = it * 512 + tid, s = id >> 4, ch = id & 15; vt[it] = *(const u32x4*)(proj + (unsigned)(tok0 + s) * NPROJ + 1536 + h * 256 + eh * 128 + ch * 8); }
            asm volatile("" ::: "memory");
#pragma unroll
            for (int it = 0; it < 4; ++it) { const int id = it * 512 + tid, s = id >> 4, ch = id & 15; *(LAS u32x4*)(Vh + s * 288 + ch * 16) = vt[it]; }
            if (eh == 0) {
                const float Mt = vM[t]; winter = __expf(m0 - Mt);
                float rowsum = 0.f;
#pragma unroll
                for (int sb = 0; sb < 8; ++sb) if (sb <= (wid | 1)) {
                    const f32x4 a4 = *(LAS f32x4*)(va + sb * 16 + fq * 4);
                    float sv[4];
#pragma unroll
                    for (int j = 0; j < 4; ++j) { const int s = sb * 16 + fq * 4 + j; const float v0 = accS[sb][j] * __expf(fminf(a4[j] - Mt, 0.f)); const float v = (s <= t) ? v0 : 0.f; sv[j] = v; rowsum += v; }
                    u32x2 o; o.x = cvt_pk_bf16(sv[0], sv[1]); o.y = cvt_pk_bf16(sv[2], sv[3]);
                    *(LAS u32x2*)(Ss + t * 272 + (sb * 16 + fq * 4) * 2) = o;
                }
                rowsum += __shfl_xor(rowsum, 16); rowsum += __shfl_xor(rowsum, 32);
                qn += __shfl_xor(qn, 16); qn += __shfl_xor(qn, 32);
                const float den = winter * qn + rowsum, mt = vb[t] + Mt;
                inv = 1.0f / fmaxf(fabsf(den), __expf(-mt));
            }
#pragma unroll
            for (int eb = 0; eb < 8; ++eb) accO[eb] = accO[eb] * winter;
            __syncthreads();
            for (int kb = 0; kb <= (wid >> 1); ++kb) {
                const s16x4 s0 = *(LAS s16x4*)(Ss + t * 272 + (kb * 32 + fq * 4) * 2), s1 = *(LAS s16x4*)(Ss + t * 272 + (kb * 32 + 16 + fq * 4) * 2);
                const bf16x8 Sf = __builtin_shufflevector(s0, s1, 0, 1, 2, 3, 4, 5, 6, 7);
#pragma unroll
                for (int eb = 0; eb < 8; ++eb) { const bf16x8 Vf = tr_frag(Vh + (kb * 32 + fq * 4 + (fr >> 2)) * 288 + (eb * 16 + (fr & 3) * 4) * 2, 16 * 288);
                    accO[eb] = __builtin_amdgcn_mfma_f32_16x16x32_bf16(Vf, Sf, accO[eb], 0, 0, 0); if ((eb & 3) == 3) { asm volatile("" ::: "memory"); __builtin_amdgcn_sched_barrier(0); } }
            }
            u32x2 ovv[8];
#pragma unroll
            for (int eb = 0; eb < 8; ++eb) ovv[eb] = *(const u32x2*)(proj + tok * NPROJ + 2560 + h * 256 + eh * 128 + eb * 16 + fq * 4);
            asm volatile("" ::: "memory");
#pragma unroll
            for (int eb = 0; eb < 8; ++eb) { const u32x2 ov = ovv[eb];
                f32x4 hc; hc.x = sigmoidf_(bflo(ov.x)) * accO[eb].x * inv; hc.y = sigmoidf_(bfhi(ov.x)) * accO[eb].y * inv; hc.z = sigmoidf_(bflo(ov.y)) * accO[eb].z * inv; hc.w = sigmoidf_(bfhi(ov.y)) * accO[eb].w * inv;
                ss += (hc.x * hc.x + hc.y * hc.y) + (hc.z * hc.z + hc.w * hc.w);
                if (eh == 0) { hc0[eb].x = cvt_pk_bf16(hc.x, hc.y); hc0[eb].y = cvt_pk_bf16(hc.z, hc.w); } else accO[eb] = hc;
                if ((eb & 3) == 3) { asm volatile("" ::: "memory"); __builtin_amdgcn_sched_barrier(0); } }
            if (eh == 1) {
                ss += __shfl_xor(ss, 16); ss += __shfl_xor(ss, 32);
                const float rs = rsqrtf(ss * (1.0f / 256.0f) + EPS);
#pragma unroll
                for (int e4 = 0; e4 < 8; ++e4) {
                    f32x4 ngv[2], skv[2]; u32x2 xvv[2];
#pragma unroll
                    for (int q = 0; q < 2; ++q) { const int col = h * 256 + (e4 * 2 + q) * 16 + fq * 4; ngv[q] = *(const f32x4*)(normg + col); skv[q] = *(const f32x4*)(skipg + col); xvv[q] = *(const u32x2*)(xc + tok * DM + col); }
                    asm volatile("" ::: "memory");
#pragma unroll
                    for (int q = 0; q < 2; ++q) { const int e2 = e4 * 2 + q, col = h * 256 + e2 * 16 + fq * 4;
                        const f32x4 ng = ngv[q], sk = skv[q]; const u32x2 xv = xvv[q];
                        f32x4 hc; if (e2 < 8) { const u32x2 hp = hc0[e2 & 7]; hc = (f32x4){bflo(hp.x), bfhi(hp.x), bflo(hp.y), bfhi(hp.y)}; } else hc = accO[e2 & 7];
                        u32x2 o; o.x = cvt_pk_bf16(hc.x * rs * ng.x + sk.x * bflo(xv.x), hc.y * rs * ng.y + sk.y * bfhi(xv.x)); o.y = cvt_pk_bf16(hc.z * rs * ng.z + sk.z * bflo(xv.y), hc.w * rs * ng.w + sk.w * bfhi(xv.y));
                        *(u32x2*)(yml + tok * DM + col) = o; }
                    asm volatile("" ::: "memory"); __builtin_amdgcn_sched_barrier(0);
                }
            }
        }
        __syncthreads();
    }
}

#define XB_TMO      128
#define XB_XCNT(j)  (256  + 64 * (j))
#define XB_XSUB(j)  (1280 + 64 * (j))
#define XB_XGEN(j)  (2304 + 64 * (j))
#define XB_TOP      3328
#define XB_TOPGEN   3392
#define XCD_BAR_WORDS 3456
#define XB_SPIN_CAP (1u << 22)
__device__ __forceinline__ unsigned xb_ld(unsigned* p)              { return __hip_atomic_load(p, __ATOMIC_RELAXED, __HIP_MEMORY_SCOPE_AGENT); }
__device__ __forceinline__ unsigned xb_add(unsigned* p, unsigned v) { return __hip_atomic_fetch_add(p, v, __ATOMIC_RELAXED, __HIP_MEMORY_SCOPE_AGENT); }
__device__ __forceinline__ unsigned xb_xcc_id() { return (unsigned)__builtin_amdgcn_s_getreg((3 << 11) | 20) & 0xFu; }
#define XB_SPIN(cond, bar) do { unsigned _sp = 0; while (cond) { __builtin_amdgcn_s_sleep(1); \
    if ((++_sp & 255u) == 0u) { if (xb_ld(&(bar)[XB_TMO])) break; if (_sp > XB_SPIN_CAP) { atomicAdd(&(bar)[XB_TMO], 1u); break; } } } } while (0)
struct XcdBarrier { unsigned* bar; unsigned x; volatile LAS unsigned* st; };
__device__ __forceinline__ XcdBarrier xcd_barrier_post(unsigned* bar, volatile LAS unsigned* st) {
    XcdBarrier b; b.bar = bar; b.x = xb_xcc_id(); b.st = st;
    if (threadIdx.x == 0) (void)xb_add(&bar[XB_XCNT(b.x)], 1u);
    return b;
}
__device__ __forceinline__ void xcd_barrier_complete(unsigned* bar, unsigned x, unsigned& nloc, unsigned& nx) {
    const unsigned G = gridDim.x * gridDim.y * gridDim.z;
    unsigned sum, cnt, mine, sp = 0u;
    for (;;) {
        sum = 0u; cnt = 0u; mine = 0u;
#pragma unroll
        for (unsigned j = 0; j < 16; ++j) { const unsigned c = xb_ld(&bar[XB_XCNT(j)]); sum += c; cnt += (c > 0u) ? 1u : 0u; mine = (j == x) ? c : mine; }
        if (sum == G) break;
        __builtin_amdgcn_s_sleep(1);
        if ((++sp & 255u) == 0u) { if (xb_ld(&bar[XB_TMO])) break; if (sp > XB_SPIN_CAP) { atomicAdd(&bar[XB_TMO], 1u); break; } }
    }
    nloc = mine > 0u ? mine : 1u; nx = cnt > 0u ? cnt : 1u;
}
__device__ __forceinline__ void xcd_barrier(const XcdBarrier& b) {
    asm volatile("s_waitcnt vmcnt(0) lgkmcnt(0)" ::: "memory");
    __syncthreads();
    if (threadIdx.x == 0) {
        unsigned* bar = b.bar;
        __builtin_amdgcn_s_waitcnt(0);
        unsigned nloc = b.st[0], nx = b.st[1];
        if (nloc == 0u) { xcd_barrier_complete(bar, b.x, nloc, nx); b.st[0] = nloc; b.st[1] = nx; }
        const unsigned old = xb_add(&bar[XB_XSUB(b.x)], 1u);
        const unsigned gen = old / nloc;
        if (old + 1u == (gen + 1u) * nloc) {
            __builtin_amdgcn_fence(__ATOMIC_RELEASE, "agent");
            asm volatile("s_waitcnt vmcnt(0)" ::: "memory");
            const unsigned og = xb_add(&bar[XB_TOP], 1u);
            const unsigned tg = og / nx;
            if (og + 1u == (tg + 1u) * nx) xb_add(&bar[XB_TOPGEN], 1u);
            else XB_SPIN(xb_ld(&bar[XB_TOPGEN]) == tg, bar);
            __builtin_amdgcn_fence(__ATOMIC_ACQUIRE, "agent");
            xb_add(&bar[XB_XGEN(b.x)], 1u);
            asm volatile("s_waitcnt vmcnt(0)" ::: "memory");
        } else {
            XB_SPIN(xb_ld(&bar[XB_XGEN(b.x)]) == gen, bar);
            __builtin_amdgcn_fence(__ATOMIC_ACQUIRE, "agent");
            asm volatile("s_waitcnt vmcnt(0)" ::: "memory");
        }
    }
    __syncthreads();
}

__global__ void __launch_bounds__(512, 2) fwd_megakernel(KP p) {
    extern __shared__ __attribute__((aligned(16))) unsigned char shm[];
    LAS unsigned char* lds = (LAS unsigned char*)shm;
    cg::grid_group grid = cg::this_grid();
    { volatile LAS unsigned* st0 = (volatile LAS unsigned*)(lds + 143360); if (threadIdx.x < 4) st0[threadIdx.x] = 0u; }
    __syncthreads();
    const XcdBarrier xb = xcd_barrier_post((unsigned*)(p.ws + O_BAR), (volatile LAS unsigned*)(lds + 143360));
    asm volatile("s_waitcnt vmcnt(0) lgkmcnt(0)" ::: "memory"); grid.sync();
#define GSYNC() xcd_barrier(xb)
    unsigned char* ws = p.ws;
    bf16_t* BIG = (bf16_t*)(ws + O_BIG); bf16_t* XN = (bf16_t*)(ws + O_XN); bf16_t* XC = (bf16_t*)(ws + O_XC);
    bf16_t* Q = (bf16_t*)(ws + O_Q); bf16_t* KB = (bf16_t*)(ws + O_K); bf16_t* Z = (bf16_t*)(ws + O_Z); bf16_t* YS5 = (bf16_t*)(ws + O_YS5);
    float* MIXACC = (float*)(ws + O_CST); float* IFB = (float*)(ws + O_IF);
    float* xo = p.out;
    for (int l = 0; l < 4; ++l) {
        const float* xcur = (l == 0) ? p.in[0] : xo;
        for (int rep = 0; rep < REP_A; ++rep) { convert_phase(p, l, lds);
        rmsnorm_phase<false>(xcur, p.in[1] + l * 1024, XN, nullptr, nullptr, nullptr, lds); }
        GSYNC(); if (STOP_PHASE == 1) break;
        for (int rep = 0; rep < REP_G; ++rep) { pg8::Gemm g{XN, (const bf16_t*)(ws + W_GU1), MTOK, 2 * FF, 1024, 1024, 1024, 0}; pg8::EpiGated<0> e{BIG, FF}; pg8::gemm_phase(lds, g, e); }
        GSYNC(); if (STOP_PHASE == 2) break;
        { pg8::Gemm g{BIG, (const bf16_t*)(ws + W_D1), MTOK, 1024, FF, FF, FF, 0}; pg8::EpiResid e{xcur, xo, 0.5f}; pg8::gemm_phase(lds, g, e); }
        GSYNC(); if (STOP_PHASE == 3) break;
        for (int rep = 0; rep < REP_A; ++rep) { rmsnorm_phase<true>(xo, p.in[5] + l * 1024, XN, p.in[6] + (size_t)l * 1024 * INC, p.in[7] + l * 8, IFB, lds); __syncthreads(); }
        GSYNC(); if (STOP_PHASE == 4) break;
        for (int rep = 0; rep < REP_G; ++rep) { pg8::Gemm g{XN, (const bf16_t*)(ws + W_IN), MTOK, NPROJ, 1024, 1024, 1024, 0}; pg8::EpiBf16 e{BIG, BIG, NPROJ, 1000, 1.0f}; pg8::gemm_phase(lds, g, e); }
        GSYNC(); if (STOP_PHASE == 5) break;
        if (gridDim.x == 256) {
            s5_phase<false>(p, l, lds);
            conv_slice(p, l, (int)blockIdx.x >> 2, (int)blockIdx.x & 3);
            asm volatile("s_waitcnt vmcnt(0) lgkmcnt(0)" ::: "memory"); __syncthreads();
            { pg8::Gemm g{XC, (const bf16_t*)(ws + W_QK), MTOK, 2048, 256, 1024, 256, 256, nullptr, nullptr, 0, 1}; pg8::EpiBf16 e{Q, KB, 1024, 4, 0.0625f}; pg8::gemm_phase(lds, g, e); }
            asm volatile("s_waitcnt vmcnt(0) lgkmcnt(0)" ::: "memory"); __syncthreads();
            mlstm_s1_phase<true>(p, lds);
            GSYNC();
            s5_phase<true>(p, l, lds);
            mlstm_s2_phase(p);
            GSYNC();
            __syncthreads();
            { pg8::Gemm g{Z, (const bf16_t*)(ws + W_GLU), MTOK, 1024, 512, 512, 512, 0}; pg8::EpiGated<1> e{YS5, 1024}; pg8::gemm_phase(lds, g, e); }
            mlstm_s3_phase(p, l, lds);
            GSYNC();
        } else {
            conv_phase(p, l);
            s5_phase<false>(p, l, lds);
            GSYNC();
            { pg8::Gemm g{XC, (const bf16_t*)(ws + W_QK), MTOK, 2048, 256, 1024, 256, 256}; pg8::EpiBf16 e{Q, KB, 1024, 4, 0.0625f}; pg8::gemm_phase(lds, g, e); }
            GSYNC();
            mlstm_s1_phase<false>(p, lds);
            s5_phase<true>(p, l, lds);
            GSYNC();
            mlstm_s2_phase(p);
            { pg8::Gemm g{Z, (const bf16_t*)(ws + W_GLU), MTOK, 1024, 512, 512, 512, 0}; pg8::EpiGated<1> e{YS5, 1024}; pg8::gemm_phase(lds, g, e); }
            GSYNC();
            mlstm_s3_phase(p, l, lds);
            GSYNC();
        }
        { pg8::Gemm g{YS5, (const bf16_t*)(ws + W_BS5), MTOK, 1024, 512, 1024, 1024, 0, XN, (const bf16_t*)(ws + W_BML), 1024}; pg8::EpiMergeDual e{BIG + 3584, BIG + 4608, Q}; pg8::gemm_phase(lds, g, e); }
        GSYNC(); if (STOP_PHASE == 11) break;
        { pg8::Gemm g{Q, (const bf16_t*)(ws + W_OUT), MTOK, 1024, 1024, 1024, 1024, 0}; pg8::EpiResid e{xo, xo, 1.0f}; pg8::gemm_phase(lds, g, e); }
        GSYNC(); if (STOP_PHASE == 12) break;
        for (int rep = 0; rep < REP_A; ++rep) rmsnorm_phase<false>(xo, p.in[27] + l * 1024, XN, nullptr, nullptr, nullptr, lds);
        GSYNC(); if (STOP_PHASE == 13) break;
        for (int rep = 0; rep < REP_G; ++rep) { pg8::Gemm g{XN, (const bf16_t*)(ws + W_GU2), MTOK, 2 * FF, 1024, 1024, 1024, 0}; pg8::EpiGated<0> e{BIG, FF}; pg8::gemm_phase(lds, g, e); }
        GSYNC(); if (STOP_PHASE == 14) break;
        { pg8::Gemm g{BIG, (const bf16_t*)(ws + W_D2), MTOK, 1024, FF, FF, FF, 0}; pg8::EpiResid e{xo, xo, 0.5f}; pg8::gemm_phase(lds, g, e); }
        GSYNC(); if (STOP_PHASE == 15) break;
    }
#ifdef DUMP_OFF
    { const int gt = blockIdx.x * 512 + opaque_tid(); const int nthr = gridDim.x * 512;
      for (int i = gt; i < MTOK * DM; i += nthr) { float v;
          if (DUMP_KIND == 5) { v = bflo((unsigned)((const bf16_t*)(ws + O_BIG))[(size_t)(i >> 10) * NPROJ + DUMP_COL + (i & 1023)]); }
          else if (DUMP_KIND == 4) { v = 0.f; if (i < 512) v = ((const float*)(ws + O_G))[i]; else if (i < 1024) v = ((const float*)(ws + O_MLOC))[i - 512]; else if (i < 1024 + 131072) v = ((const float*)(ws + O_NLOC))[i - 1024]; }
          else if (DUMP_KIND == 2 && i < 131072) v = ((const float*)(ws + O_IF))[i];
          else if (DUMP_KIND == 3) v = bflo((unsigned)((const bf16_t*)(ws + (i < 8388608 ? O_Q : O_K)))[i & 8388607]);
          else if (DUMP_KIND == 1) v = ((const float*)(ws + DUMP_OFF))[i]; else v = bflo((unsigned)((const bf16_t*)(ws + DUMP_OFF))[i]);
          xo[i] = (fabsf(v) < 1e30f) ? v : 12345.0f; } }
#else
    final_norm_phase(xo, p.in[31]);
#endif
}

extern "C" void kernel_launch(void* const* d_in, const int* in_sizes, int n_in, void* d_out, int out_size, void* d_ws, size_t ws_size, hipStream_t stream) {
    static int grid_blocks = 0;
    if (grid_blocks == 0) {
        if (n_in != 32 || ws_size < WS_END) { fprintf(stderr, "kernel_launch: unexpected n_in %d or ws_size %zu (< %zu)\n", n_in, ws_size, (size_t)WS_END); grid_blocks = -1; return; }
        int dev = 0, cus = 0, per_cu = 0;
        hipGetDevice(&dev);
        hipDeviceGetAttribute(&cus, hipDeviceAttributeMultiprocessorCount, dev);
        if (hipFuncSetAttribute((const void*)fwd_megakernel, hipFuncAttributeMaxDynamicSharedMemorySize, LDS_BYTES) != hipSuccess) { fprintf(stderr, "kernel_launch: hipFuncSetAttribute failed\n"); grid_blocks = -1; return; }
        hipOccupancyMaxActiveBlocksPerMultiprocessor(&per_cu, (const void*)fwd_megakernel, 512, LDS_BYTES);
        if (per_cu < 1) { fprintf(stderr, "kernel_launch: occupancy query says %d blocks/CU\n", per_cu); per_cu = 1; }
        (void)hipGetLastError();
        grid_blocks = cus;
    }
    if (grid_blocks < 0) return;
    if (hipMemsetAsync((unsigned char*)d_ws + O_BAR, 0, 16384, stream) != hipSuccess) { fprintf(stderr, "kernel_launch: memset of barrier words failed\n"); return; }
    KP p{};
    for (int i = 0; i < 32; ++i) p.in[i] = (const float*)d_in[i];
    p.out = (float*)d_out; p.ws = (unsigned char*)d_ws;
    void* args[] = {&p};
    hipError_t e = hipLaunchCooperativeKernel((const void*)fwd_megakernel, dim3(grid_blocks), dim3(512), args, LDS_BYTES, stream);
    if (e != hipSuccess) fprintf(stderr, "cooperative launch failed: %s (grid %d)\n", hipGetErrorString(e), grid_blocks);
}
```

```cpp
#include <hip/hip_runtime.h>
#include <hip/hip_cooperative_groups.h>
#include <cstdio>
namespace cg = cooperative_groups;

#define LAS __attribute__((address_space(3)))
typedef unsigned short bf16_t;
typedef short bf16x8 __attribute__((ext_vector_type(8)));
typedef short s16x4 __attribute__((ext_vector_type(4)));
typedef float f32x4 __attribute__((ext_vector_type(4)));
typedef float f32x2 __attribute__((ext_vector_type(2)));
typedef unsigned u32x4 __attribute__((ext_vector_type(4)));
typedef unsigned u32x2 __attribute__((ext_vector_type(2)));

constexpr int MTOK = 16384, DM = 1024, FF = 2816, NPROJ = 5632, SEQ = 8192, INC = 5640;
constexpr float EPS = 1e-6f;
constexpr int LDS_BYTES = 147456;
#ifndef STOP_PHASE
#define STOP_PHASE 99
#define REP_A 1
#define REP_G 1
#define REP_B 1
#define REP_C 1
#define REP_D 1
#endif
constexpr int VEC_OFF = 131072;

constexpr size_t W_GU1 = 0;
constexpr size_t W_D1 = W_GU1 + (size_t)5632 * 1024 * 2;
constexpr size_t W_IN = W_D1 + (size_t)1024 * 2816 * 2;
constexpr size_t W_GLU = W_IN + (size_t)5632 * 1024 * 2;
constexpr size_t W_QK = W_GLU + (size_t)1024 * 512 * 2;
constexpr size_t W_BS5 = W_QK + (size_t)2048 * 256 * 2;
constexpr size_t W_BML = W_BS5 + (size_t)1024 * 1024 * 2;
constexpr size_t W_OUT = W_BML + (size_t)1024 * 1024 * 2;
constexpr size_t W_GU2 = W_OUT + (size_t)1024 * 1024 * 2;
constexpr size_t W_D2 = W_GU2 + (size_t)5632 * 1024 * 2;
constexpr size_t W_END = W_D2 + (size_t)1024 * 2816 * 2;
constexpr size_t O_BIG = W_END;
constexpr size_t O_XN = O_BIG + (size_t)MTOK * NPROJ * 2;
constexpr size_t O_XC = O_XN + (size_t)MTOK * 1024 * 2;
constexpr size_t O_Q = O_XC + (size_t)MTOK * 1024 * 2;
constexpr size_t O_K = O_Q + (size_t)MTOK * 1024 * 2;
constexpr size_t O_Z = O_K + (size_t)MTOK * 1024 * 2;
constexpr size_t O_YS5 = O_Z + (size_t)MTOK * 512 * 2;
constexpr size_t O_CST = O_YS5 + (size_t)MTOK * 1024 * 2;
constexpr size_t O_IF = O_CST + (size_t)512 * 65536 * 2;
constexpr size_t O_S5END = O_IF + (size_t)MTOK * 8 * 4;
constexpr size_t O_G = O_S5END + (size_t)64 * 64 * 64 * 8;
constexpr size_t O_MLOC = O_G + 2048;
constexpr size_t O_MST = O_MLOC + 2048;
constexpr size_t O_NLOC = O_MST + 2048;
constexpr size_t O_NST = O_NLOC + (size_t)512 * 256 * 4;
constexpr size_t O_BAR = O_NST + (size_t)512 * 256 * 4;
constexpr size_t WS_END = O_BAR + 16384;

struct KP { const float* in[32]; float* out; unsigned char* ws; };

typedef __bf16 bf16v2_t __attribute__((ext_vector_type(2)));
__device__ __forceinline__ unsigned cvt_pk_bf16(float lo, float hi) { const f32x2 v = {lo, hi}; const bf16v2_t b = __builtin_convertvector(v, bf16v2_t); return __builtin_bit_cast(unsigned, b); }
__device__ __forceinline__ float bflo(unsigned u) { return __uint_as_float(u << 16); }
__device__ __forceinline__ float bfhi(unsigned u) { return __uint_as_float(u & 0xffff0000u); }
__device__ __forceinline__ float sigmoidf_(float x) { return __builtin_amdgcn_rcpf(1.0f + __expf(-x)); }
__device__ __forceinline__ float siluf_(float x) { return x * __builtin_amdgcn_rcpf(1.0f + __expf(-x)); }
__device__ __forceinline__ float gelu_tanh(float y) { const float v = 0.7978845608028654f * (y + 0.044715f * y * y * y); const float th = 1.0f - 2.0f * __builtin_amdgcn_rcpf(1.0f + __expf(2.0f * v)); return 0.5f * y * (1.0f + th); }
__device__ __forceinline__ float logsigmoidf_(float x) { return fminf(x, 0.f) - log1pf(__expf(-fabsf(x))); }
__device__ __forceinline__ float wave_sum(float v) {
#pragma unroll
    for (int o = 1; o < 64; o <<= 1) v += __shfl_xor(v, o);
    return v;
}
__device__ __forceinline__ int opaque_tid() { int t = threadIdx.x; asm volatile("" : "+v"(t)); return t; }
#define WAVE_LDS_SYNC() asm volatile("s_waitcnt lgkmcnt(0)" ::: "memory")
__device__ __forceinline__ void sincos_acc(float x, float& s, float& c) {
    const float k = rintf(x * 0.63661977236758134f);
    float r = fmaf(-k, 1.5703125f, x); r = fmaf(-k, 4.837512969970703125e-4f, r); r = fmaf(-k, 7.54978995489188216e-8f, r);
    const float r2 = r * r;
    const float sp = r + r * r2 * (-1.6666654611e-1f + r2 * (8.3321608736e-3f + r2 * (-1.9515295891e-4f)));
    const float cp = 1.0f - 0.5f * r2 + r2 * r2 * (4.166664568298827e-2f + r2 * (-1.388731625493765e-3f + r2 * 2.443315711809948e-5f));
    const int q = ((int)k) & 3;
    s = (q == 0) ? sp : (q == 1) ? cp : (q == 2) ? -sp : -cp;
    c = (q == 0) ? cp : (q == 1) ? -sp : (q == 2) ? -cp : sp;
}

namespace pg8 {
constexpr int BM = 256, BK = 64, HALF = 128, HTB = HALF * BK * 2, STAGE_BYTES = 8 * HTB, NXCD = 8, WGM = 8;
__host__ __device__ __forceinline__ int lds_byte(int r, int c) { const int st = (r >> 4) * 2 + (c >> 5), rr = r & 15, cc = c & 31, ob = rr * 64 + cc * 2; return st * 1024 + (ob ^ (((ob >> 9) & 1) << 5)); }
__host__ __device__ __forceinline__ void stage_rc(int b, int& R, int& C) { const int st = b / 1024, sb = b % 1024, swz = sb ^ (((sb >> 9) & 1) << 5); R = (st >> 1) * 16 + swz / 64; C = (st & 1) * 32 + (swz % 64) / 2; }
__host__ __device__ __forceinline__ int perm32(int rho) { const int n = rho >> 4, i = rho & 15; return 8 * (i >> 2) + 4 * n + (i & 3); }
struct Unit { int pm, pn; };
struct Gemm { const bf16_t* A; const bf16_t* Bt; int M, N, K, lda, ldb, ahead; const bf16_t* A2; const bf16_t* Bt2; int K2; int pairmode; };
struct StaticOrder {
    int nM, nN, nwg, G, c;
    __device__ void init(int M, int N, int G_, int c_) { nM = M / BM; nN = N / BM; nwg = nM * nN; G = G_; c = c_; }
    __device__ bool next(int i, Unit& u) const {
        const long L = (long)i * G + c; if (L >= nwg) return false;
        int wgid = (int)L; { const int q = nwg / NXCD, r = nwg % NXCD, xcd = wgid % NXCD, off = wgid / NXCD; wgid = (xcd < r ? xcd * (q + 1) : r * (q + 1) + (xcd - r) * q) + off; }
        const int nig = WGM * nN, gid = wgid / nig, fm = gid * WGM, gsz = (nM - fm) < WGM ? (nM - fm) : WGM;
        u.pm = fm + ((wgid % nig) % gsz); u.pn = (wgid % nig) / gsz; return true;
    }
};

template <class Epi>
__device__ __forceinline__ void gemm_phase(LAS unsigned char* lds, const Gemm g, const Epi& E) {
    StaticOrder S; S.init(g.M, g.N, (int)gridDim.x, (int)blockIdx.x);
    const int tid = opaque_tid(), wid = __builtin_amdgcn_readfirstlane(tid >> 6), lane = tid & 63, wr = wid >> 2, wc = wid & 3, fr = lane & 15, fq = lane >> 4;
    const int K = g.K; int nt = K / BK; int seg = 0;
    unsigned voffA[2], voffB[2];
#pragma unroll
    for (int i = 0; i < 2; ++i) { int R, C; stage_rc(tid * 16 + i * 8192, R, C); const int Rb = Epi::PERM ? ((R & ~31) + perm32(R & 31)) : R;
        voffA[i] = (unsigned)(R * g.lda + C) * 2u; voffB[i] = (unsigned)(Rb * g.ldb + C) * 2u; }
    const size_t kstep = (size_t)(BK * 2);
    const size_t hstepA = (size_t)HALF * g.lda * 2, hstepB = (size_t)HALF * g.ldb * 2;
    const size_t tstepA = 2 * hstepA, tstepB = 2 * hstepB;
    const unsigned ldsw = (unsigned)wid * 1024u;
    const int aoff = lds_byte(wr * 64 + fr, fq * 8), boff = lds_byte(wc * 32 + fr, fq * 8);
#define PG8_SA(b, h) (((b) * 2 + (h)) * HTB)
#define PG8_SB(b, h) ((4 + (b) * 2 + (h)) * HTB)
#define PG8_STAGE(bufoff, gbase, voff) do { _Pragma("unroll") for (int _i = 0; _i < 2; ++_i) \
        __builtin_amdgcn_global_load_lds((const unsigned*)((const char*)(gbase) + (voff)[_i]), (LAS unsigned*)(lds + (bufoff) + ldsw + _i * 8192), 16, 0, 0); } while (0)
#define PG8_LDA(dst, b, h) do { _Pragma("unroll") for (int m = 0; m < 4; ++m) _Pragma("unroll") for (int k = 0; k < 2; ++k) dst[m][k] = *(const LAS bf16x8*)(lds + PG8_SA(b, h) + aoff + m * 2048 + k * 1024); } while (0)
#define PG8_LDB(dst, b, h) do { _Pragma("unroll") for (int n = 0; n < 2; ++n) _Pragma("unroll") for (int k = 0; k < 2; ++k) dst[n][k] = *(const LAS bf16x8*)(lds + PG8_SB(b, h) + boff + n * 2048 + k * 1024); } while (0)
#define PG8_MMA(ai, bj, At, Bt) do { __builtin_amdgcn_s_setprio(1); _Pragma("unroll") for (int m = 0; m < 4; ++m) _Pragma("unroll") for (int n = 0; n < 2; ++n) _Pragma("unroll") for (int k = 0; k < 2; ++k) \
        acc[ai][bj][m][n] = __builtin_amdgcn_mfma_f32_16x16x32_bf16(Bt[n][k], At[m][k], acc[ai][bj][m][n], 0, 0, 0); __builtin_amdgcn_s_setprio(0); } while (0)
#define PG8_WAIT_V(n) asm volatile("s_waitcnt vmcnt(" #n ")" ::: "memory")
#define PG8_WAIT_L(n) asm volatile("s_waitcnt lgkmcnt(" #n ")" ::: "memory")
#define PG8_BAR __builtin_amdgcn_s_barrier()
#define PG8_SCHED __builtin_amdgcn_sched_barrier(0)
    auto nextu = [&](int i, Unit& u) -> bool { if (g.pairmode) { if (i >= 2) return false; u.pm = (int)blockIdx.x >> 2; u.pn = ((int)blockIdx.x & 3) + 4 * i; return true; } return S.next(i, u); };
    Unit cur, nxt; int ui = 0;
    if (!nextu(0, cur)) return;
    f32x4 acc[2][2][4][2];
#pragma unroll
    for (int a = 0; a < 2; ++a)
#pragma unroll
        for (int b = 0; b < 2; ++b)
#pragma unroll
            for (int m = 0; m < 4; ++m)
#pragma unroll
                for (int n = 0; n < 2; ++n) acc[a][b][m][n] = (f32x4){0.f, 0.f, 0.f, 0.f};
    bf16x8 At[4][2], B0[2][2], B1[2][2];
    const char* cA = (const char*)g.A + (size_t)cur.pm * tstepA + (size_t)((cur.pn & 3) * g.ahead) * 2; const char* cB = (const char*)g.Bt + (size_t)cur.pn * tstepB;
    PG8_STAGE(PG8_SB(0, 0), cB, voffB); PG8_STAGE(PG8_SA(0, 0), cA, voffA); PG8_STAGE(PG8_SB(0, 1), cB + hstepB, voffB); PG8_STAGE(PG8_SA(0, 1), cA + hstepA, voffA);
    if (wr == 1) PG8_BAR;
    PG8_WAIT_V(4); PG8_BAR;
    PG8_STAGE(PG8_SB(1, 0), cB + kstep, voffB); PG8_STAGE(PG8_SA(1, 0), cA + kstep, voffA); PG8_STAGE(PG8_SB(1, 1), cB + hstepB + kstep, voffB);
    PG8_WAIT_V(6); PG8_BAR;
    for (;;) {
        bool has_next; const char* nA; const char* nB;
        if (Epi::DUAL && seg == 0) { has_next = true; nxt = cur; nA = (const char*)g.A2 + (size_t)cur.pm * tstepA; nB = (const char*)g.Bt2 + (size_t)cur.pn * tstepB; }
        else { has_next = nextu(ui + 1, nxt);
            nA = has_next ? (const char*)g.A + (size_t)nxt.pm * tstepA + (size_t)((nxt.pn & 3) * g.ahead) * 2 : cA; nB = has_next ? (const char*)g.Bt + (size_t)nxt.pn * tstepB : cB; }
        for (int t = 0; t < nt; t += 2) {
            const bool last = (t == nt - 2);
            const char* a1 = cA + (size_t)(t + 1) * kstep;
            const char* a2 = last ? nA : cA + (size_t)(t + 2) * kstep; const char* b2 = last ? nB : cB + (size_t)(t + 2) * kstep;
            const char* a3 = a2 + kstep; const char* b3 = b2 + kstep;
            PG8_LDB(B0, 0, 0); PG8_SCHED; PG8_LDA(At, 0, 0); PG8_STAGE(PG8_SA(1, 1), a1 + hstepA, voffA);
            PG8_WAIT_L(8); PG8_BAR; PG8_WAIT_L(0); PG8_MMA(0, 0, At, B0); PG8_BAR; PG8_SCHED;
            PG8_LDB(B1, 0, 1); PG8_STAGE(PG8_SB(0, 0), b2, voffB);
            PG8_BAR; PG8_WAIT_L(0); PG8_MMA(0, 1, At, B1); PG8_BAR;
            PG8_LDA(At, 0, 1); PG8_STAGE(PG8_SA(0, 0), a2, voffA);
            PG8_BAR; PG8_WAIT_L(0); PG8_MMA(1, 0, At, B0); PG8_BAR; PG8_SCHED;
            PG8_STAGE(PG8_SB(0, 1), b2 + hstepB, voffB);
            PG8_WAIT_V(6); PG8_BAR; PG8_MMA(1, 1, At, B1); PG8_BAR;
            PG8_LDB(B0, 1, 0); PG8_SCHED; PG8_LDA(At, 1, 0); PG8_STAGE(PG8_SA(0, 1), a2 + hstepA, voffA);
            PG8_WAIT_L(8); PG8_BAR; PG8_WAIT_L(0); PG8_MMA(0, 0, At, B0); PG8_BAR; PG8_SCHED;
            PG8_LDB(B1, 1, 1); PG8_STAGE(PG8_SB(1, 0), b3, voffB);
            PG8_BAR; PG8_WAIT_L(0); PG8_MMA(0, 1, At, B1); PG8_BAR;
            PG8_LDA(At, 1, 1); PG8_STAGE(PG8_SA(1, 0), a3, voffA);
            PG8_BAR; PG8_WAIT_L(0); PG8_MMA(1, 0, At, B0); PG8_BAR; PG8_SCHED;
            PG8_STAGE(PG8_SB(1, 1), b3 + hstepB, voffB);
            PG8_WAIT_V(6); PG8_BAR; PG8_MMA(1, 1, At, B1); PG8_BAR;
        }
        if constexpr (Epi::DUAL) { if (seg == 0) { E.mid(acc, cur, wr, wc, fr, fq); seg = 1; cA = nA; cB = nB; nt = g.K2 / BK; continue; } }
        E(acc, cur, wr, wc, fr, fq);
        if (Epi::DUAL) { seg = 0; nt = K / BK; }
        if (!has_next) break;
#pragma unroll
        for (int a = 0; a < 2; ++a)
#pragma unroll
            for (int b = 0; b < 2; ++b)
#pragma unroll
                for (int m = 0; m < 4; ++m)
#pragma unroll
                    for (int n = 0; n < 2; ++n) acc[a][b][m][n] = (f32x4){0.f, 0.f, 0.f, 0.f};
        cur = nxt; cA = nA; cB = nB; ++ui;
    }
    PG8_WAIT_V(0);
    if (wr == 0) PG8_BAR;
    PG8_BAR;
#undef PG8_SA
#undef PG8_SB
#undef PG8_STAGE
#undef PG8_LDA
#undef PG8_LDB
#undef PG8_MMA
#undef PG8_WAIT_V
#undef PG8_WAIT_L
#undef PG8_BAR
#undef PG8_SCHED
}

template <int ACT> struct EpiGated {
    static constexpr bool DUAL = false;
    static constexpr bool PERM = true;
    bf16_t* O; int ldo;
    __device__ __forceinline__ void operator()(const f32x4 (&acc)[2][2][4][2], const Unit& u, int wr, int wc, int fr, int fq) const {
        const int row0 = u.pm * BM + wr * 64 + fr, col0 = u.pn * 128 + wc * 32 + 8 * fq;
#pragma unroll
        for (int ai = 0; ai < 2; ++ai)
#pragma unroll
            for (int m = 0; m < 4; ++m) {
                bf16_t* rowp = O + (size_t)(row0 + ai * HALF + m * 16) * ldo + col0;
                float r[8];
#pragma unroll
                for (int n = 0; n < 2; ++n)
#pragma unroll
                    for (int j = 0; j < 4; ++j) { const float a0 = acc[ai][0][m][n][j], a1 = acc[ai][1][m][n][j]; r[n * 4 + j] = ACT == 0 ? siluf_(a0) * a1 : a0 * sigmoidf_(a1); }
                u32x4 o; o.x = cvt_pk_bf16(r[0], r[1]); o.y = cvt_pk_bf16(r[2], r[3]); o.z = cvt_pk_bf16(r[4], r[5]); o.w = cvt_pk_bf16(r[6], r[7]);
                *(u32x4*)rowp = o;
            }
    }
};
struct EpiResid {
    static constexpr bool DUAL = false;
    static constexpr bool PERM = false;
    const float* xin; float* xout; float scale;
    __device__ __forceinline__ void operator()(const f32x4 (&acc)[2][2][4][2], const Unit& u, int wr, int wc, int fr, int fq) const {
        const int row0 = u.pm * BM + wr * 64 + fr, col0 = u.pn * BM + wc * 32 + 4 * fq;
#pragma unroll
        for (int ai = 0; ai < 2; ++ai) {
            f32x4 xv[4][2][2];
#pragma unroll
            for (int m = 0; m < 4; ++m) { const size_t ro = (size_t)(row0 + ai * HALF + m * 16) * DM + col0;
#pragma unroll
                for (int bj = 0; bj < 2; ++bj)
#pragma unroll
                    for (int n = 0; n < 2; ++n) xv[m][bj][n] = *(const f32x4*)(xin + ro + bj * HALF + n * 16); }
            asm volatile("" ::: "memory");
#pragma unroll
            for (int m = 0; m < 4; ++m) { const size_t ro = (size_t)(row0 + ai * HALF + m * 16) * DM + col0;
#pragma unroll
                for (int bj = 0; bj < 2; ++bj)
#pragma unroll
                    for (int n = 0; n < 2; ++n) *(f32x4*)(xout + ro + bj * HALF + n * 16) = xv[m][bj][n] + scale * acc[ai][bj][m][n]; }
            asm volatile("" ::: "memory");
        }
    }
};
struct EpiBf16 {
    static constexpr bool DUAL = false;
    static constexpr bool PERM = true;
    bf16_t* O; bf16_t* O2; int ldo, split; float scale1;
    __device__ __forceinline__ void operator()(const f32x4 (&acc)[2][2][4][2], const Unit& u, int wr, int wc, int fr, int fq) const {
        const int row0 = u.pm * BM + wr * 64 + fr; int pn = u.pn; bf16_t* base = O; float sc = scale1;
        if (pn >= split) { pn -= split; base = O2; sc = 1.0f; }
        const int col0 = pn * BM + wc * 32 + 8 * fq;
#pragma unroll
        for (int ai = 0; ai < 2; ++ai)
#pragma unroll
            for (int m = 0; m < 4; ++m) { bf16_t* rowp = base + (size_t)(row0 + ai * HALF + m * 16) * ldo + col0;
#pragma unroll
                for (int bj = 0; bj < 2; ++bj) { const f32x4 v0 = acc[ai][bj][m][0] * sc, v1 = acc[ai][bj][m][1] * sc;
                    u32x4 o; o.x = cvt_pk_bf16(v0[0], v0[1]); o.y = cvt_pk_bf16(v0[2], v0[3]); o.z = cvt_pk_bf16(v1[0], v1[1]); o.w = cvt_pk_bf16(v1[2], v1[3]);
                    *(u32x4*)(rowp + bj * HALF) = o; } }
    }
};
template <int SECOND> struct EpiMerge {
    static constexpr bool DUAL = false;
    static constexpr bool PERM = true;
    const bf16_t* gate; float* mixacc; bf16_t* mix;
    __device__ __forceinline__ void operator()(const f32x4 (&acc)[2][2][4][2], const Unit& u, int wr, int wc, int fr, int fq) const {
        const int row0 = u.pm * BM + wr * 64 + fr, col0 = u.pn * BM + wc * 32 + 8 * fq;
#pragma unroll
        for (int ai = 0; ai < 2; ++ai)
#pragma unroll
            for (int mp = 0; mp < 2; ++mp) {
                u32x4 gv[2][2]; f32x4 pv[2][2][2];
#pragma unroll
                for (int mi = 0; mi < 2; ++mi)
#pragma unroll
                    for (int bj = 0; bj < 2; ++bj) { const size_t row = (size_t)(row0 + ai * HALF + (mp * 2 + mi) * 16); const int col = col0 + bj * HALF;
                        gv[mi][bj] = *(const u32x4*)(gate + row * NPROJ + col);
                        if (SECOND == 1) { pv[mi][bj][0] = *(const f32x4*)(mixacc + row * DM + col); pv[mi][bj][1] = *(const f32x4*)(mixacc + row * DM + col + 4); } }
                asm volatile("" ::: "memory");
#pragma unroll
                for (int mi = 0; mi < 2; ++mi)
#pragma unroll
                    for (int bj = 0; bj < 2; ++bj) { const int m = mp * 2 + mi; const size_t row = (size_t)(row0 + ai * HALF + m * 16); const int col = col0 + bj * HALF; const u32x4 g4 = gv[mi][bj];
                        float r[8];
                        r[0] = sigmoidf_(bflo(g4.x)) * acc[ai][bj][m][0][0]; r[1] = sigmoidf_(bfhi(g4.x)) * acc[ai][bj][m][0][1];
                        r[2] = sigmoidf_(bflo(g4.y)) * acc[ai][bj][m][0][2]; r[3] = sigmoidf_(bfhi(g4.y)) * acc[ai][bj][m][0][3];
                        r[4] = sigmoidf_(bflo(g4.z)) * acc[ai][bj][m][1][0]; r[5] = sigmoidf_(bfhi(g4.z)) * acc[ai][bj][m][1][1];
                        r[6] = sigmoidf_(bflo(g4.w)) * acc[ai][bj][m][1][2]; r[7] = sigmoidf_(bfhi(g4.w)) * acc[ai][bj][m][1][3];
                        if (SECOND == 0) { float* mp_ = mixacc + row * DM + col; *(f32x4*)mp_ = (f32x4){r[0], r[1], r[2], r[3]}; *(f32x4*)(mp_ + 4) = (f32x4){r[4], r[5], r[6], r[7]}; }
                        else { const f32x4 p0 = pv[mi][bj][0], p1 = pv[mi][bj][1];
                            u32x4 o; o.x = cvt_pk_bf16(r[0] + p0[0], r[1] + p0[1]); o.y = cvt_pk_bf16(r[2] + p0[2], r[3] + p0[3]); o.z = cvt_pk_bf16(r[4] + p1[0], r[5] + p1[1]); o.w = cvt_pk_bf16(r[6] + p1[2], r[7] + p1[3]);
                            *(u32x4*)(mix + row * DM + col) = o; } }
                asm volatile("" ::: "memory");
            }
    }
};
struct EpiMergeDual {
    static constexpr bool PERM = true, DUAL = true;
    const bf16_t* gate1; const bf16_t* gate2; bf16_t* mix;
    static __device__ __forceinline__ float em(float g) { return fminf(__expf(-g), 1e30f); }
    __device__ __forceinline__ void mid(f32x4 (&acc)[2][2][4][2], const Unit& u, int wr, int wc, int fr, int fq) const {
        const int row0 = u.pm * BM + wr * 64 + fr, col0 = u.pn * BM + wc * 32 + 8 * fq;
#pragma unroll
        for (int ai = 0; ai < 2; ++ai)
#pragma unroll
            for (int mp = 0; mp < 2; ++mp) {
                u32x4 g1v[2][2], g2v[2][2];
#pragma unroll
                for (int mi = 0; mi < 2; ++mi)
#pragma unroll
                    for (int bj = 0; bj < 2; ++bj) { const size_t row = (size_t)(row0 + ai * HALF + (mp * 2 + mi) * 16); const int col = col0 + bj * HALF;
                        g1v[mi][bj] = *(const u32x4*)(gate1 + row * NPROJ + col); g2v[mi][bj] = *(const u32x4*)(gate2 + row * NPROJ + col); }
#pragma unroll
                for (int mi = 0; mi < 2; ++mi)
#pragma unroll
                    for (int bj = 0; bj < 2; ++bj) { const int m = mp * 2 + mi; const u32x4 a = g1v[mi][bj], b = g2v[mi][bj];
                        const float ga[8] = {bflo(a.x), bfhi(a.x), bflo(a.y), bfhi(a.y), bflo(a.z), bfhi(a.z), bflo(a.w), bfhi(a.w)};
                        const float gb[8] = {bflo(b.x), bfhi(b.x), bflo(b.y), bfhi(b.y), bflo(b.z), bfhi(b.z), bflo(b.w), bfhi(b.w)};
#pragma unroll
                        for (int j = 0; j < 8; ++j) acc[ai][bj][m][j >> 2][j & 3] *= (1.0f + em(gb[j])) * __builtin_amdgcn_rcpf(1.0f + em(ga[j])); }
            }
    }
    __device__ __forceinline__ void operator()(const f32x4 (&acc)[2][2][4][2], const Unit& u, int wr, int wc, int fr, int fq) const {
        const int row0 = u.pm * BM + wr * 64 + fr, col0 = u.pn * BM + wc * 32 + 8 * fq;
#pragma unroll
        for (int ai = 0; ai < 2; ++ai)
#pragma unroll
            for (int mp = 0; mp < 2; ++mp) {
                u32x4 g2v[2][2];
#pragma unroll
                for (int mi = 0; mi < 2; ++mi)
#pragma unroll
                    for (int bj = 0; bj < 2; ++bj) { const size_t row = (size_t)(row0 + ai * HALF + (mp * 2 + mi) * 16); const int col = col0 + bj * HALF;
                        g2v[mi][bj] = *(const u32x4*)(gate2 + row * NPROJ + col); }
#pragma unroll
                for (int mi = 0; mi < 2; ++mi)
#pragma unroll
                    for (int bj = 0; bj < 2; ++bj) { const int m = mp * 2 + mi; const size_t row = (size_t)(row0 + ai * HALF + m * 16); const int col = col0 + bj * HALF; const u32x4 b = g2v[mi][bj];
                        const float gb[8] = {bflo(b.x), bfhi(b.x), bflo(b.y), bfhi(b.y), bflo(b.z), bfhi(b.z), bflo(b.w), bfhi(b.w)};
                        float r[8];
#pragma unroll
                        for (int j = 0; j < 8; ++j) r[j] = acc[ai][bj][m][j >> 2][j & 3] * __builtin_amdgcn_rcpf(1.0f + em(gb[j]));
                        u32x4 o; o.x = cvt_pk_bf16(r[0], r[1]); o.y = cvt_pk_bf16(r[2], r[3]); o.z = cvt_pk_bf16(r[4], r[5]); o.w = cvt_pk_bf16(r[6], r[7]);
                        *(u32x4*)(mix + row * DM + col) = o; }
            }
    }
};
}

__device__ __forceinline__ void tr_job(const float* W, int K, int ld, int c0, int NC, bf16_t* WT, int rowbase, int rs, LAS float* scr, int gw, int nw, int lane, int ldw = 0) {
    if (ldw == 0) ldw = K;
    const int nblk = NC / 32, nitems = (K / 64) * nblk;
    for (int item = gw; item < nitems; item += nw) {
        const int kb = item / nblk, nb = item % nblk, k0 = 64 * kb, n0 = 32 * nb;
        float wv[32];
#pragma unroll
        for (int i = 0; i < 32; ++i) { const int kk = 2 * i + (lane >> 5); wv[i] = W[(size_t)(k0 + kk) * ld + c0 + n0 + (lane & 31)]; }
#pragma unroll
        for (int i = 0; i < 32; ++i) { const int kk = 2 * i + (lane >> 5); scr[kk * 33 + (lane & 31)] = wv[i]; }
        WAVE_LDS_SYNC();
        const int c = lane & 7;
#pragma unroll
        for (int j = 0; j < 4; ++j) { const int n = (lane >> 3) + 8 * j; const LAS float* s = scr + (8 * c) * 33 + n;
            u32x4 o; o.x = cvt_pk_bf16(s[0 * 33], s[1 * 33]); o.y = cvt_pk_bf16(s[2 * 33], s[3 * 33]); o.z = cvt_pk_bf16(s[4 * 33], s[5 * 33]); o.w = cvt_pk_bf16(s[6 * 33], s[7 * 33]);
            const int nn = n0 + n, drow = rowbase + (nn >> 7) * rs + (nn & 127);
            *(u32x4*)(WT + (size_t)drow * ldw + k0 + 8 * c) = o; }
        WAVE_LDS_SYNC();
    }
}
__device__ __forceinline__ void convert_phase(const KP& p, int l, LAS unsigned char* lds) {
    const int tid = opaque_tid(); const int wid = tid >> 6, lane = tid & 63, nw = gridDim.x * 8;
    int gw = blockIdx.x * 8 + wid;
    LAS float* scr = (LAS float*)(lds + wid * 8448);
    unsigned char* ws = p.ws;
    const size_t ffw = (size_t)l * 1024 * 2816;
#define ROT(n) gw = (gw + (n)) % nw
    tr_job(p.in[2] + ffw, 1024, 2816, 0, 2816, (bf16_t*)(ws + W_GU1), 0, 256, scr, gw, nw, lane);
    tr_job(p.in[3] + ffw, 1024, 2816, 0, 2816, (bf16_t*)(ws + W_GU1), 128, 256, scr, gw, nw, lane);
    tr_job(p.in[4] + ffw, 2816, 1024, 0, 1024, (bf16_t*)(ws + W_D1), 0, 128, scr, gw, nw, lane);
    tr_job(p.in[6] + (size_t)l * 1024 * INC, 1024, INC, 0, 3584, (bf16_t*)(ws + W_IN), 0, 128, scr, gw, nw, lane);
    tr_job(p.in[6] + (size_t)l * 1024 * INC, 1024, INC, 3592, 2048, (bf16_t*)(ws + W_IN), 3584, 128, scr, gw, nw, lane);
    tr_job(p.in[28] + ffw, 1024, 2816, 0, 2816, (bf16_t*)(ws + W_GU2), 0, 256, scr, gw, nw, lane);
    tr_job(p.in[29] + ffw, 1024, 2816, 0, 2816, (bf16_t*)(ws + W_GU2), 128, 256, scr, gw, nw, lane);
    tr_job(p.in[30] + ffw, 2816, 1024, 0, 1024, (bf16_t*)(ws + W_D2), 0, 128, scr, gw, nw, lane);
    ROT(768);
    tr_job(p.in[16] + (size_t)l * 512 * 512, 512, 512, 0, 512, (bf16_t*)(ws + W_GLU), 0, 256, scr, gw, nw, lane);
    ROT(128);
    tr_job(p.in[17] + (size_t)l * 512 * 512, 512, 512, 0, 512, (bf16_t*)(ws + W_GLU), 128, 256, scr, gw, nw, lane);
    ROT(128);
    tr_job(p.in[24] + (size_t)l * 512 * 1024, 512, 1024, 0, 1024, (bf16_t*)(ws + W_BS5), 0, 128, scr, gw, nw, lane, 1024);
    ROT(256);
    tr_job(p.in[25] + (size_t)l * 1024 * 1024, 1024, 1024, 0, 1024, (bf16_t*)(ws + W_BML), 0, 128, scr, gw, nw, lane);
    ROT(512);
    tr_job(p.in[26] + (size_t)l * 1024 * 1024, 1024, 1024, 0, 1024, (bf16_t*)(ws + W_OUT), 0, 128, scr, gw, nw, lane);
    ROT(512);
    for (int h = 0; h < 4; ++h) {
        tr_job(p.in[20] + ((size_t)l * 4 + h) * 65536, 256, 256, 0, 256, (bf16_t*)(ws + W_QK), h * 256, 128, scr, gw, nw, lane);
        ROT(32);
        tr_job(p.in[21] + ((size_t)l * 4 + h) * 65536, 256, 256, 0, 256, (bf16_t*)(ws + W_QK), 1024 + h * 256, 128, scr, gw, nw, lane);
        ROT(32);
    }
#undef ROT
}

template <bool WITH_IF>
__device__ __forceinline__ void rmsnorm_phase(const float* x, const float* gain, bf16_t* xn, const float* win_l, const float* bif, float* ifbuf, LAS unsigned char* lds) {
    const int tid = opaque_tid(); const int wid = tid >> 6, lane = tid & 63;
    LAS float* ifw = (LAS float*)lds;
    if (WITH_IF) {
        for (int k = tid; k < 1024; k += 512) { const f32x4 a = *(const f32x4*)(win_l + (size_t)k * INC + 3584), b = *(const f32x4*)(win_l + (size_t)k * INC + 3588);
            *(LAS f32x4*)(ifw + k * 8) = a; *(LAS f32x4*)(ifw + k * 8 + 4) = b; }
        __syncthreads();
    }
    f32x4 gv[4];
#pragma unroll
    for (int i = 0; i < 4; ++i) gv[i] = *(const f32x4*)(gain + 4 * (lane + 64 * i));
    const int nw = gridDim.x * 8;
    constexpr int RPT = WITH_IF ? 4 : 8;
    for (int row0 = blockIdx.x * 8 + wid; row0 < MTOK; row0 += RPT * nw) {
        f32x4 v[RPT][4];
#pragma unroll
        for (int q = 0; q < RPT; ++q) { const int row = (row0 + q * nw < MTOK) ? row0 + q * nw : row0;
#pragma unroll
            for (int i = 0; i < 4; ++i) v[q][i] = *(const f32x4*)(x + (size_t)row * DM + 4 * (lane + 64 * i)); }
        asm volatile("" ::: "memory");
#pragma unroll
        for (int q = 0; q < RPT; ++q) { const int row = row0 + q * nw;
            float ss = 0.f;
#pragma unroll
            for (int i = 0; i < 4; ++i) ss += (v[q][i].x * v[q][i].x + v[q][i].y * v[q][i].y) + (v[q][i].z * v[q][i].z + v[q][i].w * v[q][i].w);
            ss = wave_sum(ss);
            const float r = rsqrtf(ss * (1.0f / DM) + EPS);
            float ga[8];
            if (WITH_IF) {
#pragma unroll
                for (int j = 0; j < 8; ++j) ga[j] = 0.f;
            }
            if (row < MTOK) {
#pragma unroll
                for (int i = 0; i < 4; ++i) { const f32x4 y = v[q][i] * r * gv[i];
                    u32x2 o; o.x = cvt_pk_bf16(y.x, y.y); o.y = cvt_pk_bf16(y.z, y.w);
                    *(u32x2*)(xn + (size_t)row * DM + 4 * (lane + 64 * i)) = o;
                    if (WITH_IF) {
#pragma unroll
                        for (int e = 0; e < 4; ++e) { const int k = 4 * (lane + 64 * i) + e; const f32x4 a = *(LAS f32x4*)(ifw + k * 8), b = *(LAS f32x4*)(ifw + k * 8 + 4); const float xv = y[e];
                            ga[0] += xv * a.x; ga[1] += xv * a.y; ga[2] += xv * a.z; ga[3] += xv * a.w; ga[4] += xv * b.x; ga[5] += xv * b.y; ga[6] += xv * b.z; ga[7] += xv * b.w; }
                        asm volatile("" ::: "memory");
                    }
                }
                if (WITH_IF) {
#pragma unroll
                    for (int j = 0; j < 8; ++j) ga[j] = wave_sum(ga[j]);
                    if (lane == 0) { *(f32x4*)(ifbuf + (size_t)row * 8) = (f32x4){ga[0] + bif[0], ga[1] + bif[1], ga[2] + bif[2], ga[3] + bif[3]};
                        *(f32x4*)(ifbuf + (size_t)row * 8 + 4) = (f32x4){ga[4] + bif[4], ga[5] + bif[5], ga[6] + bif[6], ga[7] + bif[7]}; }
                }
            }
        }
    }
}
__device__ __forceinline__ void final_norm_phase(float* x, const float* gain) {
    const int tid = opaque_tid(); const int wid = tid >> 6, lane = tid & 63;
    f32x4 gv[4];
#pragma unroll
    for (int i = 0; i < 4; ++i) gv[i] = *(const f32x4*)(gain + 4 * (lane + 64 * i));
    for (int row = blockIdx.x * 8 + wid; row < MTOK; row += gridDim.x * 8) {
        float* xr = x + (size_t)row * DM;
        f32x4 v[4]; float ss = 0.f;
#pragma unroll
        for (int i = 0; i < 4; ++i) { v[i] = *(const f32x4*)(xr + 4 * (lane + 64 * i)); ss += (v[i].x * v[i].x + v[i].y * v[i].y) + (v[i].z * v[i].z + v[i].w * v[i].w); }
        ss = wave_sum(ss);
        const float r = rsqrtf(ss * (1.0f / DM) + EPS);
#pragma unroll
        for (int i = 0; i < 4; ++i) *(f32x4*)(xr + 4 * (lane + 64 * i)) = v[i] * r * gv[i];
    }
}

__device__ __forceinline__ void conv_phase(const KP& p, int l) {
    const bf16_t* proj = (const bf16_t*)(p.ws + O_BIG); bf16_t* xc = (bf16_t*)(p.ws + O_XC);
    const int gt = blockIdx.x * 512 + opaque_tid(), c8 = gt & 127;
    const float* cw = p.in[18] + (size_t)l * 4 * 1024 + c8 * 8; const float* cb = p.in[19] + (size_t)l * 1024 + c8 * 8;
    float w[4][8], bias[8];
#pragma unroll
    for (int j = 0; j < 4; ++j) { const f32x4 a = *(const f32x4*)(cw + j * 1024), b = *(const f32x4*)(cw + j * 1024 + 4); w[j][0] = a.x; w[j][1] = a.y; w[j][2] = a.z; w[j][3] = a.w; w[j][4] = b.x; w[j][5] = b.y; w[j][6] = b.z; w[j][7] = b.w; }
    { const f32x4 a = *(const f32x4*)cb, b = *(const f32x4*)(cb + 4); bias[0] = a.x; bias[1] = a.y; bias[2] = a.z; bias[3] = a.w; bias[4] = b.x; bias[5] = b.y; bias[6] = b.z; bias[7] = b.w; }
    const int nthr = gridDim.x * 512;
    for (int idx0 = gt; idx0 < MTOK * 128; idx0 += 4 * nthr) {
        u32x4 v[4][4];
#pragma unroll
        for (int q = 0; q < 4; ++q) { const int idx = idx0 + q * nthr; const int t = idx >> 7, pos = t & (SEQ - 1);
#pragma unroll
            for (int j = 0; j < 4; ++j) { v[q][j] = (u32x4){0u, 0u, 0u, 0u}; if (idx < MTOK * 128 && pos - 3 + j >= 0) v[q][j] = *(const u32x4*)(proj + (size_t)(t - 3 + j) * NPROJ + 512 + c8 * 8); } }
        asm volatile("" ::: "memory");
#pragma unroll
        for (int q = 0; q < 4; ++q) { const int idx = idx0 + q * nthr; const int t = idx >> 7;
            float y[8];
#pragma unroll
            for (int e = 0; e < 8; ++e) y[e] = bias[e];
#pragma unroll
            for (int j = 0; j < 4; ++j) { const u32x4 vv = v[q][j];
                y[0] += w[j][0] * bflo(vv.x); y[1] += w[j][1] * bfhi(vv.x); y[2] += w[j][2] * bflo(vv.y); y[3] += w[j][3] * bfhi(vv.y);
                y[4] += w[j][4] * bflo(vv.z); y[5] += w[j][5] * bfhi(vv.z); y[6] += w[j][6] * bflo(vv.w); y[7] += w[j][7] * bfhi(vv.w); }
            u32x4 o; o.x = cvt_pk_bf16(siluf_(y[0]), siluf_(y[1])); o.y = cvt_pk_bf16(siluf_(y[2]), siluf_(y[3])); o.z = cvt_pk_bf16(siluf_(y[4]), siluf_(y[5])); o.w = cvt_pk_bf16(siluf_(y[6]), siluf_(y[7]));
            if (idx < MTOK * 128) *(u32x4*)(xc + (size_t)t * DM + c8 * 8) = o; }
    }
}

__device__ __forceinline__ void conv_slice(const KP& p, int l, int pm, int head) {
    const bf16_t* proj = (const bf16_t*)(p.ws + O_BIG); bf16_t* xc = (bf16_t*)(p.ws + O_XC);
    const int tid = opaque_tid(); const int c8 = head * 32 + (tid & 31), rsub = tid >> 5;
    const float* cw = p.in[18] + (size_t)l * 4 * 1024 + c8 * 8; const float* cb = p.in[19] + (size_t)l * 1024 + c8 * 8;
    float w[4][8], bias[8];
#pragma unroll
    for (int j = 0; j < 4; ++j) { const f32x4 a = *(const f32x4*)(cw + j * 1024), b = *(const f32x4*)(cw + j * 1024 + 4); w[j][0] = a.x; w[j][1] = a.y; w[j][2] = a.z; w[j][3] = a.w; w[j][4] = b.x; w[j][5] = b.y; w[j][6] = b.z; w[j][7] = b.w; }
    { const f32x4 a = *(const f32x4*)cb, b = *(const f32x4*)(cb + 4); bias[0] = a.x; bias[1] = a.y; bias[2] = a.z; bias[3] = a.w; bias[4] = b.x; bias[5] = b.y; bias[6] = b.z; bias[7] = b.w; }
    for (int j0 = 0; j0 < 16; j0 += 4) {
        u32x4 v[4][4];
#pragma unroll
        for (int q = 0; q < 4; ++q) { const int t = pm * 256 + rsub + 16 * (j0 + q), pos = t & (SEQ - 1);
#pragma unroll
            for (int j = 0; j < 4; ++j) { v[q][j] = (u32x4){0u, 0u, 0u, 0u}; if (pos - 3 + j >= 0) v[q][j] = *(const u32x4*)(proj + (size_t)(t - 3 + j) * NPROJ + 512 + c8 * 8); } }
        asm volatile("" ::: "memory");
#pragma unroll
        for (int q = 0; q < 4; ++q) { const int t = pm * 256 + rsub + 16 * (j0 + q);
            float y[8];
#pragma unroll
            for (int e = 0; e < 8; ++e) y[e] = bias[e];
#pragma unroll
            for (int j = 0; j < 4; ++j) { const u32x4 vv = v[q][j];
                y[0] += w[j][0] * bflo(vv.x); y[1] += w[j][1] * bfhi(vv.x); y[2] += w[j][2] * bflo(vv.y); y[3] += w[j][3] * bfhi(vv.y);
                y[4] += w[j][4] * bflo(vv.z); y[5] += w[j][5] * bfhi(vv.z); y[6] += w[j][6] * bflo(vv.w); y[7] += w[j][7] * bfhi(vv.w); }
            u32x4 o; o.x = cvt_pk_bf16(siluf_(y[0]), siluf_(y[1])); o.y = cvt_pk_bf16(siluf_(y[2]), siluf_(y[3])); o.z = cvt_pk_bf16(siluf_(y[4]), siluf_(y[5])); o.w = cvt_pk_bf16(siluf_(y[6]), siluf_(y[7]));
            *(u32x4*)(xc + (size_t)t * DM + c8 * 8) = o; }
    }
}

template <bool PASSC>
__device__ __forceinline__ void s5_phase(const KP& p, int l, LAS unsigned char* lds) {
    const int tid = opaque_tid(); const int wid = tid >> 6, lane = tid & 63, fr = lane & 15, fq = lane >> 4;
    LAS float* buS = (LAS float*)(lds + wid * 12800);
    LAS unsigned char* sS = lds + wid * 12800 + 8448;
    const bf16_t* proj = (const bf16_t*)(p.ws + O_BIG); bf16_t* z = (bf16_t*)(p.ws + O_Z);
    f32x2* s5end = (f32x2*)(p.ws + O_S5END);
    for (int task = blockIdx.x * 8 + wid; task < 2048; task += gridDim.x * 8) {
        const int seq = task >> 5, c = task & 31, b = seq >> 5, g = seq & 31, n = lane, lg = l * 32 + g;
        const float dt = expf(p.in[10][lg]);
        float ar, ai;
        { const float lr = fminf(p.in[8][lg * 64 + n], -1e-4f), li = p.in[9][lg * 64 + n];
          const float mag = expf(lr * dt); float sn, cs; sincos_acc(li * dt, sn, cs); ar = mag * cs; ai = mag * sn; }
        bf16x8 bx[8];
#pragma unroll
        for (int q4 = 0; q4 < 4; ++q4) { const int n2 = q4 * 16 + fr;
            const float lr = fminf(p.in[8][lg * 64 + n2], -1e-4f), li = p.in[9][lg * 64 + n2];
            const float mag = expf(lr * dt); float sn, cs; sincos_acc(li * dt, sn, cs);
            const float a_r = mag * cs, a_i = mag * sn, den = lr * lr + li * li;
            float qr = ((a_r - 1.0f) * lr + a_i * li) / den, qi = (a_i * lr - (a_r - 1.0f) * li) / den;
            if (fq >= 2) { qr = 0.f; qi = 0.f; }
            const float* brp = p.in[11] + (size_t)(lg * 64 + n2) * 16 + (fq & 1) * 8; const float* bip = p.in[12] + (size_t)(lg * 64 + n2) * 16 + (fq & 1) * 8;
            const f32x4 br0 = *(const f32x4*)brp, br1 = *(const f32x4*)(brp + 4), bi0 = *(const f32x4*)bip, bi1 = *(const f32x4*)(bip + 4);
            const f32x4 re0 = qr * br0 - qi * bi0, re1 = qr * br1 - qi * bi1, im0 = qr * bi0 + qi * br0, im1 = qr * bi1 + qi * br1;
            u32x4 o; o.x = cvt_pk_bf16(re0.x, re0.y); o.y = cvt_pk_bf16(re0.z, re0.w); o.z = cvt_pk_bf16(re1.x, re1.y); o.w = cvt_pk_bf16(re1.z, re1.w);
            bx[q4] = __builtin_bit_cast(bf16x8, o);
            o.x = cvt_pk_bf16(im0.x, im0.y); o.y = cvt_pk_bf16(im0.z, im0.w); o.z = cvt_pk_bf16(im1.x, im1.y); o.w = cvt_pk_bf16(im1.z, im1.w);
            bx[4 + q4] = __builtin_bit_cast(bf16x8, o); }
        float sr = 0.f, si = 0.f;
        bf16x8 cm[4]; f32x4 d4 = (f32x4){0.f, 0.f, 0.f, 0.f};
        if (PASSC) {
            float xr = ar, xi = ai;
#pragma unroll
            for (int q = 0; q < 8; ++q) { const float t0 = xr * xr - xi * xi, t1 = 2.0f * xr * xi; xr = t0; xi = t1; }
            for (int c0 = 0; c0 < c; c0 += 16) {
                f32x2 ev[16];
#pragma unroll
                for (int j = 0; j < 16; ++j) { const int cc = (c0 + j < c) ? c0 + j : c - 1; ev[j] = s5end[(size_t)(seq * 32 + cc) * 64 + n]; }
#pragma unroll
                for (int j = 0; j < 16; ++j) { const bool on = c0 + j < c; const float t0 = sr * xr - si * xi + ev[j].x, t1 = sr * xi + si * xr + ev[j].y; sr = on ? t0 : sr; si = on ? t1 : si; }
            }
#pragma unroll
            for (int kb = 0; kb < 4; ++kb) { const float* src = (kb < 2 ? p.in[13] : p.in[14]) + (size_t)(lg * 16 + fr) * 64 + (kb & 1) * 32 + fq * 8;
                const f32x4 a = *(const f32x4*)src, bq = *(const f32x4*)(src + 4); const float sg = kb < 2 ? 1.0f : -1.0f;
                u32x4 o; o.x = cvt_pk_bf16(sg * a.x, sg * a.y); o.y = cvt_pk_bf16(sg * a.z, sg * a.w); o.z = cvt_pk_bf16(sg * bq.x, sg * bq.y); o.w = cvt_pk_bf16(sg * bq.z, sg * bq.w);
                cm[kb] = __builtin_bit_cast(bf16x8, o); }
            d4 = *(const f32x4*)(p.in[15] + (size_t)l * 512 + g * 16 + fq * 4);
        }
        const int tok0 = b * SEQ + c * 256;
        const bf16_t* urow0 = proj + (size_t)(tok0 + fr) * NPROJ + g * 16;
        u32x4 unext = *(const u32x4*)(urow0 + (fq & 1) * 8); u32x2 u4next = *(const u32x2*)(urow0 + fq * 4);
        for (int sub = 0; sub < 16; ++sub) {
            u32x4 uraw = unext; const u32x2 u4 = u4next;
            if (sub < 15) { const bf16_t* urow = urow0 + (size_t)(sub + 1) * 16 * NPROJ; unext = *(const u32x4*)(urow + (fq & 1) * 8); u4next = *(const u32x2*)(urow + fq * 4); }
            if (fq >= 2) uraw = (u32x4){0u, 0u, 0u, 0u};
            const bf16x8 yu = __builtin_bit_cast(bf16x8, uraw);
#pragma unroll
            for (int kb = 0; kb < 8; ++kb) { const f32x4 acc = __builtin_amdgcn_mfma_f32_16x16x32_bf16(bx[kb], yu, (f32x4){0.f, 0.f, 0.f, 0.f}, 0, 0, 0);
                *(LAS f32x4*)(buS + fr * 132 + kb * 16 + fq * 4) = acc; }
            WAVE_LDS_SYNC();
            float burv[16], buiv[16];
#pragma unroll
            for (int tt = 0; tt < 16; ++tt) { burv[tt] = buS[tt * 132 + n]; buiv[tt] = buS[tt * 132 + 64 + n]; }
#pragma unroll
            for (int tt = 0; tt < 16; ++tt) {
                const float bur = burv[tt], bui = buiv[tt];
                const float t0 = ar * sr - ai * si + bur, t1 = ar * si + ai * sr + bui; sr = t0; si = t1;
                if (PASSC) { const unsigned pk = cvt_pk_bf16(sr, si); *(LAS unsigned short*)(sS + tt * 272 + n * 2) = (unsigned short)(pk & 0xffffu); *(LAS unsigned short*)(sS + tt * 272 + 128 + n * 2) = (unsigned short)(pk >> 16); }
            }
            if (PASSC) {
                WAVE_LDS_SYNC();
                f32x4 acc = (f32x4){0.f, 0.f, 0.f, 0.f};
#pragma unroll
                for (int kb = 0; kb < 4; ++kb) { const bf16x8 yf = *(LAS bf16x8*)(sS + fr * 272 + (kb * 32 + fq * 8) * 2); acc = __builtin_amdgcn_mfma_f32_16x16x32_bf16(cm[kb], yf, acc, 0, 0, 0); }
                const f32x4 uv = (f32x4){bflo(u4.x), bfhi(u4.x), bflo(u4.y), bfhi(u4.y)};
                const f32x4 y = acc + d4 * uv;
                u32x2 o; o.x = cvt_pk_bf16(gelu_tanh(y.x), gelu_tanh(y.y)); o.y = cvt_pk_bf16(gelu_tanh(y.z), gelu_tanh(y.w));
                *(u32x2*)(z + (size_t)(tok0 + sub * 16 + fr) * 512 + g * 16 + fq * 4) = o;
            }
            WAVE_LDS_SYNC();
        }
        if (!PASSC) s5end[(size_t)(seq * 32 + c) * 64 + n] = (f32x2){sr, si};
    }
}

__device__ __forceinline__ float scan_sum128(float v, int tid, LAS float* tmp) {
    const int lane = tid & 63; float x = v;
#pragma unroll
    for (int o = 1; o < 64; o <<= 1) { const float y = __shfl_up(x, o); if (lane >= o) x += y; }
    if (tid == 63) tmp[0] = x;
    __syncthreads();
    if (tid >= 64 && tid < 128) x += tmp[0];
    return x;
}
__device__ __forceinline__ float scan_max128(float v, int tid, LAS float* tmp) {
    const int lane = tid & 63; float x = v;
#pragma unroll
    for (int o = 1; o < 64; o <<= 1) { const float y = __shfl_up(x, o); if (lane >= o) x = fmaxf(x, y); }
    if (tid == 63) tmp[1] = x;
    __syncthreads();
    if (tid >= 64 && tid < 128) x = fmaxf(x, tmp[1]);
    return x;
}
__device__ __forceinline__ bf16x8 tr_frag(LAS unsigned char* a0, int second_off) {
    const s16x4 lo = __builtin_amdgcn_ds_read_tr16_b64_v4i16((LAS s16x4*)a0);
    const s16x4 hi = __builtin_amdgcn_ds_read_tr16_b64_v4i16((LAS s16x4*)(a0 + second_off));
    return __builtin_shufflevector(lo, hi, 0, 1, 2, 3, 4, 5, 6, 7);
}
template <bool OWN> __device__ __forceinline__ void mlstm_s1_phase(const KP& p, LAS unsigned char* lds) {
    const int tid = opaque_tid(), wid = tid >> 6, lane = tid & 63, fr = lane & 15, fq = lane >> 4;
    const bf16_t* proj = (const bf16_t*)(p.ws + O_BIG); const bf16_t* kbuf = (const bf16_t*)(p.ws + O_K);
    const float* ifb = (const float*)(p.ws + O_IF); bf16_t* cst = (bf16_t*)(p.ws + O_CST);
    float* gout = (float*)(p.ws + O_G); float* mlout = (float*)(p.ws + O_MLOC); float* nloc = (float*)(p.ws + O_NLOC);
    LAS unsigned char* Ks = lds; LAS unsigned char* Vs = lds + 69632;
    LAS float* vlf = (LAS float*)(lds + VEC_OFF); LAS float* vi = vlf + 128; LAS float* vb = vlf + 256; LAS float* vdec = vlf + 384;
    const int own_pm = (int)blockIdx.x >> 2, own_bhc0 = (((own_pm >> 5) * 4 + ((int)blockIdx.x & 3)) * 64) + (own_pm & 31) * 2;
    for (int tk = OWN ? 0 : (int)blockIdx.x; tk < (OWN ? 4 : 1024); tk += OWN ? 1 : (int)gridDim.x) {
        const int task = OWN ? (((own_bhc0 + (tk >> 1)) << 1) | (tk & 1)) : tk;
        const int eh = task & 1, bhc = task >> 1, c = bhc & 63, bh = bhc >> 6, h = bh & 3, b = bh >> 2;
        const int tok0 = b * SEQ + c * 128;
        const bool newk = !OWN || eh == 0;
        u32x4 kv[8], vv[4];
        if (newk) {
#pragma unroll
            for (int it = 0; it < 8; ++it) { const int id = it * 512 + tid, s = id >> 5, ch = id & 31; kv[it] = *(const u32x4*)(kbuf + (unsigned)(tok0 + s) * DM + h * 256 + ch * 8); }
        }
#pragma unroll
        for (int it = 0; it < 4; ++it) { const int id = it * 512 + tid, s = id >> 4, ch = id & 15; vv[it] = *(const u32x4*)(proj + (unsigned)(tok0 + s) * NPROJ + 1536 + h * 256 + eh * 128 + ch * 8); }
        LAS float* tmp = vlf;
        float gg = 0.f, mloc = 0.f;
        if (newk) {
        float gi = 0.f, glf = 0.f;
        if (tid < 128) { gi = ifb[(size_t)(tok0 + tid) * 8 + h]; glf = logsigmoidf_(ifb[(size_t)(tok0 + tid) * 8 + 4 + h]); }
        const float bsum = scan_sum128(glf, tid, tmp);
        if (tid == 127) tmp[2] = bsum;
        __syncthreads();
        gg = tmp[2];
        float dec = -INFINITY;
        if (tid < 128) { dec = gg - bsum + gi; vdec[tid] = dec; }
        { float x = dec;
#pragma unroll
          for (int o = 1; o < 64; o <<= 1) x = fmaxf(x, __shfl_xor(x, o));
          if (lane == 0 && wid < 2) tmp[4 + wid] = x; }
        __syncthreads();
        mloc = fmaxf(tmp[4], tmp[5]);
        asm volatile("" ::: "memory");
#pragma unroll
        for (int it = 0; it < 8; ++it) { const int id = it * 512 + tid, s = id >> 5, ch = id & 31;
            const u32x4 v = kv[it]; const float w = __expf(vdec[s] - mloc);
            u32x4 o; o.x = cvt_pk_bf16(bflo(v.x) * w, bfhi(v.x) * w); o.y = cvt_pk_bf16(bflo(v.y) * w, bfhi(v.y) * w); o.z = cvt_pk_bf16(bflo(v.z) * w, bfhi(v.z) * w); o.w = cvt_pk_bf16(bflo(v.w) * w, bfhi(v.w) * w);
            *(LAS u32x4*)(Ks + s * 544 + ch * 16) = o; }
        }
#pragma unroll
        for (int it = 0; it < 4; ++it) { const int id = it * 512 + tid, s = id >> 4, ch = id & 15;
            *(LAS u32x4*)(Vs + s * 288 + ch * 16) = vv[it]; }
        __syncthreads();
        f32x4 acc[2][8];
#pragma unroll
        for (int a = 0; a < 2; ++a)
#pragma unroll
            for (int e = 0; e < 8; ++e) acc[a][e] = (f32x4){0.f, 0.f, 0.f, 0.f};
#pragma unroll
        for (int kb = 0; kb < 4; ++kb) {
            bf16x8 X[2];
#pragma unroll
            for (int db = 0; db < 2; ++db) X[db] = tr_frag(Ks + (kb * 32 + fq * 4 + (fr >> 2)) * 544 + (32 * wid + db * 16 + (fr & 3) * 4) * 2, 16 * 544);
#pragma unroll
            for (int eb = 0; eb < 8; ++eb) { const bf16x8 Y = tr_frag(Vs + (kb * 32 + fq * 4 + (fr >> 2)) * 288 + (eb * 16 + (fr & 3) * 4) * 2, 16 * 288);
#pragma unroll
                for (int db = 0; db < 2; ++db) acc[db][eb] = __builtin_amdgcn_mfma_f32_16x16x32_bf16(X[db], Y, acc[db][eb], 0, 0, 0); }
        }
#pragma unroll
        for (int db = 0; db < 2; ++db)
#pragma unroll
            for (int eb = 0; eb < 8; ++eb) { u32x2 o; o.x = cvt_pk_bf16(acc[db][eb][0], acc[db][eb][1]); o.y = cvt_pk_bf16(acc[db][eb][2], acc[db][eb][3]);
                *(u32x2*)(cst + (size_t)bhc * 65536 + (size_t)(eh * 128 + eb * 16 + fr) * 256 + 32 * wid + db * 16 + fq * 4) = o; }
        if (eh == 0) {
            if (tid < 256) { float sn = 0.f;
                for (int s0 = 0; s0 < 128; s0 += 16) { unsigned short tv[16];
#pragma unroll
                    for (int j = 0; j < 16; ++j) tv[j] = *(LAS unsigned short*)(Ks + (s0 + j) * 544 + tid * 2);
#pragma unroll
                    for (int j = 0; j < 16; ++j) sn += bflo((unsigned)tv[j]); }
                nloc[(size_t)bhc * 256 + tid] = sn; }
            if (tid == 0) { gout[bhc] = gg; mlout[bhc] = mloc; }
        }
        __syncthreads();
    }
}
__device__ __forceinline__ void mlstm_s2_phase(const KP& p) {
    const int tid = opaque_tid();
    bf16_t* cst = (bf16_t*)(p.ws + O_CST);
    const float* gin = (const float*)(p.ws + O_G); const float* mlin = (const float*)(p.ws + O_MLOC); float* mst = (float*)(p.ws + O_MST);
    const float* nloc = (const float*)(p.ws + O_NLOC); float* nst = (float*)(p.ws + O_NST);
    for (int slot = blockIdx.x; slot < 256; slot += gridDim.x) {
        const int bh = slot >> 5, part = slot & 31; const size_t e0 = (size_t)(part * 512 + tid) * 4;
        float m = 0.f, C0 = 0.f, C1 = 0.f, C2 = 0.f, C3 = 0.f, nv = 0.f;
        const bool do_n = (part == 0) && (tid < 256);
        for (int c8 = 0; c8 < 64; c8 += 8) {
            u32x2 loc[8]; float nl[8];
#pragma unroll
            for (int j = 0; j < 8; ++j) { loc[j] = *(const u32x2*)(cst + (size_t)(bh * 64 + c8 + j) * 65536 + e0); nl[j] = do_n ? nloc[(size_t)(bh * 64 + c8 + j) * 256 + tid] : 0.f; }
#pragma unroll
            for (int j = 0; j < 8; ++j) { const int idx = bh * 64 + c8 + j;
                const float g = gin[idx], ml = mlin[idx]; const float mnew = fmaxf(g + m, ml); const float wo = __expf(g + m - mnew), wl = __expf(ml - mnew);
                u32x2 o; o.x = cvt_pk_bf16(C0, C1); o.y = cvt_pk_bf16(C2, C3);
                *(u32x2*)(cst + (size_t)idx * 65536 + e0) = o;
                C0 = wo * C0 + wl * bflo(loc[j].x); C1 = wo * C1 + wl * bfhi(loc[j].x); C2 = wo * C2 + wl * bflo(loc[j].y); C3 = wo * C3 + wl * bfhi(loc[j].y);
                if (do_n) { nst[(size_t)idx * 256 + tid] = nv; nv = wo * nv + wl * nl[j]; if (tid == 0) mst[idx] = m; }
                m = mnew; }
        }
    }
}
__device__ __forceinline__ void mlstm_s3_phase(const KP& p, int l, LAS unsigned char* lds) {
    const int tid = opaque_tid(), wid = tid >> 6, lane = tid & 63, fr = lane & 15, fq = lane >> 4;
    const bf16_t* proj = (const bf16_t*)(p.ws + O_BIG); const bf16_t* qbuf = (const bf16_t*)(p.ws + O_Q); const bf16_t* kbuf = (const bf16_t*)(p.ws + O_K);
    const bf16_t* xc = (const bf16_t*)(p.ws + O_XC); const float* ifb = (const float*)(p.ws + O_IF); const bf16_t* cst = (const bf16_t*)(p.ws + O_CST);
    const float* mst = (const float*)(p.ws + O_MST); const float* nst = (const float*)(p.ws + O_NST); bf16_t* yml = (bf16_t*)(p.ws + O_XN);
    const float* normg = p.in[22] + (unsigned)l * 1024; const float* skipg = p.in[23] + (unsigned)l * 1024;
    LAS unsigned char* Vh = lds;
    LAS unsigned char* Qs = lds + 36864;
    LAS unsigned char* Kt = lds + 55296;
    LAS unsigned char* CTs = lds + 73728;
    LAS unsigned char* Ss = lds + 92160;
    LAS float* vlf = (LAS float*)(lds + VEC_OFF); LAS float* va = vlf + 128; LAS float* vb = vlf + 256; LAS float* vM = vlf + 384; LAS float* nvec = vlf + 512;
    for (int task = blockIdx.x; task < 512; task += gridDim.x) {
        const int bhc = task, c = bhc & 63, bh = bhc >> 6, h = bh & 3, b = bh >> 2;
        const int tok0 = b * SEQ + c * 128;
        const float m0 = mst[bhc];
        float gi = 0.f, glf = 0.f;
        if (tid < 128) { gi = ifb[(unsigned)(tok0 + tid) * 8 + h]; glf = logsigmoidf_(ifb[(unsigned)(tok0 + tid) * 8 + 4 + h]); }
        if (tid < 256) nvec[tid] = nst[(unsigned)bhc * 256 + tid];
        const float bs = scan_sum128(glf, tid, vlf);
        const float av = (tid < 128) ? gi - bs : -INFINITY;
        const float mm = scan_max128(av, tid, vlf);
        if (tid < 128) { vb[tid] = bs; va[tid] = av; vM[tid] = fmaxf(m0, mm); }
        const int t = 16 * wid + fr;
        const unsigned tok = (unsigned)(tok0 + t);
        u32x2 hc0[8];
        float qn = 0.f, ss = 0.f, inv = 0.f, winter = 0.f;
#pragma unroll
        for (int eh = 0; eh < 2; ++eh) {
            f32x4 accS[8], accO[8];
#pragma unroll
            for (int i = 0; i < 8; ++i) { accS[i] = (f32x4){0.f, 0.f, 0.f, 0.f}; accO[i] = (f32x4){0.f, 0.f, 0.f, 0.f}; }
            u32x4 pq[2], pk[2], pc[2];
#define S3_LOAD(DB) do { _Pragma("unroll") for (int it = 0; it < 2; ++it) { const int id = it * 512 + tid, row = id >> 3, ch = id & 7; \
                    pq[it] = *(const u32x4*)(qbuf + (unsigned)(tok0 + row) * DM + h * 256 + (DB) * 64 + ch * 8); \
                    if (eh == 0) pk[it] = *(const u32x4*)(kbuf + (unsigned)(tok0 + row) * DM + h * 256 + (DB) * 64 + ch * 8); \
                    pc[it] = *(const u32x4*)(cst + (unsigned)bhc * 65536 + (unsigned)(eh * 128 + row) * 256 + (DB) * 64 + ch * 8); } } while (0)
            S3_LOAD(0);
            for (int db4 = 0; db4 < 4; ++db4) {
                __syncthreads();
#pragma unroll
                for (int it = 0; it < 2; ++it) { const int id = it * 512 + tid, row = id >> 3, ch = id & 7;
                    *(LAS u32x4*)(Qs + row * 144 + ch * 16) = pq[it];
                    if (eh == 0) *(LAS u32x4*)(Kt + row * 144 + ch * 16) = pk[it];
                    *(LAS u32x4*)(CTs + row * 144 + ch * 16) = pc[it]; }
                if (db4 < 3) S3_LOAD(db4 + 1);
                __syncthreads();
#pragma unroll
                for (int kk = 0; kk < 2; ++kk) {
                    const bf16x8 Qf = *(LAS bf16x8*)(Qs + (16 * wid + fr) * 144 + (kk * 32 + fq * 8) * 2);
                    if (eh == 0) {
                        const u32x4 qu = __builtin_bit_cast(u32x4, Qf); const LAS float* nvp = nvec + db4 * 64 + kk * 32 + fq * 8; const f32x4 n0 = *(LAS f32x4*)nvp, n1 = *(LAS f32x4*)(nvp + 4);
                        qn += bflo(qu.x) * n0.x + bfhi(qu.x) * n0.y + bflo(qu.y) * n0.z + bfhi(qu.y) * n0.w + bflo(qu.z) * n1.x + bfhi(qu.z) * n1.y + bflo(qu.w) * n1.z + bfhi(qu.w) * n1.w;
#pragma unroll
                        for (int sb = 0; sb < 8; ++sb) { if (sb <= wid) { const bf16x8 Kf = *(LAS bf16x8*)(Kt + (sb * 16 + fr) * 144 + (kk * 32 + fq * 8) * 2); accS[sb] = __builtin_amdgcn_mfma_f32_16x16x32_bf16(Kf, Qf, accS[sb], 0, 0, 0); } if ((sb & 3) == 3) { asm volatile("" ::: "memory"); __builtin_amdgcn_sched_barrier(0); } }
                    }
#pragma unroll
                    for (int eb = 0; eb < 8; ++eb) { const bf16x8 Cf = *(LAS bf16x8*)(CTs + (eb * 16 + fr) * 144 + (kk * 32 + fq * 8) * 2); accO[eb] = __builtin_amdgcn_mfma_f32_16x16x32_bf16(Cf, Qf, accO[eb], 0, 0, 0); if ((eb & 3) == 3) { asm volatile("" ::: "memory"); __builtin_amdgcn_sched_barrier(0); } }
                }
            }
            u32x4 vt[4];
#pragma unroll
            for (int it = 0; it < 4; ++it) { const int id = it * 512 + tid, s = id >> 4, ch = id & 15; vt[it] = *(const u32x4*)(proj + (unsigned)(tok0 + s) * NPROJ + 1536 + h * 256 + eh * 128 + ch * 8); }
            asm volatile("" ::: "memory");
#pragma unroll
            for (int it = 0; it < 4; ++it) { const int id = it * 512 + tid, s = id >> 4, ch = id & 15; *(LAS u32x4*)(Vh + s * 288 + ch * 16) = vt[it]; }
            if (eh == 0) {
                const float Mt = vM[t]; winter = __expf(m0 - Mt);
                float rowsum = 0.f;
#pragma unroll
                for (int sb = 0; sb < 8; ++sb) if (sb <= (wid | 1)) {
                    const f32x4 a4 = *(LAS f32x4*)(va + sb * 16 + fq * 4);
                    float sv[4];
#pragma unroll
                    for (int j = 0; j < 4; ++j) { const int s = sb * 16 + fq * 4 + j; const float v0 = accS[sb][j] * __expf(fminf(a4[j] - Mt, 0.f)); const float v = (s <= t) ? v0 : 0.f; sv[j] = v; rowsum += v; }
                    u32x2 o; o.x = cvt_pk_bf16(sv[0], sv[1]); o.y = cvt_pk_bf16(sv[2], sv[3]);
                    *(LAS u32x2*)(Ss + t * 272 + (sb * 16 + fq * 4) * 2) = o;
                }
                rowsum += __shfl_xor(rowsum, 16); rowsum += __shfl_xor(rowsum, 32);
                qn += __shfl_xor(qn, 16); qn += __shfl_xor(qn, 32);
                const float den = winter * qn + rowsum, mt = vb[t] + Mt;
                inv = 1.0f / fmaxf(fabsf(den), __expf(-mt));
            }
#pragma unroll
            for (int eb = 0; eb < 8; ++eb) accO[eb] = accO[eb] * winter;
            __syncthreads();
            for (int kb = 0; kb <= (wid >> 1); ++kb) {
                const s16x4 s0 = *(LAS s16x4*)(Ss + t * 272 + (kb * 32 + fq * 4) * 2), s1 = *(LAS s16x4*)(Ss + t * 272 + (kb * 32 + 16 + fq * 4) * 2);
                const bf16x8 Sf = __builtin_shufflevector(s0, s1, 0, 1, 2, 3, 4, 5, 6, 7);
#pragma unroll
                for (int eb = 0; eb < 8; ++eb) { const bf16x8 Vf = tr_frag(Vh + (kb * 32 + fq * 4 + (fr >> 2)) * 288 + (eb * 16 + (fr & 3) * 4) * 2, 16 * 288);
                    accO[eb] = __builtin_amdgcn_mfma_f32_16x16x32_bf16(Vf, Sf, accO[eb], 0, 0, 0); if ((eb & 3) == 3) { asm volatile("" ::: "memory"); __builtin_amdgcn_sched_barrier(0); } }
            }
            u32x2 ovv[8];
#pragma unroll
            for (int eb = 0; eb < 8; ++eb) ovv[eb] = *(const u32x2*)(proj + tok * NPROJ + 2560 + h * 256 + eh * 128 + eb * 16 + fq * 4);
            asm volatile("" ::: "memory");
#pragma unroll
            for (int eb = 0; eb < 8; ++eb) { const u32x2 ov = ovv[eb];
                f32x4 hc; hc.x = sigmoidf_(bflo(ov.x)) * accO[eb].x * inv; hc.y = sigmoidf_(bfhi(ov.x)) * accO[eb].y * inv; hc.z = sigmoidf_(bflo(ov.y)) * accO[eb].z * inv; hc.w = sigmoidf_(bfhi(ov.y)) * accO[eb].w * inv;
                ss += (hc.x * hc.x + hc.y * hc.y) + (hc.z * hc.z + hc.w * hc.w);
                if (eh == 0) { hc0[eb].x = cvt_pk_bf16(hc.x, hc.y); hc0[eb].y = cvt_pk_bf16(hc.z, hc.w); } else accO[eb] = hc;
                if ((eb & 3) == 3) { asm volatile("" ::: "memory"); __builtin_amdgcn_sched_barrier(0); } }
            if (eh == 1) {
                ss += __shfl_xor(ss, 16); ss += __shfl_xor(ss, 32);
                const float rs = rsqrtf(ss * (1.0f / 256.0f) + EPS);
#pragma unroll
                for (int e4 = 0; e4 < 8; ++e4) {
                    f32x4 ngv[2], skv[2]; u32x2 xvv[2];
#pragma unroll
                    for (int q = 0; q < 2; ++q) { const int col = h * 256 + (e4 * 2 + q) * 16 + fq * 4; ngv[q] = *(const f32x4*)(normg + col); skv[q] = *(const f32x4*)(skipg + col); xvv[q] = *(const u32x2*)(xc + tok * DM + col); }
                    asm volatile("" ::: "memory");
#pragma unroll
                    for (int q = 0; q < 2; ++q) { const int e2 = e4 * 2 + q, col = h * 256 + e2 * 16 + fq * 4;
                        const f32x4 ng = ngv[q], sk = skv[q]; const u32x2 xv = xvv[q];
                        f32x4 hc; if (e2 < 8) { const u32x2 hp = hc0[e2 & 7]; hc = (f32x4){bflo(hp.x), bfhi(hp.x), bflo(hp.y), bfhi(hp.y)}; } else hc = accO[e2 & 7];
                        u32x2 o; o.x = cvt_pk_bf16(hc.x * rs * ng.x + sk.x * bflo(xv.x), hc.y * rs * ng.y + sk.y * bfhi(xv.x)); o.y = cvt_pk_bf16(hc.z * rs * ng.z + sk.z * bflo(xv.y), hc.w * rs * ng.w + sk.w * bfhi(xv.y));
                        *(u32x2*)(yml + tok * DM + col) = o; }
                    asm volatile("" ::: "memory"); __builtin_amdgcn_sched_barrier(0);
                }
            }
        }
        __syncthreads();
    }
}

#define XB_TMO      128
#define XB_XCNT(j)  (256  + 64 * (j))
#define XB_XSUB(j)  (1280 + 64 * (j))
#define XB_XGEN(j)  (2304 + 64 * (j))
#define XB_TOP      3328
#define XB_TOPGEN   3392
#define XCD_BAR_WORDS 3456
#define XB_SPIN_CAP (1u << 22)
__device__ __forceinline__ unsigned xb_ld(unsigned* p)              { return __hip_atomic_load(p, __ATOMIC_RELAXED, __HIP_MEMORY_SCOPE_AGENT); }
__device__ __forceinline__ unsigned xb_add(unsigned* p, unsigned v) { return __hip_atomic_fetch_add(p, v, __ATOMIC_RELAXED, __HIP_MEMORY_SCOPE_AGENT); }
__device__ __forceinline__ unsigned xb_xcc_id() { return (unsigned)__builtin_amdgcn_s_getreg((3 << 11) | 20) & 0xFu; }
#define XB_SPIN(cond, bar) do { unsigned _sp = 0; while (cond) { __builtin_amdgcn_s_sleep(1); \
    if ((++_sp & 255u) == 0u) { if (xb_ld(&(bar)[XB_TMO])) break; if (_sp > XB_SPIN_CAP) { atomicAdd(&(bar)[XB_TMO], 1u); break; } } } } while (0)
struct XcdBarrier { unsigned* bar; unsigned x; volatile LAS unsigned* st; };
__device__ __forceinline__ XcdBarrier xcd_barrier_post(unsigned* bar, volatile LAS unsigned* st) {
    XcdBarrier b; b.bar = bar; b.x = xb_xcc_id(); b.st = st;
    if (threadIdx.x == 0) (void)xb_add(&bar[XB_XCNT(b.x)], 1u);
    return b;
}
__device__ __forceinline__ void xcd_barrier_complete(unsigned* bar, unsigned x, unsigned& nloc, unsigned& nx) {
    const unsigned G = gridDim.x * gridDim.y * gridDim.z;
    unsigned sum, cnt, mine, sp = 0u;
    for (;;) {
        sum = 0u; cnt = 0u; mine = 0u;
#pragma unroll
        for (unsigned j = 0; j < 16; ++j) { const unsigned c = xb_ld(&bar[XB_XCNT(j)]); sum += c; cnt += (c > 0u) ? 1u : 0u; mine = (j == x) ? c : mine; }
        if (sum == G) break;
        __builtin_amdgcn_s_sleep(1);
        if ((++sp & 255u) == 0u) { if (xb_ld(&bar[XB_TMO])) break; if (sp > XB_SPIN_CAP) { atomicAdd(&bar[XB_TMO], 1u); break; } }
    }
    nloc = mine > 0u ? mine : 1u; nx = cnt > 0u ? cnt : 1u;
}
__device__ __forceinline__ void xcd_barrier(const XcdBarrier& b) {
    asm volatile("s_waitcnt vmcnt(0) lgkmcnt(0)" ::: "memory");
    __syncthreads();
    if (threadIdx.x == 0) {
        unsigned* bar = b.bar;
        __builtin_amdgcn_s_waitcnt(0);
        unsigned nloc = b.st[0], nx = b.st[1];
        if (nloc == 0u) { xcd_barrier_complete(bar, b.x, nloc, nx); b.st[0] = nloc; b.st[1] = nx; }
        const unsigned old = xb_add(&bar[XB_XSUB(b.x)], 1u);
        const unsigned gen = old / nloc;
        if (old + 1u == (gen + 1u) * nloc) {
            __builtin_amdgcn_fence(__ATOMIC_RELEASE, "agent");
            asm volatile("s_waitcnt vmcnt(0)" ::: "memory");
            const unsigned og = xb_add(&bar[XB_TOP], 1u);
            const unsigned tg = og / nx;
            if (og + 1u == (tg + 1u) * nx) xb_add(&bar[XB_TOPGEN], 1u);
            else XB_SPIN(xb_ld(&bar[XB_TOPGEN]) == tg, bar);
            __builtin_amdgcn_fence(__ATOMIC_ACQUIRE, "agent");
            xb_add(&bar[XB_XGEN(b.x)], 1u);
            asm volatile("s_waitcnt vmcnt(0)" ::: "memory");
        } else {
            XB_SPIN(xb_ld(&bar[XB_XGEN(b.x)]) == gen, bar);
            __builtin_amdgcn_fence(__ATOMIC_ACQUIRE, "agent");
            asm volatile("s_waitcnt vmcnt(0)" ::: "memory");
        }
    }
    __syncthreads();
}

__global__ void __launch_bounds__(512, 2) fwd_megakernel(KP p) {
    extern __shared__ __attribute__((aligned(16))) unsigned char shm[];
    LAS unsigned char* lds = (LAS unsigned char*)shm;
    cg::grid_group grid = cg::this_grid();
    { volatile LAS unsigned* st0 = (volatile LAS unsigned*)(lds + 143360); if (threadIdx.x < 4) st0[threadIdx.x] = 0u; }
    __syncthreads();
    const XcdBarrier xb = xcd_barrier_post((unsigned*)(p.ws + O_BAR), (volatile LAS unsigned*)(lds + 143360));
    asm volatile("s_waitcnt vmcnt(0) lgkmcnt(0)" ::: "memory"); grid.sync();
#define GSYNC() xcd_barrier(xb)
    unsigned char* ws = p.ws;
    bf16_t* BIG = (bf16_t*)(ws + O_BIG); bf16_t* XN = (bf16_t*)(ws + O_XN); bf16_t* XC = (bf16_t*)(ws + O_XC);
    bf16_t* Q = (bf16_t*)(ws + O_Q); bf16_t* KB = (bf16_t*)(ws + O_K); bf16_t* Z = (bf16_t*)(ws + O_Z); bf16_t* YS5 = (bf16_t*)(ws + O_YS5);
    float* MIXACC = (float*)(ws + O_CST); float* IFB = (float*)(ws + O_IF);
    float* xo = p.out;
    for (int l = 0; l < 4; ++l) {
        const float* xcur = (l == 0) ? p.in[0] : xo;
        for (int rep = 0; rep < REP_A; ++rep) { convert_phase(p, l, lds);
        rmsnorm_phase<false>(xcur, p.in[1] + l * 1024, XN, nullptr, nullptr, nullptr, lds); }
        GSYNC(); if (STOP_PHASE == 1) break;
        for (int rep = 0; rep < REP_G; ++rep) { pg8::Gemm g{XN, (const bf16_t*)(ws + W_GU1), MTOK, 2 * FF, 1024, 1024, 1024, 0}; pg8::EpiGated<0> e{BIG, FF}; pg8::gemm_phase(lds, g, e); }
        GSYNC(); if (STOP_PHASE == 2) break;
        { pg8::Gemm g{BIG, (const bf16_t*)(ws + W_D1), MTOK, 1024, FF, FF, FF, 0}; pg8::EpiResid e{xcur, xo, 0.5f}; pg8::gemm_phase(lds, g, e); }
        GSYNC(); if (STOP_PHASE == 3) break;
        for (int rep = 0; rep < REP_A; ++rep) { rmsnorm_phase<true>(xo, p.in[5] + l * 1024, XN, p.in[6] + (size_t)l * 1024 * INC, p.in[7] + l * 8, IFB, lds); __syncthreads(); }
        GSYNC(); if (STOP_PHASE == 4) break;
        for (int rep = 0; rep < REP_G; ++rep) { pg8::Gemm g{XN, (const bf16_t*)(ws + W_IN), MTOK, NPROJ, 1024, 1024, 1024, 0}; pg8::EpiBf16 e{BIG, BIG, NPROJ, 1000, 1.0f}; pg8::gemm_phase(lds, g, e); }
        GSYNC(); if (STOP_PHASE == 5) break;
        if (gridDim.x == 256) {
            s5_phase<false>(p, l, lds);
            conv_slice(p, l, (int)blockIdx.x >> 2, (int)blockIdx.x & 3);
            asm volatile("s_waitcnt vmcnt(0) lgkmcnt(0)" ::: "memory"); __syncthreads();
            { pg8::Gemm g{XC, (const bf16_t*)(ws + W_QK), MTOK, 2048, 256, 1024, 256, 256, nullptr, nullptr, 0, 1}; pg8::EpiBf16 e{Q, KB, 1024, 4, 0.0625f}; pg8::gemm_phase(lds, g, e); }
            asm volatile("s_waitcnt vmcnt(0) lgkmcnt(0)" ::: "memory"); __syncthreads();
            mlstm_s1_phase<true>(p, lds);
            GSYNC();
            s5_phase<true>(p, l, lds);
            mlstm_s2_phase(p);
            GSYNC();
            __syncthreads();
            { pg8::Gemm g{Z, (const bf16_t*)(ws + W_GLU), MTOK, 1024, 512, 512, 512, 0}; pg8::EpiGated<1> e{YS5, 1024}; pg8::gemm_phase(lds, g, e); }
            mlstm_s3_phase(p, l, lds);
            GSYNC();
        } else {
            conv_phase(p, l);
            s5_phase<false>(p, l, lds);
            GSYNC();
            { pg8::Gemm g{XC, (const bf16_t*)(ws + W_QK), MTOK, 2048, 256, 1024, 256, 256}; pg8::EpiBf16 e{Q, KB, 1024, 4, 0.0625f}; pg8::gemm_phase(lds, g, e); }
            GSYNC();
            mlstm_s1_phase<false>(p, lds);
            s5_phase<true>(p, l, lds);
            GSYNC();
            mlstm_s2_phase(p);
            { pg8::Gemm g{Z, (const bf16_t*)(ws + W_GLU), MTOK, 1024, 512, 512, 512, 0}; pg8::EpiGated<1> e{YS5, 1024}; pg8::gemm_phase(lds, g, e); }
            GSYNC();
            mlstm_s3_phase(p, l, lds);
            GSYNC();
        }
        { pg8::Gemm g{YS5, (const bf16_t*)(ws + W_BS5), MTOK, 1024, 512, 1024, 1024, 0, XN, (const bf16_t*)(ws + W_BML), 1024}; pg8::EpiMergeDual e{BIG + 3584, BIG + 4608, Q}; pg8::gemm_phase(lds, g, e); }
        GSYNC(); if (STOP_PHASE == 11) break;
        { pg8::Gemm g{Q, (const bf16_t*)(ws + W_OUT), MTOK, 1024, 1024, 1024, 1024, 0}; pg8::EpiResid e{xo, xo, 1.0f}; pg8::gemm_phase(lds, g, e); }
        GSYNC(); if (STOP_PHASE == 12) break;
        for (int rep = 0; rep < REP_A; ++rep) rmsnorm_phase<false>(xo, p.in[27] + l * 1024, XN, nullptr, nullptr, nullptr, lds);
        GSYNC(); if (STOP_PHASE == 13) break;
        for (int rep = 0; rep < REP_G; ++rep) { pg8::Gemm g{XN, (const bf16_t*)(ws + W_GU2), MTOK, 2 * FF, 1024, 1024, 1024, 0}; pg8::EpiGated<0> e{BIG, FF}; pg8::gemm_phase(lds, g, e); }
        GSYNC(); if (STOP_PHASE == 14) break;
        { pg8::Gemm g{BIG, (const bf16_t*)(ws + W_D2), MTOK, 1024, FF, FF, FF, 0}; pg8::EpiResid e{xo, xo, 0.5f}; pg8::gemm_phase(lds, g, e); }
        GSYNC(); if (STOP_PHASE == 15) break;
    }
#ifdef DUMP_OFF
    { const int gt = blockIdx.x * 512 + opaque_tid(); const int nthr = gridDim.x * 512;
      for (int i = gt; i < MTOK * DM; i += nthr) { float v;
          if (DUMP_KIND == 5) { v = bflo((unsigned)((const bf16_t*)(ws + O_BIG))[(size_t)(i >> 10) * NPROJ + DUMP_COL + (i & 1023)]); }
          else if (DUMP_KIND == 4) { v = 0.f; if (i < 512) v = ((const float*)(ws + O_G))[i]; else if (i < 1024) v = ((const float*)(ws + O_MLOC))[i - 512]; else if (i < 1024 + 131072) v = ((const float*)(ws + O_NLOC))[i - 1024]; }
          else if (DUMP_KIND == 2 && i < 131072) v = ((const float*)(ws + O_IF))[i];
          else if (DUMP_KIND == 3) v = bflo((unsigned)((const bf16_t*)(ws + (i < 8388608 ? O_Q : O_K)))[i & 8388607]);
          else if (DUMP_KIND == 1) v = ((const float*)(ws + DUMP_OFF))[i]; else v = bflo((unsigned)((const bf16_t*)(ws + DUMP_OFF))[i]);
          xo[i] = (fabsf(v) < 1e30f) ? v : 12345.0f; } }
#else
    final_norm_phase(xo, p.in[31]);
#endif
}

extern "C" void kernel_launch(void* const* d_in, const int* in_sizes, int n_in, void* d_out, int out_size, void* d_ws, size_t ws_size, hipStream_t stream) {
    static int grid_blocks = 0;
    if (grid_blocks == 0) {
        if (n_in != 32 || ws_size < WS_END) { fprintf(stderr, "kernel_launch: unexpected n_in %d or ws_size %zu (< %zu)\n", n_in, ws_size, (size_t)WS_END); grid_blocks = -1; return; }
        int dev = 0, cus = 0, per_cu = 0;
        hipGetDevice(&dev);
        hipDeviceGetAttribute(&cus, hipDeviceAttributeMultiprocessorCount, dev);
        if (hipFuncSetAttribute((const void*)fwd_megakernel, hipFuncAttributeMaxDynamicSharedMemorySize, LDS_BYTES) != hipSuccess) { fprintf(stderr, "kernel_launch: hipFuncSetAttribute failed\n"); grid_blocks = -1; return; }
        hipOccupancyMaxActiveBlocksPerMultiprocessor(&per_cu, (const void*)fwd_megakernel, 512, LDS_BYTES);
        if (per_cu < 1) { fprintf(stderr, "kernel_launch: occupancy query says %d blocks/CU\n", per_cu); per_cu = 1; }
        (void)hipGetLastError();
        grid_blocks = cus;
    }
    if (grid_blocks < 0) return;
    if (hipMemsetAsync((unsigned char*)d_ws + O_BAR, 0, 16384, stream) != hipSuccess) { fprintf(stderr, "kernel_launch: memset of barrier words failed\n"); return; }
    KP p{};
    for (int i = 0; i < 32; ++i) p.in[i] = (const float*)d_in[i];
    p.out = (float*)d_out; p.ws = (unsigned char*)d_ws;
    void* args[] = {&p};
    hipError_t e = hipLaunchCooperativeKernel((const void*)fwd_megakernel, dim3(grid_blocks), dim3(512), args, LDS_BYTES, stream);
    if (e != hipSuccess) fprintf(stderr, "cooperative launch failed: %s (grid %d)\n", hipGetErrorString(e), grid_blocks);
}
```

```cpp
#include <hip/hip_runtime.h>
#include <hip/hip_cooperative_groups.h>
#include <cstdio>
namespace cg = cooperative_groups;

#define LAS __attribute__((address_space(3)))
typedef unsigned short bf16_t;
typedef short bf16x8 __attribute__((ext_vector_type(8)));
typedef short s16x4 __attribute__((ext_vector_type(4)));
typedef float f32x4 __attribute__((ext_vector_type(4)));
typedef float f32x2 __attribute__((ext_vector_type(2)));
typedef unsigned u32x4 __attribute__((ext_vector_type(4)));
typedef unsigned u32x2 __attribute__((ext_vector_type(2)));

constexpr int MTOK = 16384, DM = 1024, FF = 2816, NPROJ = 5632, SEQ = 8192, INC = 5640;
constexpr float EPS = 1e-6f;
constexpr int LDS_BYTES = 147456;
#ifndef STOP_PHASE
#define STOP_PHASE 99
#define REP_A 1
#define REP_G 1
#define REP_B 1
#define REP_C 1
#define REP_D 1
#endif
constexpr int VEC_OFF = 131072;

constexpr size_t W_GU1 = 0;
constexpr size_t W_D1 = W_GU1 + (size_t)5632 * 1024 * 2;
constexpr size_t W_IN = W_D1 + (size_t)1024 * 2816 * 2;
constexpr size_t W_GLU = W_IN + (size_t)5632 * 1024 * 2;
constexpr size_t W_QK = W_GLU + (size_t)1024 * 512 * 2;
constexpr size_t W_BS5 = W_QK + (size_t)2048 * 256 * 2;
constexpr size_t W_BML = W_BS5 + (size_t)1024 * 1024 * 2;
constexpr size_t W_OUT = W_BML + (size_t)1024 * 1024 * 2;
constexpr size_t W_GU2 = W_OUT + (size_t)1024 * 1024 * 2;
constexpr size_t W_D2 = W_GU2 + (size_t)5632 * 1024 * 2;
constexpr size_t W_END = W_D2 + (size_t)1024 * 2816 * 2;
constexpr size_t O_BIG = W_END;
constexpr size_t O_XN = O_BIG + (size_t)MTOK * NPROJ * 2;
constexpr size_t O_XC = O_XN + (size_t)MTOK * 1024 * 2;
constexpr size_t O_Q = O_XC + (size_t)MTOK * 1024 * 2;
constexpr size_t O_K = O_Q + (size_t)MTOK * 1024 * 2;
constexpr size_t O_Z = O_K + (size_t)MTOK * 1024 * 2;
constexpr size_t O_YS5 = O_Z + (size_t)MTOK * 512 * 2;
constexpr size_t O_CST = O_YS5 + (size_t)MTOK * 1024 * 2;
constexpr size_t O_IF = O_CST + (size_t)512 * 65536 * 2;
constexpr size_t O_S5END = O_IF + (size_t)MTOK * 8 * 4;
constexpr size_t O_G = O_S5END + (size_t)64 * 64 * 64 * 8;
constexpr size_t O_MLOC = O_G + 2048;
constexpr size_t O_MST = O_MLOC + 2048;
constexpr size_t O_NLOC = O_MST + 2048;
constexpr size_t O_NST = O_NLOC + (size_t)512 * 256 * 4;
constexpr size_t O_BAR = O_NST + (size_t)512 * 256 * 4;
constexpr size_t WS_END = O_BAR + 16384;

struct KP { const float* in[32]; float* out; unsigned char* ws; };

typedef __bf16 bf16v2_t __attribute__((ext_vector_type(2)));
__device__ __forceinline__ unsigned cvt_pk_bf16(float lo, float hi) { const f32x2 v = {lo, hi}; const bf16v2_t b = __builtin_convertvector(v, bf16v2_t); return __builtin_bit_cast(unsigned, b); }
__device__ __forceinline__ float bflo(unsigned u) { return __uint_as_float(u << 16); }
__device__ __forceinline__ float bfhi(unsigned u) { return __uint_as_float(u & 0xffff0000u); }
__device__ __forceinline__ float sigmoidf_(float x) { return __builtin_amdgcn_rcpf(1.0f + __expf(-x)); }
__device__ __forceinline__ float siluf_(float x) { return x * __builtin_amdgcn_rcpf(1.0f + __expf(-x)); }
__device__ __forceinline__ float gelu_tanh(float y) { const float v = 0.7978845608028654f * (y + 0.044715f * y * y * y); const float th = 1.0f - 2.0f * __builtin_amdgcn_rcpf(1.0f + __expf(2.0f * v)); return 0.5f * y * (1.0f + th); }
__device__ __forceinline__ float logsigmoidf_(float x) { return fminf(x, 0.f) - log1pf(__expf(-fabsf(x))); }
__device__ __forceinline__ float wave_sum(float v) {
#pragma unroll
    for (int o = 1; o < 64; o <<= 1) v += __shfl_xor(v, o);
    return v;
}
__device__ __forceinline__ int opaque_tid() { int t = threadIdx.x; asm volatile("" : "+v"(t)); return t; }
#define WAVE_LDS_SYNC() asm volatile("s_waitcnt lgkmcnt(0)" ::: "memory")
__device__ __forceinline__ void sincos_acc(float x, float& s, float& c) {
    const float k = rintf(x * 0.63661977236758134f);
    float r = fmaf(-k, 1.5703125f, x); r = fmaf(-k, 4.837512969970703125e-4f, r); r = fmaf(-k, 7.54978995489188216e-8f, r);
    const float r2 = r * r;
    const float sp = r + r * r2 * (-1.6666654611e-1f + r2 * (8.3321608736e-3f + r2 * (-1.9515295891e-4f)));
    const float cp = 1.0f - 0.5f * r2 + r2 * r2 * (4.166664568298827e-2f + r2 * (-1.388731625493765e-3f + r2 * 2.443315711809948e-5f));
    const int q = ((int)k) & 3;
    s = (q == 0) ? sp : (q == 1) ? cp : (q == 2) ? -sp : -cp;
    c = (q == 0) ? cp : (q == 1) ? -sp : (q == 2) ? -cp : sp;
}

namespace pg8 {
constexpr int BM = 256, BK = 64, HALF = 128, HTB = HALF * BK * 2, STAGE_BYTES = 8 * HTB, NXCD = 8, WGM = 8;
__host__ __device__ __forceinline__ int lds_byte(int r, int c) { const int st = (r >> 4) * 2 + (c >> 5), rr = r & 15, cc = c & 31, ob = rr * 64 + cc * 2; return st * 1024 + (ob ^ (((ob >> 9) & 1) << 5)); }
__host__ __device__ __forceinline__ void stage_rc(int b, int& R, int& C) { const int st = b / 1024, sb = b % 1024, swz = sb ^ (((sb >> 9) & 1) << 5); R = (st >> 1) * 16 + swz / 64; C = (st & 1) * 32 + (swz % 64) / 2; }
__host__ __device__ __forceinline__ int perm32(int rho) { const int n = rho >> 4, i = rho & 15; return 8 * (i >> 2) + 4 * n + (i & 3); }
struct Unit { int pm, pn; };
struct Gemm { const bf16_t* A; const bf16_t* Bt; int M, N, K, lda, ldb, ahead; const bf16_t* A2; const bf16_t* Bt2; int K2; int pairmode; };
struct StaticOrder {
    int nM, nN, nwg, G, c;
    __device__ void init(int M, int N, int G_, int c_) { nM = M / BM; nN = N / BM; nwg = nM * nN; G = G_; c = c_; }
    __device__ bool next(int i, Unit& u) const {
        const long L = (long)i * G + c; if (L >= nwg) return false;
        int wgid = (int)L; { const int q = nwg / NXCD, r = nwg % NXCD, xcd = wgid % NXCD, off = wgid / NXCD; wgid = (xcd < r ? xcd * (q + 1) : r * (q + 1) + (xcd - r) * q) + off; }
        const int nig = WGM * nN, gid = wgid / nig, fm = gid * WGM, gsz = (nM - fm) < WGM ? (nM - fm) : WGM;
        u.pm = fm + ((wgid % nig) % gsz); u.pn = (wgid % nig) / gsz; return true;
    }
};

template <class Epi>
__device__ __forceinline__ void gemm_phase(LAS unsigned char* lds, const Gemm g, const Epi& E) {
    StaticOrder S; S.init(g.M, g.N, (int)gridDim.x, (int)blockIdx.x);
    const int tid = opaque_tid(), wid = __builtin_amdgcn_readfirstlane(tid >> 6), lane = tid & 63, wr = wid >> 2, wc = wid & 3, fr = lane & 15, fq = lane >> 4;
    const int K = g.K; int nt = K / BK; int seg = 0;
    unsigned voffA[2], voffB[2];
#pragma unroll
    for (int i = 0; i < 2; ++i) { int R, C; stage_rc(tid * 16 + i * 8192, R, C); const int Rb = Epi::PERM ? ((R & ~31) + perm32(R & 31)) : R;
        voffA[i] = (unsigned)(R * g.lda + C) * 2u; voffB[i] = (unsigned)(Rb * g.ldb + C) * 2u; }
    const size_t kstep = (size_t)(BK * 2);
    const size_t hstepA = (size_t)HALF * g.lda * 2, hstepB = (size_t)HALF * g.ldb * 2;
    const size_t tstepA = 2 * hstepA, tstepB = 2 * hstepB;
    const unsigned ldsw = (unsigned)wid * 1024u;
    const int aoff = lds_byte(wr * 64 + fr, fq * 8), boff = lds_byte(wc * 32 + fr, fq * 8);
#define PG8_SA(b, h) (((b) * 2 + (h)) * HTB)
#define PG8_SB(b, h) ((4 + (b) * 2 + (h)) * HTB)
#define PG8_STAGE(bufoff, gbase, voff) do { _Pragma("unroll") for (int _i = 0; _i < 2; ++_i) \
        __builtin_amdgcn_global_load_lds((const unsigned*)((const char*)(gbase) + (voff)[_i]), (LAS unsigned*)(lds + (bufoff) + ldsw + _i * 8192), 16, 0, 0); } while (0)
#define PG8_LDA(dst, b, h) do { _Pragma("unroll") for (int m = 0; m < 4; ++m) _Pragma("unroll") for (int k = 0; k < 2; ++k) dst[m][k] = *(const LAS bf16x8*)(lds + PG8_SA(b, h) + aoff + m * 2048 + k * 1024); } while (0)
#define PG8_LDB(dst, b, h) do { _Pragma("unroll") for (int n = 0; n < 2; ++n) _Pragma("unroll") for (int k = 0; k < 2; ++k) dst[n][k] = *(const LAS bf16x8*)(lds + PG8_SB(b, h) + boff + n * 2048 + k * 1024); } while (0)
#define PG8_MMA(ai, bj, At, Bt) do { __builtin_amdgcn_s_setprio(1); _Pragma("unroll") for (int m = 0; m < 4; ++m) _Pragma("unroll") for (int n = 0; n < 2; ++n) _Pragma("unroll") for (int k = 0; k < 2; ++k) \
        acc[ai][bj][m][n] = __builtin_amdgcn_mfma_f32_16x16x32_bf16(Bt[n][k], At[m][k], acc[ai][bj][m][n], 0, 0, 0); __builtin_amdgcn_s_setprio(0); } while (0)
#define PG8_WAIT_V(n) asm volatile("s_waitcnt vmcnt(" #n ")" ::: "memory")
#define PG8_WAIT_L(n) asm volatile("s_waitcnt lgkmcnt(" #n ")" ::: "memory")
#define PG8_BAR __builtin_amdgcn_s_barrier()
#define PG8_SCHED __builtin_amdgcn_sched_barrier(0)
    auto nextu = [&](int i, Unit& u) -> bool { if (g.pairmode) { if (i >= 2) return false; u.pm = (int)blockIdx.x >> 2; u.pn = ((int)blockIdx.x & 3) + 4 * i; return true; } return S.next(i, u); };
    Unit cur, nxt; int ui = 0;
    if (!nextu(0, cur)) return;
    f32x4 acc[2][2][4][2];
#pragma unroll
    for (int a = 0; a < 2; ++a)
#pragma unroll
        for (int b = 0; b < 2; ++b)
#pragma unroll
            for (int m = 0; m < 4; ++m)
#pragma unroll
                for (int n = 0; n < 2; ++n) acc[a][b][m][n] = (f32x4){0.f, 0.f, 0.f, 0.f};
    bf16x8 At[4][2], B0[2][2], B1[2][2];
    const char* cA = (const char*)g.A + (size_t)cur.pm * tstepA + (size_t)((cur.pn & 3) * g.ahead) * 2; const char* cB = (const char*)g.Bt + (size_t)cur.pn * tstepB;
    PG8_STAGE(PG8_SB(0, 0), cB, voffB); PG8_STAGE(PG8_SA(0, 0), cA, voffA); PG8_STAGE(PG8_SB(0, 1), cB + hstepB, voffB); PG8_STAGE(PG8_SA(0, 1), cA + hstepA, voffA);
    if (wr == 1) PG8_BAR;
    PG8_WAIT_V(4); PG8_BAR;
    PG8_STAGE(PG8_SB(1, 0), cB + kstep, voffB); PG8_STAGE(PG8_SA(1, 0), cA + kstep, voffA); PG8_STAGE(PG8_SB(1, 1), cB + hstepB + kstep, voffB);
    PG8_WAIT_V(6); PG8_BAR;
    for (;;) {
        bool has_next; const char* nA; const char* nB;
        if (Epi::DUAL && seg == 0) { has_next = true; nxt = cur; nA = (const char*)g.A2 + (size_t)cur.pm * tstepA; nB = (const char*)g.Bt2 + (size_t)cur.pn * tstepB; }
        else { has_next = nextu(ui + 1, nxt);
            nA = has_next ? (const char*)g.A + (size_t)nxt.pm * tstepA + (size_t)((nxt.pn & 3) * g.ahead) * 2 : cA; nB = has_next ? (const char*)g.Bt + (size_t)nxt.pn * tstepB : cB; }
        for (int t = 0; t < nt; t += 2) {
            const bool last = (t == nt - 2);
            const char* a1 = cA + (size_t)(t + 1) * kstep;
            const char* a2 = last ? nA : cA + (size_t)(t + 2) * kstep; const char* b2 = last ? nB : cB + (size_t)(t + 2) * kstep;
            const char* a3 = a2 + kstep; const char* b3 = b2 + kstep;
            PG8_LDB(B0, 0, 0); PG8_SCHED; PG8_LDA(At, 0, 0); PG8_STAGE(PG8_SA(1, 1), a1 + hstepA, voffA);
            PG8_WAIT_L(8); PG8_BAR; PG8_WAIT_L(0); PG8_MMA(0, 0, At, B0); PG8_BAR; PG8_SCHED;
            PG8_LDB(B1, 0, 1); PG8_STAGE(PG8_SB(0, 0), b2, voffB);
            PG8_BAR; PG8_WAIT_L(0); PG8_MMA(0, 1, At, B1); PG8_BAR;
            PG8_LDA(At, 0, 1); PG8_STAGE(PG8_SA(0, 0), a2, voffA);
            PG8_BAR; PG8_WAIT_L(0); PG8_MMA(1, 0, At, B0); PG8_BAR; PG8_SCHED;
            PG8_STAGE(PG8_SB(0, 1), b2 + hstepB, voffB);
            PG8_WAIT_V(6); PG8_BAR; PG8_MMA(1, 1, At, B1); PG8_BAR;
            PG8_LDB(B0, 1, 0); PG8_SCHED; PG8_LDA(At, 1, 0); PG8_STAGE(PG8_SA(0, 1), a2 + hstepA, voffA);
            PG8_WAIT_L(8); PG8_BAR; PG8_WAIT_L(0); PG8_MMA(0, 0, At, B0); PG8_BAR; PG8_SCHED;
            PG8_LDB(B1, 1, 1); PG8_STAGE(PG8_SB(1, 0), b3, voffB);
            PG8_BAR; PG8_WAIT_L(0); PG8_MMA(0, 1, At, B1); PG8_BAR;
            PG8_LDA(At, 1, 1); PG8_STAGE(PG8_SA(1, 0), a3, voffA);
            PG8_BAR; PG8_WAIT_L(0); PG8_MMA(1, 0, At, B0); PG8_BAR; PG8_SCHED;
            PG8_STAGE(PG8_SB(1, 1), b3 + hstepB, voffB);
            PG8_WAIT_V(6); PG8_BAR; PG8_MMA(1, 1, At, B1); PG8_BAR;
        }
        if constexpr (Epi::DUAL) { if (seg == 0) { E.mid(acc, cur, wr, wc, fr, fq); seg = 1; cA = nA; cB = nB; nt = g.K2 / BK; continue; } }
        E(acc, cur, wr, wc, fr, fq);
        if (Epi::DUAL) { seg = 0; nt = K / BK; }
        if (!has_next) break;
#pragma unroll
        for (int a = 0; a < 2; ++a)
#pragma unroll
            for (int b = 0; b < 2; ++b)
#pragma unroll
                for (int m = 0; m < 4; ++m)
#pragma unroll
                    for (int n = 0; n < 2; ++n) acc[a][b][m][n] = (f32x4){0.f, 0.f, 0.f, 0.f};
        cur = nxt; cA = nA; cB = nB; ++ui;
    }
    PG8_WAIT_V(0);
    if (wr == 0) PG8_BAR;
    PG8_BAR;
#undef PG8_SA
#undef PG8_SB
#undef PG8_STAGE
#undef PG8_LDA
#undef PG8_LDB
#undef PG8_MMA
#undef PG8_WAIT_V
#undef PG8_WAIT_L
#undef PG8_BAR
#undef PG8_SCHED
}

template <int ACT> struct EpiGated {
    static constexpr bool DUAL = false;
    static constexpr bool PERM = true;
    bf16_t* O; int ldo;
    __device__ __forceinline__ void operator()(const f32x4 (&acc)[2][2][4][2], const Unit& u, int wr, int wc, int fr, int fq) const {
        const int row0 = u.pm * BM + wr * 64 + fr, col0 = u.pn * 128 + wc * 32 + 8 * fq;
#pragma unroll
        for (int ai = 0; ai < 2; ++ai)
#pragma unroll
            for (int m = 0; m < 4; ++m) {
                bf16_t* rowp = O + (size_t)(row0 + ai * HALF + m * 16) * ldo + col0;
                float r[8];
#pragma unroll
                for (int n = 0; n < 2; ++n)
#pragma unroll
                    for (int j = 0; j < 4; ++j) { const float a0 = acc[ai][0][m][n][j], a1 = acc[ai][1][m][n][j]; r[n * 4 + j] = ACT == 0 ? siluf_(a0) * a1 : a0 * sigmoidf_(a1); }
                u32x4 o; o.x = cvt_pk_bf16(r[0], r[1]); o.y = cvt_pk_bf16(r[2], r[3]); o.z = cvt_pk_bf16(r[4], r[5]); o.w = cvt_pk_bf16(r[6], r[7]);
                *(u32x4*)rowp = o;
            }
    }
};
struct EpiResid {
    static constexpr bool DUAL = false;
    static constexpr bool PERM = false;
    const float* xin; float* xout; float scale;
    __device__ __forceinline__ void operator()(const f32x4 (&acc)[2][2][4][2], const Unit& u, int wr, int wc, int fr, int fq) const {
        const int row0 = u.pm * BM + wr * 64 + fr, col0 = u.pn * BM + wc * 32 + 4 * fq;
#pragma unroll
        for (int ai = 0; ai < 2; ++ai) {
            f32x4 xv[4][2][2];
#pragma unroll
            for (int m = 0; m < 4; ++m) { const size_t ro = (size_t)(row0 + ai * HALF + m * 16) * DM + col0;
#pragma unroll
                for (int bj = 0; bj < 2; ++bj)
#pragma unroll
                    for (int n = 0; n < 2; ++n) xv[m][bj][n] = *(const f32x4*)(xin + ro + bj * HALF + n * 16); }
            asm volatile("" ::: "memory");
#pragma unroll
            for (int m = 0; m < 4; ++m) { const size_t ro = (size_t)(row0 + ai * HALF + m * 16) * DM + col0;
#pragma unroll
                for (int bj = 0; bj < 2; ++bj)
#pragma unroll
                    for (int n = 0; n < 2; ++n) *(f32x4*)(xout + ro + bj * HALF + n * 16) = xv[m][bj][n] + scale * acc[ai][bj][m][n]; }
            asm volatile("" ::: "memory");
        }
    }
};
struct EpiBf16 {
    static constexpr bool DUAL = false;
    static constexpr bool PERM = true;
    bf16_t* O; bf16_t* O2; int ldo, split; float scale1;
    __device__ __forceinline__ void operator()(const f32x4 (&acc)[2][2][4][2], const Unit& u, int wr, int wc, int fr, int fq) const {
        const int row0 = u.pm * BM + wr * 64 + fr; int pn = u.pn; bf16_t* base = O; float sc = scale1;
        if (pn >= split) { pn -= split; base = O2; sc = 1.0f; }
        const int col0 = pn * BM + wc * 32 + 8 * fq;
#pragma unroll
        for (int ai = 0; ai < 2; ++ai)
#pragma unroll
            for (int m = 0; m < 4; ++m) { bf16_t* rowp = base + (size_t)(row0 + ai * HALF + m * 16) * ldo + col0;
#pragma unroll
                for (int bj = 0; bj < 2; ++bj) { const f32x4 v0 = acc[ai][bj][m][0] * sc, v1 = acc[ai][bj][m][1] * sc;
                    u32x4 o; o.x = cvt_pk_bf16(v0[0], v0[1]); o.y = cvt_pk_bf16(v0[2], v0[3]); o.z = cvt_pk_bf16(v1[0], v1[1]); o.w = cvt_pk_bf16(v1[2], v1[3]);
                    *(u32x4*)(rowp + bj * HALF) = o; } }
    }
};
template <int SECOND> struct EpiMerge {
    static constexpr bool DUAL = false;
    static constexpr bool PERM = true;
    const bf16_t* gate; float* mixacc; bf16_t* mix;
    __device__ __forceinline__ void operator()(const f32x4 (&acc)[2][2][4][2], const Unit& u, int wr, int wc, int fr, int fq) const {
        const int row0 = u.pm * BM + wr * 64 + fr, col0 = u.pn * BM + wc * 32 + 8 * fq;
#pragma unroll
        for (int ai = 0; ai < 2; ++ai)
#pragma unroll
            for (int mp = 0; mp < 2; ++mp) {
                u32x4 gv[2][2]; f32x4 pv[2][2][2];
#pragma unroll
                for (int mi = 0; mi < 2; ++mi)
#pragma unroll
                    for (int bj = 0; bj < 2; ++bj) { const size_t row = (size_t)(row0 + ai * HALF + (mp * 2 + mi) * 16); const int col = col0 + bj * HALF;
                        gv[mi][bj] = *(const u32x4*)(gate + row * NPROJ + col);
                        if (SECOND == 1) { pv[mi][bj][0] = *(const f32x4*)(mixacc + row * DM + col); pv[mi][bj][1] = *(const f32x4*)(mixacc + row * DM + col + 4); } }
                asm volatile("" ::: "memory");
#pragma unroll
                for (int mi = 0; mi < 2; ++mi)
#pragma unroll
                    for (int bj = 0; bj < 2; ++bj) { const int m = mp * 2 + mi; const size_t row = (size_t)(row0 + ai * HALF + m * 16); const int col = col0 + bj * HALF; const u32x4 g4 = gv[mi][bj];
                        float r[8];
                        r[0] = sigmoidf_(bflo(g4.x)) * acc[ai][bj][m][0][0]; r[1] = sigmoidf_(bfhi(g4.x)) * acc[ai][bj][m][0][1];
                        r[2] = sigmoidf_(bflo(g4.y)) * acc[ai][bj][m][0][2]; r[3] = sigmoidf_(bfhi(g4.y)) * acc[ai][bj][m][0][3];
                        r[4] = sigmoidf_(bflo(g4.z)) * acc[ai][bj][m][1][0]; r[5] = sigmoidf_(bfhi(g4.z)) * acc[ai][bj][m][1][1];
                        r[6] = sigmoidf_(bflo(g4.w)) * acc[ai][bj][m][1][2]; r[7] = sigmoidf_(bfhi(g4.w)) * acc[ai][bj][m][1][3];
                        if (SECOND == 0) { float* mp_ = mixacc + row * DM + col; *(f32x4*)mp_ = (f32x4){r[0], r[1], r[2], r[3]}; *(f32x4*)(mp_ + 4) = (f32x4){r[4], r[5], r[6], r[7]}; }
                        else { const f32x4 p0 = pv[mi][bj][0], p1 = pv[mi][bj][1];
                            u32x4 o; o.x = cvt_pk_bf16(r[0] + p0[0], r[1] + p0[1]); o.y = cvt_pk_bf16(r[2] + p0[2], r[3] + p0[3]); o.z = cvt_pk_bf16(r[4] + p1[0], r[5] + p1[1]); o.w = cvt_pk_bf16(r[6] + p1[2], r[7] + p1[3]);
                            *(u32x4*)(mix + row * DM + col) = o; } }
                asm volatile("" ::: "memory");
            }
    }
};
struct EpiMergeDual {
    static constexpr bool PERM = true, DUAL = true;
    const bf16_t* gate1; const bf16_t* gate2; bf16_t* mix;
    static __device__ __forceinline__ float em(float g) { return fminf(__expf(-g), 1e30f); }
    __device__ __forceinline__ void mid(f32x4 (&acc)[2][2][4][2], const Unit& u, int wr, int wc, int fr, int fq) const {
        const int row0 = u.pm * BM + wr * 64 + fr, col0 = u.pn * BM + wc * 32 + 8 * fq;
#pragma unroll
        for (int ai = 0; ai < 2; ++ai)
#pragma unroll
            for (int mp = 0; mp < 2; ++mp) {
                u32x4 g1v[2][2], g2v[2][2];
#pragma unroll
                for (int mi = 0; mi < 2; ++mi)
#pragma unroll
                    for (int bj = 0; bj < 2; ++bj) { const size_t row = (size_t)(row0 + ai * HALF + (mp * 2 + mi) * 16); const int col = col0 + bj * HALF;
                        g1v[mi][bj] = *(const u32x4*)(gate1 + row * NPROJ + col); g2v[mi][bj] = *(const u32x4*)(gate2 + row * NPROJ + col); }
#pragma unroll
                for (int mi = 0; mi < 2; ++mi)
#pragma unroll
                    for (int bj = 0; bj < 2; ++bj) { const int m = mp * 2 + mi; const u32x4 a = g1v[mi][bj], b = g2v[mi][bj];
                        const float ga[8] = {bflo(a.x), bfhi(a.x), bflo(a.y), bfhi(a.y), bflo(a.z), bfhi(a.z), bflo(a.w), bfhi(a.w)};
                        const float gb[8] = {bflo(b.x), bfhi(b.x), bflo(b.y), bfhi(b.y), bflo(b.z), bfhi(b.z), bflo(b.w), bfhi(b.w)};
#pragma unroll
                        for (int j = 0; j < 8; ++j) acc[ai][bj][m][j >> 2][j & 3] *= (1.0f + em(gb[j])) * __builtin_amdgcn_rcpf(1.0f + em(ga[j])); }
            }
    }
    __device__ __forceinline__ void operator()(const f32x4 (&acc)[2][2][4][2], const Unit& u, int wr, int wc, int fr, int fq) const {
        const int row0 = u.pm * BM + wr * 64 + fr, col0 = u.pn * BM + wc * 32 + 8 * fq;
#pragma unroll
        for (int ai = 0; ai < 2; ++ai)
#pragma unroll
            for (int mp = 0; mp < 2; ++mp) {
                u32x4 g2v[2][2];
#pragma unroll
                for (int mi = 0; mi < 2; ++mi)
#pragma unroll
                    for (int bj = 0; bj < 2; ++bj) { const size_t row = (size_t)(row0 + ai * HALF + (mp * 2 + mi) * 16); const int col = col0 + bj * HALF;
                        g2v[mi][bj] = *(const u32x4*)(gate2 + row * NPROJ + col); }
#pragma unroll
                for (int mi = 0; mi < 2; ++mi)
#pragma unroll
                    for (int bj = 0; bj < 2; ++bj) { const int m = mp * 2 + mi; const size_t row = (size_t)(row0 + ai * HALF + m * 16); const int col = col0 + bj * HALF; const u32x4 b = g2v[mi][bj];
                        const float gb[8] = {bflo(b.x), bfhi(b.x), bflo(b.y), bfhi(b.y), bflo(b.z), bfhi(b.z), bflo(b.w), bfhi(b.w)};
                        float r[8];
#pragma unroll
                        for (int j = 0; j < 8; ++j) r[j] = acc[ai][bj][m][j >> 2][j & 3] * __builtin_amdgcn_rcpf(1.0f + em(gb[j]));
                        u32x4 o; o.x = cvt_pk_bf16(r[0], r[1]); o.y = cvt_pk_bf16(r[2], r[3]); o.z = cvt_pk_bf16(r[4], r[5]); o.w = cvt_pk_bf16(r[6], r[7]);
                        *(u32x4*)(mix + row * DM + col) = o; }
            }
    }
};
}

__device__ __forceinline__ void tr_job(const float* W, int K, int ld, int c0, int NC, bf16_t* WT, int rowbase, int rs, LAS float* scr, int gw, int nw, int lane, int ldw = 0) {
    if (ldw == 0) ldw = K;
    const int nblk = NC / 32, nitems = (K / 64) * nblk;
    for (int item = gw; item < nitems; item += nw) {
        const int kb = item / nblk, nb = item % nblk, k0 = 64 * kb, n0 = 32 * nb;
        float wv[32];
#pragma unroll
        for (int i = 0; i < 32; ++i) { const int kk = 2 * i + (lane >> 5); wv[i] = W[(size_t)(k0 + kk) * ld + c0 + n0 + (lane & 31)]; }
#pragma unroll
        for (int i = 0; i < 32; ++i) { const int kk = 2 * i + (lane >> 5); scr[kk * 33 + (lane & 31)] = wv[i]; }
        WAVE_LDS_SYNC();
        const int c = lane & 7;
#pragma unroll
        for (int j = 0; j < 4; ++j) { const int n = (lane >> 3) + 8 * j; const LAS float* s = scr + (8 * c) * 33 + n;
            u32x4 o; o.x = cvt_pk_bf16(s[0 * 33], s[1 * 33]); o.y = cvt_pk_bf16(s[2 * 33], s[3 * 33]); o.z = cvt_pk_bf16(s[4 * 33], s[5 * 33]); o.w = cvt_pk_bf16(s[6 * 33], s[7 * 33]);
            const int nn = n0 + n, drow = rowbase + (nn >> 7) * rs + (nn & 127);
            *(u32x4*)(WT + (size_t)drow * ldw + k0 + 8 * c) = o; }
        WAVE_LDS_SYNC();
    }
}
__device__ __forceinline__ void convert_phase(const KP& p, int l, LAS unsigned char* lds) {
    const int tid = opaque_tid(); const int wid = tid >> 6, lane = tid & 63, nw = gridDim.x * 8;
    int gw = blockIdx.x * 8 + wid;
    LAS float* scr = (LAS float*)(lds + wid * 8448);
    unsigned char* ws = p.ws;
    const size_t ffw = (size_t)l * 1024 * 2816;
#define ROT(n) gw = (gw + (n)) % nw
    tr_job(p.in[2] + ffw, 1024, 2816, 0, 2816, (bf16_t*)(ws + W_GU1), 0, 256, scr, gw, nw, lane);
    tr_job(p.in[3] + ffw, 1024, 2816, 0, 2816, (bf16_t*)(ws + W_GU1), 128, 256, scr, gw, nw, lane);
    tr_job(p.in[4] + ffw, 2816, 1024, 0, 1024, (bf16_t*)(ws + W_D1), 0, 128, scr, gw, nw, lane);
    tr_job(p.in[6] + (size_t)l * 1024 * INC, 1024, INC, 0, 3584, (bf16_t*)(ws + W_IN), 0, 128, scr, gw, nw, lane);
    tr_job(p.in[6] + (size_t)l * 1024 * INC, 1024, INC, 3592, 2048, (bf16_t*)(ws + W_IN), 3584, 128, scr, gw, nw, lane);
    tr_job(p.in[28] + ffw, 1024, 2816, 0, 2816, (bf16_t*)(ws + W_GU2), 0, 256, scr, gw, nw, lane);
    tr_job(p.in[29] + ffw, 1024, 2816, 0, 2816, (bf16_t*)(ws + W_GU2), 128, 256, scr, gw, nw, lane);
    tr_job(p.in[30] + ffw, 2816, 1024, 0, 1024, (bf16_t*)(ws + W_D2), 0, 128, scr, gw, nw, lane);
    ROT(768);
    tr_job(p.in[16] + (size_t)l * 512 * 512, 512, 512, 0, 512, (bf16_t*)(ws + W_GLU), 0, 256, scr, gw, nw, lane);
    ROT(128);
    tr_job(p.in[17] + (size_t)l * 512 * 512, 512, 512, 0, 512, (bf16_t*)(ws + W_GLU), 128, 256, scr, gw, nw, lane);
    ROT(128);
    tr_job(p.in[24] + (size_t)l * 512 * 1024, 512, 1024, 0, 1024, (bf16_t*)(ws + W_BS5), 0, 128, scr, gw, nw, lane, 1024);
    ROT(256);
    tr_job(p.in[25] + (size_t)l * 1024 * 1024, 1024, 1024, 0, 1024, (bf16_t*)(ws + W_BML), 0, 128, scr, gw, nw, lane);
    ROT(512);
    tr_job(p.in[26] + (size_t)l * 1024 * 1024, 1024, 1024, 0, 1024, (bf16_t*)(ws + W_OUT), 0, 128, scr, gw, nw, lane);
    ROT(512);
    for (int h = 0; h < 4; ++h) {
        tr_job(p.in[20] + ((size_t)l * 4 + h) * 65536, 256, 256, 0, 256, (bf16_t*)(ws + W_QK), h * 256, 128, scr, gw, nw, lane);
        ROT(32);
        tr_job(p.in[21] + ((size_t)l * 4 + h) * 65536, 256, 256, 0, 256, (bf16_t*)(ws + W_QK), 1024 + h * 256, 128, scr, gw, nw, lane);
        ROT(32);
    }
#undef ROT
}

template <bool WITH_IF>
__device__ __forceinline__ void rmsnorm_phase(const float* x, const float* gain, bf16_t* xn, const float* win_l, const float* bif, float* ifbuf, LAS unsigned char* lds) {
    const int tid = opaque_tid(); const int wid = tid >> 6, lane = tid & 63;
    LAS float* ifw = (LAS float*)lds;
    if (WITH_IF) {
        for (int k = tid; k < 1024; k += 512) { const f32x4 a = *(const f32x4*)(win_l + (size_t)k * INC + 3584), b = *(const f32x4*)(win_l + (size_t)k * INC + 3588);
            *(LAS f32x4*)(ifw + k * 8) = a; *(LAS f32x4*)(ifw + k * 8 + 4) = b; }
        __syncthreads();
    }
    f32x4 gv[4];
#pragma unroll
    for (int i = 0; i < 4; ++i) gv[i] = *(const f32x4*)(gain + 4 * (lane + 64 * i));
    const int nw = gridDim.x * 8;
    constexpr int RPT = WITH_IF ? 4 : 8;
    for (int row0 = blockIdx.x * 8 + wid; row0 < MTOK; row0 += RPT * nw) {
        f32x4 v[RPT][4];
#pragma unroll
        for (int q = 0; q < RPT; ++q) { const int row = (row0 + q * nw < MTOK) ? row0 + q * nw : row0;
#pragma unroll
            for (int i = 0; i < 4; ++i) v[q][i] = *(const f32x4*)(x + (size_t)row * DM + 4 * (lane + 64 * i)); }
        asm volatile("" ::: "memory");
#pragma unroll
        for (int q = 0; q < RPT; ++q) { const int row = row0 + q * nw;
            float ss = 0.f;
#pragma unroll
            for (int i = 0; i < 4; ++i) ss += (v[q][i].x * v[q][i].x + v[q][i].y * v[q][i].y) + (v[q][i].z * v[q][i].z + v[q][i].w * v[q][i].w);
            ss = wave_sum(ss);
            const float r = rsqrtf(ss * (1.0f / DM) + EPS);
            float ga[8];
            if (WITH_IF) {
#pragma unroll
                for (int j = 0; j < 8; ++j) ga[j] = 0.f;
            }
            if (row < MTOK) {
#pragma unroll
                for (int i = 0; i < 4; ++i) { const f32x4 y = v[q][i] * r * gv[i];
                    u32x2 o; o.x = cvt_pk_bf16(y.x, y.y); o.y = cvt_pk_bf16(y.z, y.w);
                    *(u32x2*)(xn + (size_t)row * DM + 4 * (lane + 64 * i)) = o;
                    if (WITH_IF) {
#pragma unroll
                        for (int e = 0; e < 4; ++e) { const int k = 4 * (lane + 64 * i) + e; const f32x4 a = *(LAS f32x4*)(ifw + k * 8), b = *(LAS f32x4*)(ifw + k * 8 + 4); const float xv = y[e];
                            ga[0] += xv * a.x; ga[1] += xv * a.y; ga[2] += xv * a.z; ga[3] += xv * a.w; ga[4] += xv * b.x; ga[5] += xv * b.y; ga[6] += xv * b.z; ga[7] += xv * b.w; }
                        asm volatile("" ::: "memory");
                    }
                }
                if (WITH_IF) {
#pragma unroll
                    for (int j = 0; j < 8; ++j) ga[j] = wave_sum(ga[j]);
                    if (lane == 0) { *(f32x4*)(ifbuf + (size_t)row * 8) = (f32x4){ga[0] + bif[0], ga[1] + bif[1], ga[2] + bif[2], ga[3] + bif[3]};
                        *(f32x4*)(ifbuf + (size_t)row * 8 + 4) = (f32x4){ga[4] + bif[4], ga[5] + bif[5], ga[6] + bif[6], ga[7] + bif[7]}; }
                }
            }
        }
    }
}
__device__ __forceinline__ void final_norm_phase(float* x, const float* gain) {
    const int tid = opaque_tid(); const int wid = tid >> 6, lane = tid & 63;
    f32x4 gv[4];
#pragma unroll
    for (int i = 0; i < 4; ++i) gv[i] = *(const f32x4*)(gain + 4 * (lane + 64 * i));
    for (int row = blockIdx.x * 8 + wid; row < MTOK; row += gridDim.x * 8) {
        float* xr = x + (size_t)row * DM;
        f32x4 v[4]; float ss = 0.f;
#pragma unroll
        for (int i = 0; i < 4; ++i) { v[i] = *(const f32x4*)(xr + 4 * (lane + 64 * i)); ss += (v[i].x * v[i].x + v[i].y * v[i].y) + (v[i].z * v[i].z + v[i].w * v[i].w); }
        ss = wave_sum(ss);
        const float r = rsqrtf(ss * (1.0f / DM) + EPS);
#pragma unroll
        for (int i = 0; i < 4; ++i) *(f32x4*)(xr + 4 * (lane + 64 * i)) = v[i] * r * gv[i];
    }
}

__device__ __forceinline__ void conv_phase(const KP& p, int l) {
    const bf16_t* proj = (const bf16_t*)(p.ws + O_BIG); bf16_t* xc = (bf16_t*)(p.ws + O_XC);
    const int gt = blockIdx.x * 512 + opaque_tid(), c8 = gt & 127;
    const float* cw = p.in[18] + (size_t)l * 4 * 1024 + c8 * 8; const float* cb = p.in[19] + (size_t)l * 1024 + c8 * 8;
    float w[4][8], bias[8];
#pragma unroll
    for (int j = 0; j < 4; ++j) { const f32x4 a = *(const f32x4*)(cw + j * 1024), b = *(const f32x4*)(cw + j * 1024 + 4); w[j][0] = a.x; w[j][1] = a.y; w[j][2] = a.z; w[j][3] = a.w; w[j][4] = b.x; w[j][5] = b.y; w[j][6] = b.z; w[j][7] = b.w; }
    { const f32x4 a = *(const f32x4*)cb, b = *(const f32x4*)(cb + 4); bias[0] = a.x; bias[1] = a.y; bias[2] = a.z; bias[3] = a.w; bias[4] = b.x; bias[5] = b.y; bias[6] = b.z; bias[7] = b.w; }
    const int nthr = gridDim.x * 512;
    for (int idx0 = gt; idx0 < MTOK * 128; idx0 += 4 * nthr) {
        u32x4 v[4][4];
#pragma unroll
        for (int q = 0; q < 4; ++q) { const int idx = idx0 + q * nthr; const int t = idx >> 7, pos = t & (SEQ - 1);
#pragma unroll
            for (int j = 0; j < 4; ++j) { v[q][j] = (u32x4){0u, 0u, 0u, 0u}; if (idx < MTOK * 128 && pos - 3 + j >= 0) v[q][j] = *(const u32x4*)(proj + (size_t)(t - 3 + j) * NPROJ + 512 + c8 * 8); } }
        asm volatile("" ::: "memory");
#pragma unroll
        for (int q = 0; q < 4; ++q) { const int idx = idx0 + q * nthr; const int t = idx >> 7;
            float y[8];
#pragma unroll
            for (int e = 0; e < 8; ++e) y[e] = bias[e];
#pragma unroll
            for (int j = 0; j < 4; ++j) { const u32x4 vv = v[q][j];
                y[0] += w[j][0] * bflo(vv.x); y[1] += w[j][1] * bfhi(vv.x); y[2] += w[j][2] * bflo(vv.y); y[3] += w[j][3] * bfhi(vv.y);
                y[4] += w[j][4] * bflo(vv.z); y[5] += w[j][5] * bfhi(vv.z); y[6] += w[j][6] * bflo(vv.w); y[7] += w[j][7] * bfhi(vv.w); }
            u32x4 o; o.x = cvt_pk_bf16(siluf_(y[0]), siluf_(y[1])); o.y = cvt_pk_bf16(siluf_(y[2]), siluf_(y[3])); o.z = cvt_pk_bf16(siluf_(y[4]), siluf_(y[5])); o.w = cvt_pk_bf16(siluf_(y[6]), siluf_(y[7]));
            if (idx < MTOK * 128) *(u32x4*)(xc + (size_t)t * DM + c8 * 8) = o; }
    }
}

__device__ __forceinline__ void conv_slice(const KP& p, int l, int pm, int head) {
    const bf16_t* proj = (const bf16_t*)(p.ws + O_BIG); bf16_t* xc = (bf16_t*)(p.ws + O_XC);
    const int tid = opaque_tid(); const int c8 = head * 32 + (tid & 31), rsub = tid >> 5;
    const float* cw = p.in[18] + (size_t)l * 4 * 1024 + c8 * 8; const float* cb = p.in[19] + (size_t)l * 1024 + c8 * 8;
    float w[4][8], bias[8];
#pragma unroll
    for (int j = 0; j < 4; ++j) { const f32x4 a = *(const f32x4*)(cw + j * 1024), b = *(const f32x4*)(cw + j * 1024 + 4); w[j][0] = a.x; w[j][1] = a.y; w[j][2] = a.z; w[j][3] = a.w; w[j][4] = b.x; w[j][5] = b.y; w[j][6] = b.z; w[j][7] = b.w; }
    { const f32x4 a = *(const f32x4*)cb, b = *(const f32x4*)(cb + 4); bias[0] = a.x; bias[1] = a.y; bias[2] = a.z; bias[3] = a.w; bias[4] = b.x; bias[5] = b.y; bias[6] = b.z; bias[7] = b.w; }
    for (int j0 = 0; j0 < 16; j0 += 4) {
        u32x4 v[4][4];
#pragma unroll
        for (int q = 0; q < 4; ++q) { const int t = pm * 256 + rsub + 16 * (j0 + q), pos = t & (SEQ - 1);
#pragma unroll
            for (int j = 0; j < 4; ++j) { v[q][j] = (u32x4){0u, 0u, 0u, 0u}; if (pos - 3 + j >= 0) v[q][j] = *(const u32x4*)(proj + (size_t)(t - 3 + j) * NPROJ + 512 + c8 * 8); } }
        asm volatile("" ::: "memory");
#pragma unroll
        for (int q = 0; q < 4; ++q) { const int t = pm * 256 + rsub + 16 * (j0 + q);
            float y[8];
#pragma unroll
            for (int e = 0; e < 8; ++e) y[e] = bias[e];
#pragma unroll
            for (int j = 0; j < 4; ++j) { const u32x4 vv = v[q][j];
                y[0] += w[j][0] * bflo(vv.x); y[1] += w[j][1] * bfhi(vv.x); y[2] += w[j][2] * bflo(vv.y); y[3] += w[j][3] * bfhi(vv.y);
                y[4] += w[j][4] * bflo(vv.z); y[5] += w[j][5] * bfhi(vv.z); y[6] += w[j][6] * bflo(vv.w); y[7] += w[j][7] * bfhi(vv.w); }
            u32x4 o; o.x = cvt_pk_bf16(siluf_(y[0]), siluf_(y[1])); o.y = cvt_pk_bf16(siluf_(y[2]), siluf_(y[3])); o.z = cvt_pk_bf16(siluf_(y[4]), siluf_(y[5])); o.w = cvt_pk_bf16(siluf_(y[6]), siluf_(y[7]));
            *(u32x4*)(xc + (size_t)t * DM + c8 * 8) = o; }
    }
}

template <bool PASSC>
__device__ __forceinline__ void s5_phase(const KP& p, int l, LAS unsigned char* lds) {
    const int tid = opaque_tid(); const int wid = tid >> 6, lane = tid & 63, fr = lane & 15, fq = lane >> 4;
    LAS float* buS = (LAS float*)(lds + wid * 12800);
    LAS unsigned char* sS = lds + wid * 12800 + 8448;
    const bf16_t* proj = (const bf16_t*)(p.ws + O_BIG); bf16_t* z = (bf16_t*)(p.ws + O_Z);
    f32x2* s5end = (f32x2*)(p.ws + O_S5END);
    for (int task = blockIdx.x * 8 + wid; task < 2048; task += gridDim.x * 8) {
        const int seq = task >> 5, c = task & 31, b = seq >> 5, g = seq & 31, n = lane, lg = l * 32 + g;
        const float dt = expf(p.in[10][lg]);
        float ar, ai;
        { const float lr = fminf(p.in[8][lg * 64 + n], -1e-4f), li = p.in[9][lg * 64 + n];
          const float mag = expf(lr * dt); float sn, cs; sincos_acc(li * dt, sn, cs); ar = mag * cs; ai = mag * sn; }
        bf16x8 bx[8];
#pragma unroll
        for (int q4 = 0; q4 < 4; ++q4) { const int n2 = q4 * 16 + fr;
            const float lr = fminf(p.in[8][lg * 64 + n2], -1e-4f), li = p.in[9][lg * 64 + n2];
            const float mag = expf(lr * dt); float sn, cs; sincos_acc(li * dt, sn, cs);
            const float a_r = mag * cs, a_i = mag * sn, den = lr * lr + li * li;
            float qr = ((a_r - 1.0f) * lr + a_i * li) / den, qi = (a_i * lr - (a_r - 1.0f) * li) / den;
            if (fq >= 2) { qr = 0.f; qi = 0.f; }
            const float* brp = p.in[11] + (size_t)(lg * 64 + n2) * 16 + (fq & 1) * 8; const float* bip = p.in[12] + (size_t)(lg * 64 + n2) * 16 + (fq & 1) * 8;
            const f32x4 br0 = *(const f32x4*)brp, br1 = *(const f32x4*)(brp + 4), bi0 = *(const f32x4*)bip, bi1 = *(const f32x4*)(bip + 4);
            const f32x4 re0 = qr * br0 - qi * bi0, re1 = qr * br1 - qi * bi1, im0 = qr * bi0 + qi * br0, im1 = qr * bi1 + qi * br1;
            u32x4 o; o.x = cvt_pk_bf16(re0.x, re0.y); o.y = cvt_pk_bf16(re0.z, re0.w); o.z = cvt_pk_bf16(re1.x, re1.y); o.w = cvt_pk_bf16(re1.z, re1.w);
            bx[q4] = __builtin_bit_cast(bf16x8, o);
            o.x = cvt_pk_bf16(im0.x, im0.y); o.y = cvt_pk_bf16(im0.z, im0.w); o.z = cvt_pk_bf16(im1.x, im1.y); o.w = cvt_pk_bf16(im1.z, im1.w);
            bx[4 + q4] = __builtin_bit_cast(bf16x8, o); }
        float sr = 0.f, si = 0.f;
        bf16x8 cm[4]; f32x4 d4 = (f32x4){0.f, 0.f, 0.f, 0.f};
        if (PASSC) {
            float xr = ar, xi = ai;
#pragma unroll
            for (int q = 0; q < 8; ++q) { const float t0 = xr * xr - xi * xi, t1 = 2.0f * xr * xi; xr = t0; xi = t1; }
            for (int c0 = 0; c0 < c; c0 += 16) {
                f32x2 ev[16];
#pragma unroll
                for (int j = 0; j < 16; ++j) { const int cc = (c0 + j < c) ? c0 + j : c - 1; ev[j] = s5end[(size_t)(seq * 32 + cc) * 64 + n]; }
#pragma unroll
                for (int j = 0; j < 16; ++j) { const bool on = c0 + j < c; const float t0 = sr * xr - si * xi + ev[j].x, t1 = sr * xi + si * xr + ev[j].y; sr = on ? t0 : sr; si = on ? t1 : si; }
            }
#pragma unroll
            for (int kb = 0; kb < 4; ++kb) { const float* src = (kb < 2 ? p.in[13] : p.in[14]) + (size_t)(lg * 16 + fr) * 64 + (kb & 1) * 32 + fq * 8;
                const f32x4 a = *(const f32x4*)src, bq = *(const f32x4*)(src + 4); const float sg = kb < 2 ? 1.0f : -1.0f;
                u32x4 o; o.x = cvt_pk_bf16(sg * a.x, sg * a.y); o.y = cvt_pk_bf16(sg * a.z, sg * a.w); o.z = cvt_pk_bf16(sg * bq.x, sg * bq.y); o.w = cvt_pk_bf16(sg * bq.z, sg * bq.w);
                cm[kb] = __builtin_bit_cast(bf16x8, o); }
            d4 = *(const f32x4*)(p.in[15] + (size_t)l * 512 + g * 16 + fq * 4);
        }
        const int tok0 = b * SEQ + c * 256;
        const bf16_t* urow0 = proj + (size_t)(tok0 + fr) * NPROJ + g * 16;
        u32x4 unext = *(const u32x4*)(urow0 + (fq & 1) * 8); u32x2 u4next = *(const u32x2*)(urow0 + fq * 4);
        for (int sub = 0; sub < 16; ++sub) {
            u32x4 uraw = unext; const u32x2 u4 = u4next;
            if (sub < 15) { const bf16_t* urow = urow0 + (size_t)(sub + 1) * 16 * NPROJ; unext = *(const u32x4*)(urow + (fq & 1) * 8); u4next = *(const u32x2*)(urow + fq * 4); }
            if (fq >= 2) uraw = (u32x4){0u, 0u, 0u, 0u};
            const bf16x8 yu = __builtin_bit_cast(bf16x8, uraw);
#pragma unroll
            for (int kb = 0; kb < 8; ++kb) { const f32x4 acc = __builtin_amdgcn_mfma_f32_16x16x32_bf16(bx[kb], yu, (f32x4){0.f, 0.f, 0.f, 0.f}, 0, 0, 0);
                *(LAS f32x4*)(buS + fr * 132 + kb * 16 + fq * 4) = acc; }
            WAVE_LDS_SYNC();
            float burv[16], buiv[16];
#pragma unroll
            for (int tt = 0; tt < 16; ++tt) { burv[tt] = buS[tt * 132 + n]; buiv[tt] = buS[tt * 132 + 64 + n]; }
#pragma unroll
            for (int tt = 0; tt < 16; ++tt) {
                const float bur = burv[tt], bui = buiv[tt];
                const float t0 = ar * sr - ai * si + bur, t1 = ar * si + ai * sr + bui; sr = t0; si = t1;
                if (PASSC) { const unsigned pk = cvt_pk_bf16(sr, si); *(LAS unsigned short*)(sS + tt * 272 + n * 2) = (unsigned short)(pk & 0xffffu); *(LAS unsigned short*)(sS + tt * 272 + 128 + n * 2) = (unsigned short)(pk >> 16); }
            }
            if (PASSC) {
                WAVE_LDS_SYNC();
                f32x4 acc = (f32x4){0.f, 0.f, 0.f, 0.f};
#pragma unroll
                for (int kb = 0; kb < 4; ++kb) { const bf16x8 yf = *(LAS bf16x8*)(sS + fr * 272 + (kb * 32 + fq * 8) * 2); acc = __builtin_amdgcn_mfma_f32_16x16x32_bf16(cm[kb], yf, acc, 0, 0, 0); }
                const f32x4 uv = (f32x4){bflo(u4.x), bfhi(u4.x), bflo(u4.y), bfhi(u4.y)};
                const f32x4 y = acc + d4 * uv;
                u32x2 o; o.x = cvt_pk_bf16(gelu_tanh(y.x), gelu_tanh(y.y)); o.y = cvt_pk_bf16(gelu_tanh(y.z), gelu_tanh(y.w));
                *(u32x2*)(z + (size_t)(tok0 + sub * 16 + fr) * 512 + g * 16 + fq * 4) = o;
            }
            WAVE_LDS_SYNC();
        }
        if (!PASSC) s5end[(size_t)(seq * 32 + c) * 64 + n] = (f32x2){sr, si};
    }
}

__device__ __forceinline__ float scan_sum128(float v, int tid, LAS float* tmp) {
    const int lane = tid & 63; float x = v;
#pragma unroll
    for (int o = 1; o < 64; o <<= 1) { const float y = __shfl_up(x, o); if (lane >= o) x += y; }
    if (tid == 63) tmp[0] = x;
    __syncthreads();
    if (tid >= 64 && tid < 128) x += tmp[0];
    return x;
}
__device__ __forceinline__ float scan_max128(float v, int tid, LAS float* tmp) {
    const int lane = tid & 63; float x = v;
#pragma unroll
    for (int o = 1; o < 64; o <<= 1) { const float y = __shfl_up(x, o); if (lane >= o) x = fmaxf(x, y); }
    if (tid == 63) tmp[1] = x;
    __syncthreads();
    if (tid >= 64 && tid < 128) x = fmaxf(x, tmp[1]);
    return x;
}
__device__ __forceinline__ bf16x8 tr_frag(LAS unsigned char* a0, int second_off) {
    const s16x4 lo = __builtin_amdgcn_ds_read_tr16_b64_v4i16((LAS s16x4*)a0);
    const s16x4 hi = __builtin_amdgcn_ds_read_tr16_b64_v4i16((LAS s16x4*)(a0 + second_off));
    return __builtin_shufflevector(lo, hi, 0, 1, 2, 3, 4, 5, 6, 7);
}
template <bool OWN> __device__ __forceinline__ void mlstm_s1_phase(const KP& p, LAS unsigned char* lds) {
    const int tid = opaque_tid(), wid = tid >> 6, lane = tid & 63, fr = lane & 15, fq = lane >> 4;
    const bf16_t* proj = (const bf16_t*)(p.ws + O_BIG); const bf16_t* kbuf = (const bf16_t*)(p.ws + O_K);
    const float* ifb = (const float*)(p.ws + O_IF); bf16_t* cst = (bf16_t*)(p.ws + O_CST);
    float* gout = (float*)(p.ws + O_G); float* mlout = (float*)(p.ws + O_MLOC); float* nloc = (float*)(p.ws + O_NLOC);
    LAS unsigned char* Ks = lds; LAS unsigned char* Vs = lds + 69632;
    LAS float* vlf = (LAS float*)(lds + VEC_OFF); LAS float* vi = vlf + 128; LAS float* vb = vlf + 256; LAS float* vdec = vlf + 384;
    const int own_pm = (int)blockIdx.x >> 2, own_bhc0 = (((own_pm >> 5) * 4 + ((int)blockIdx.x & 3)) * 64) + (own_pm & 31) * 2;
    for (int tk = OWN ? 0 : (int)blockIdx.x; tk < (OWN ? 4 : 1024); tk += OWN ? 1 : (int)gridDim.x) {
        const int task = OWN ? (((own_bhc0 + (tk >> 1)) << 1) | (tk & 1)) : tk;
        const int eh = task & 1, bhc = task >> 1, c = bhc & 63, bh = bhc >> 6, h = bh & 3, b = bh >> 2;
        const int tok0 = b * SEQ + c * 128;
        const bool newk = !OWN || eh == 0;
        u32x4 kv[8], vv[4];
        if (newk) {
#pragma unroll
            for (int it = 0; it < 8; ++it) { const int id = it * 512 + tid, s = id >> 5, ch = id & 31; kv[it] = *(const u32x4*)(kbuf + (unsigned)(tok0 + s) * DM + h * 256 + ch * 8); }
        }
#pragma unroll
        for (int it = 0; it < 4; ++it) { const int id = it * 512 + tid, s = id >> 4, ch = id & 15; vv[it] = *(const u32x4*)(proj + (unsigned)(tok0 + s) * NPROJ + 1536 + h * 256 + eh * 128 + ch * 8); }
        LAS float* tmp = vlf;
        float gg = 0.f, mloc = 0.f;
        if (newk) {
        float gi = 0.f, glf = 0.f;
        if (tid < 128) { gi = ifb[(size_t)(tok0 + tid) * 8 + h]; glf = logsigmoidf_(ifb[(size_t)(tok0 + tid) * 8 + 4 + h]); }
        const float bsum = scan_sum128(glf, tid, tmp);
        if (tid == 127) tmp[2] = bsum;
        __syncthreads();
        gg = tmp[2];
        float dec = -INFINITY;
        if (tid < 128) { dec = gg - bsum + gi; vdec[tid] = dec; }
        { float x = dec;
#pragma unroll
          for (int o = 1; o < 64; o <<= 1) x = fmaxf(x, __shfl_xor(x, o));
          if (lane == 0 && wid < 2) tmp[4 + wid] = x; }
        __syncthreads();
        mloc = fmaxf(tmp[4], tmp[5]);
        asm volatile("" ::: "memory");
#pragma unroll
        for (int it = 0; it < 8; ++it) { const int id = it * 512 + tid, s = id >> 5, ch = id & 31;
            const u32x4 v = kv[it]; const float w = __expf(vdec[s] - mloc);
            u32x4 o; o.x = cvt_pk_bf16(bflo(v.x) * w, bfhi(v.x) * w); o.y = cvt_pk_bf16(bflo(v.y) * w, bfhi(v.y) * w); o.z = cvt_pk_bf16(bflo(v.z) * w, bfhi(v.z) * w); o.w = cvt_pk_bf16(bflo(v.w) * w, bfhi(v.w) * w);
            *(LAS u32x4*)(Ks + s * 544 + ch * 16) = o; }
        }
#pragma unroll
        for (int it = 0; it < 4; ++it) { const int id = it * 512 + tid, s = id >> 4, ch = id & 15;
            *(LAS u32x4*)(Vs + s * 288 + ch * 16) = vv[it]; }
        __syncthreads();
        f32x4 acc[2][8];
#pragma unroll
        for (int a = 0; a < 2; ++a)
#pragma unroll
            for (int e = 0; e < 8; ++e) acc[a][e] = (f32x4){0.f, 0.f, 0.f, 0.f};
#pragma unroll
        for (int kb = 0; kb < 4; ++kb) {
            bf16x8 X[2];
#pragma unroll
            for (int db = 0; db < 2; ++db) X[db] = tr_frag(Ks + (kb * 32 + fq * 4 + (fr >> 2)) * 544 + (32 * wid + db * 16 + (fr & 3) * 4) * 2, 16 * 544);
#pragma unroll
            for (int eb = 0; eb < 8; ++eb) { const bf16x8 Y = tr_frag(Vs + (kb * 32 + fq * 4 + (fr >> 2)) * 288 + (eb * 16 + (fr & 3) * 4) * 2, 16 * 288);
#pragma unroll
                for (int db = 0; db < 2; ++db) acc[db][eb] = __builtin_amdgcn_mfma_f32_16x16x32_bf16(X[db], Y, acc[db][eb], 0, 0, 0); }
        }
#pragma unroll
        for (int db = 0; db < 2; ++db)
#pragma unroll
            for (int eb = 0; eb < 8; ++eb) { u32x2 o; o.x = cvt_pk_bf16(acc[db][eb][0], acc[db][eb][1]); o.y = cvt_pk_bf16(acc[db][eb][2], acc[db][eb][3]);
                *(u32x2*)(cst + (size_t)bhc * 65536 + (size_t)(eh * 128 + eb * 16 + fr) * 256 + 32 * wid + db * 16 + fq * 4) = o; }
        if (eh == 0) {
            if (tid < 256) { float sn = 0.f;
                for (int s0 = 0; s0 < 128; s0 += 16) { unsigned short tv[16];
#pragma unroll
                    for (int j = 0; j < 16; ++j) tv[j] = *(LAS unsigned short*)(Ks + (s0 + j) * 544 + tid * 2);
#pragma unroll
                    for (int j = 0; j < 16; ++j) sn += bflo((unsigned)tv[j]); }
                nloc[(size_t)bhc * 256 + tid] = sn; }
            if (tid == 0) { gout[bhc] = gg; mlout[bhc] = mloc; }
        }
        __syncthreads();
    }
}
__device__ __forceinline__ void mlstm_s2_phase(const KP& p) {
    const int tid = opaque_tid();
    bf16_t* cst = (bf16_t*)(p.ws + O_CST);
    const float* gin = (const float*)(p.ws + O_G); const float* mlin = (const float*)(p.ws + O_MLOC); float* mst = (float*)(p.ws + O_MST);
    const float* nloc = (const float*)(p.ws + O_NLOC); float* nst = (float*)(p.ws + O_NST);
    for (int slot = blockIdx.x; slot < 256; slot += gridDim.x) {
        const int bh = slot >> 5, part = slot & 31; const size_t e0 = (size_t)(part * 512 + tid) * 4;
        float m = 0.f, C0 = 0.f, C1 = 0.f, C2 = 0.f, C3 = 0.f, nv = 0.f;
        const bool do_n = (part == 0) && (tid < 256);
        for (int c8 = 0; c8 < 64; c8 += 8) {
            u32x2 loc[8]; float nl[8];
#pragma unroll
            for (int j = 0; j < 8; ++j) { loc[j] = *(const u32x2*)(cst + (size_t)(bh * 64 + c8 + j) * 65536 + e0); nl[j] = do_n ? nloc[(size_t)(bh * 64 + c8 + j) * 256 + tid] : 0.f; }
#pragma unroll
            for (int j = 0; j < 8; ++j) { const int idx = bh * 64 + c8 + j;
                const float g = gin[idx], ml = mlin[idx]; const float mnew = fmaxf(g + m, ml); const float wo = __expf(g + m - mnew), wl = __expf(ml - mnew);
                u32x2 o; o.x = cvt_pk_bf16(C0, C1); o.y = cvt_pk_bf16(C2, C3);
                *(u32x2*)(cst + (size_t)idx * 65536 + e0) = o;
                C0 = wo * C0 + wl * bflo(loc[j].x); C1 = wo * C1 + wl * bfhi(loc[j].x); C2 = wo * C2 + wl * bflo(loc[j].y); C3 = wo * C3 + wl * bfhi(loc[j].y);
                if (do_n) { nst[(size_t)idx * 256 + tid] = nv; nv = wo * nv + wl * nl[j]; if (tid == 0) mst[idx] = m; }
                m = mnew; }
        }
    }
}
__device__ __forceinline__ void mlstm_s3_phase(const KP& p, int l, LAS unsigned char* lds) {
    const int tid = opaque_tid(), wid = tid >> 6, lane = tid & 63, fr = lane & 15, fq = lane >> 4;
    const bf16_t* proj = (const bf16_t*)(p.ws + O_BIG); const bf16_t* qbuf = (const bf16_t*)(p.ws + O_Q); const bf16_t* kbuf = (const bf16_t*)(p.ws + O_K);
    const bf16_t* xc = (const bf16_t*)(p.ws + O_XC); const float* ifb = (const float*)(p.ws + O_IF); const bf16_t* cst = (const bf16_t*)(p.ws + O_CST);
    const float* mst = (const float*)(p.ws + O_MST); const float* nst = (const float*)(p.ws + O_NST); bf16_t* yml = (bf16_t*)(p.ws + O_XN);
    const float* normg = p.in[22] + (unsigned)l * 1024; const float* skipg = p.in[23] + (unsigned)l * 1024;
    LAS unsigned char* Vh = lds;
    LAS unsigned char* Qs = lds + 36864;
    LAS unsigned char* Kt = lds + 55296;
    LAS unsigned char* CTs = lds + 73728;
    LAS unsigned char* Ss = lds + 92160;
    LAS float* vlf = (LAS float*)(lds + VEC_OFF); LAS float* va = vlf + 128; LAS float* vb = vlf + 256; LAS float* vM = vlf + 384; LAS float* nvec = vlf + 512;
    for (int task = blockIdx.x; task < 512; task += gridDim.x) {
        const int bhc = task, c = bhc & 63, bh = bhc >> 6, h = bh & 3, b = bh >> 2;
        const int tok0 = b * SEQ + c * 128;
        const float m0 = mst[bhc];
        float gi = 0.f, glf = 0.f;
        if (tid < 128) { gi = ifb[(unsigned)(tok0 + tid) * 8 + h]; glf = logsigmoidf_(ifb[(unsigned)(tok0 + tid) * 8 + 4 + h]); }
        if (tid < 256) nvec[tid] = nst[(unsigned)bhc * 256 + tid];
        const float bs = scan_sum128(glf, tid, vlf);
        const float av = (tid < 128) ? gi - bs : -INFINITY;
        const float mm = scan_max128(av, tid, vlf);
        if (tid < 128) { vb[tid] = bs; va[tid] = av; vM[tid] = fmaxf(m0, mm); }
        const int t = 16 * wid + fr;
        const unsigned tok = (unsigned)(tok0 + t);
        u32x2 hc0[8];
        float qn = 0.f, ss = 0.f, inv = 0.f, winter = 0.f;
#pragma unroll
        for (int eh = 0; eh < 2; ++eh) {
            f32x4 accS[8], accO[8];
#pragma unroll
            for (int i = 0; i < 8; ++i) { accS[i] = (f32x4){0.f, 0.f, 0.f, 0.f}; accO[i] = (f32x4){0.f, 0.f, 0.f, 0.f}; }
            u32x4 pq[2], pk[2], pc[2];
#define S3_LOAD(DB) do { _Pragma("unroll") for (int it = 0; it < 2; ++it) { const int id = it * 512 + tid, row = id >> 3, ch = id & 7; \
                    pq[it] = *(const u32x4*)(qbuf + (unsigned)(tok0 + row) * DM + h * 256 + (DB) * 64 + ch * 8); \
                    if (eh == 0) pk[it] = *(const u32x4*)(kbuf + (unsigned)(tok0 + row) * DM + h * 256 + (DB) * 64 + ch * 8); \
                    pc[it] = *(const u32x4*)(cst + (unsigned)bhc * 65536 + (unsigned)(eh * 128 + row) * 256 + (DB) * 64 + ch * 8); } } while (0)
            S3_LOAD(0);
            for (int db4 = 0; db4 < 4; ++db4) {
                __syncthreads();
#pragma unroll
                for (int it = 0; it < 2; ++it) { const int id = it * 512 + tid, row = id >> 3, ch = id & 7;
                    *(LAS u32x4*)(Qs + row * 144 + ch * 16) = pq[it];
                    if (eh == 0) *(LAS u32x4*)(Kt + row * 144 + ch * 16) = pk[it];
                    *(LAS u32x4*)(CTs + row * 144 + ch * 16) = pc[it]; }
                if (db4 < 3) S3_LOAD(db4 + 1);
                __syncthreads();
#pragma unroll
                for (int kk = 0; kk < 2; ++kk) {
                    const bf16x8 Qf = *(LAS bf16x8*)(Qs + (16 * wid + fr) * 144 + (kk * 32 + fq * 8) * 2);
                    if (eh == 0) {
                        const u32x4 qu = __builtin_bit_cast(u32x4, Qf); const LAS float* nvp = nvec + db4 * 64 + kk * 32 + fq * 8; const f32x4 n0 = *(LAS f32x4*)nvp, n1 = *(LAS f32x4*)(nvp + 4);
                        qn += bflo(qu.x) * n0.x + bfhi(qu.x) * n0.y + bflo(qu.y) * n0.z + bfhi(qu.y) * n0.w + bflo(qu.z) * n1.x + bfhi(qu.z) * n1.y + bflo(qu.w) * n1.z + bfhi(qu.w) * n1.w;
#pragma unroll
                        for (int sb = 0; sb < 8; ++sb) { if (sb <= wid) { const bf16x8 Kf = *(LAS bf16x8*)(Kt + (sb * 16 + fr) * 144 + (kk * 32 + fq * 8) * 2); accS[sb] = __builtin_amdgcn_mfma_f32_16x16x32_bf16(Kf, Qf, accS[sb], 0, 0, 0); } if ((sb & 3) == 3) { asm volatile("" ::: "memory"); __builtin_amdgcn_sched_barrier(0); } }
                    }
#pragma unroll
                    for (int eb = 0; eb < 8; ++eb) { const bf16x8 Cf = *(LAS bf16x8*)(CTs + (eb * 16 + fr) * 144 + (kk * 32 + fq * 8) * 2); accO[eb] = __builtin_amdgcn_mfma_f32_16x16x32_bf16(Cf, Qf, accO[eb], 0, 0, 0); if ((eb & 3) == 3) { asm volatile("" ::: "memory"); __builtin_amdgcn_sched_barrier(0); } }
                }
            }
            u32x4 vt[4];
#pragma unroll
            for (int it = 0; it < 4; ++it) { const int id = it * 512 + tid, s = id >> 4, ch = id & 15; vt[it] = *(const u32x4*)(proj + (unsigned)(tok0 + s) * NPROJ + 1536 + h * 256 + eh * 128 + ch * 8); }
            asm volatile("" ::: "memory");
#pragma unroll
            for (int it = 0; it < 4; ++it) { const int id = it * 512 + tid, s = id >> 4, ch = id & 15; *(LAS u32x4*)(Vh + s * 288 + ch * 16) = vt[it]; }
            if (eh == 0) {
                const float Mt = vM[t]; winter = __expf(m0 - Mt);
                float rowsum = 0.f;
#pragma unroll
                for (int sb = 0; sb < 8; ++sb) if (sb <= (wid | 1)) {
                    const f32x4 a4 = *(LAS f32x4*)(va + sb * 16 + fq * 4);
                    float sv[4];
#pragma unroll
                    for (int j = 0; j < 4; ++j) { const int s = sb * 16 + fq * 4 + j; const float v0 = accS[sb][j] * __expf(fminf(a4[j] - Mt, 0.f)); const float v = (s <= t) ? v0 : 0.f; sv[j] = v; rowsum += v; }
                    u32x2 o; o.x = cvt_pk_bf16(sv[0], sv[1]); o.y = cvt_pk_bf16(sv[2], sv[3]);
                    *(LAS u32x2*)(Ss + t * 272 + (sb * 16 + fq * 4) * 2) = o;
                }
                rowsum += __shfl_xor(rowsum, 16); rowsum += __shfl_xor(rowsum, 32);
                qn += __shfl_xor(qn, 16); qn += __shfl_xor(qn, 32);
                const float den = winter * qn + rowsum, mt = vb[t] + Mt;
                inv = 1.0f / fmaxf(fabsf(den), __expf(-mt));
            }
#pragma unroll
            for (int eb = 0; eb < 8; ++eb) accO[eb] = accO[eb] * winter;
            __syncthreads();
            for (int kb = 0; kb <= (wid >> 1); ++kb) {
                const s16x4 s0 = *(LAS s16x4*)(Ss + t * 272 + (kb * 32 + fq * 4) * 2), s1 = *(LAS s16x4*)(Ss + t * 272 + (kb * 32 + 16 + fq * 4) * 2);
                const bf16x8 Sf = __builtin_shufflevector(s0, s1, 0, 1, 2, 3, 4, 5, 6, 7);
#pragma unroll
                for (int eb = 0; eb < 8; ++eb) { const bf16x8 Vf = tr_frag(Vh + (kb * 32 + fq * 4 + (fr >> 2)) * 288 + (eb * 16 + (fr & 3) * 4) * 2, 16 * 288);
                    accO[eb] = __builtin_amdgcn_mfma_f32_16x16x32_bf16(Vf, Sf, accO[eb], 0, 0, 0); if ((eb & 3) == 3) { asm volatile("" ::: "memory"); __builtin_amdgcn_sched_barrier(0); } }
            }
            u32x2 ovv[8];
#pragma unroll
            for (int eb = 0; eb < 8; ++eb) ovv[eb] = *(const u32x2*)(proj + tok * NPROJ + 2560 + h * 256 + eh * 128 + eb * 16 + fq * 4);
            asm volatile("" ::: "memory");
#pragma unroll
            for (int eb = 0; eb < 8; ++eb) { const u32x2 ov = ovv[eb];
                f32x4 hc; hc.x = sigmoidf_(bflo(ov.x)) * accO[eb].x * inv; hc.y = sigmoidf_(bfhi(ov.x)) * accO[eb].y * inv; hc.z = sigmoidf_(bflo(ov.y)) * accO[eb].z * inv; hc.w = sigmoidf_(bfhi(ov.y)) * accO[eb].w * inv;
                ss += (hc.x * hc.x + hc.y * hc.y) + (hc.z * hc.z + hc.w * hc.w);
                if (eh == 0) { hc0[eb].x = cvt_pk_bf16(hc.x, hc.y); hc0[eb].y = cvt_pk_bf16(hc.z, hc.w); } else accO[eb] = hc;
                if ((eb & 3) == 3) { asm volatile("" ::: "memory"); __builtin_amdgcn_sched_barrier(0); } }
            if (eh == 1) {
                ss += __shfl_xor(ss, 16); ss += __shfl_xor(ss, 32);
                const float rs = rsqrtf(ss * (1.0f / 256.0f) + EPS);
#pragma unroll
                for (int e4 = 0; e4 < 8; ++e4) {
                    f32x4 ngv[2], skv[2]; u32x2 xvv[2];
#pragma unroll
                    for (int q = 0; q < 2; ++q) { const int col = h * 256 + (e4 * 2 + q) * 16 + fq * 4; ngv[q] = *(const f32x4*)(normg + col); skv[q] = *(const f32x4*)(skipg + col); xvv[q] = *(const u32x2*)(xc + tok * DM + col); }
                    asm volatile("" ::: "memory");
#pragma unroll
                    for (int q = 0; q < 2; ++q) { const int e2 = e4 * 2 + q, col = h * 256 + e2 * 16 + fq * 4;
                        const f32x4 ng = ngv[q], sk = skv[q]; const u32x2 xv = xvv[q];
                        f32x4 hc; if (e2 < 8) { const u32x2 hp = hc0[e2 & 7]; hc = (f32x4){bflo(hp.x), bfhi(hp.x), bflo(hp.y), bfhi(hp.y)}; } else hc = accO[e2 & 7];
                        u32x2 o; o.x = cvt_pk_bf16(hc.x * rs * ng.x + sk.x * bflo(xv.x), hc.y * rs * ng.y + sk.y * bfhi(xv.x)); o.y = cvt_pk_bf16(hc.z * rs * ng.z + sk.z * bflo(xv.y), hc.w * rs * ng.w + sk.w * bfhi(xv.y));
                        *(u32x2*)(yml + tok * DM + col) = o; }
                    asm volatile("" ::: "memory"); __builtin_amdgcn_sched_barrier(0);
                }
            }
        }
        __syncthreads();
    }
}

#define XB_TMO      128
#define XB_XCNT(j)  (256  + 64 * (j))
#define XB_XSUB(j)  (1280 + 64 * (j))
#define XB_XGEN(j)  (2304 + 64 * (j))
#define XB_TOP      3328
#define XB_TOPGEN   3392
#define XCD_BAR_WORDS 3456
#define XB_SPIN_CAP (1u << 22)
__device__ __forceinline__ unsigned xb_ld(unsigned* p)              { return __hip_atomic_load(p, __ATOMIC_RELAXED, __HIP_MEMORY_SCOPE_AGENT); }
__device__ __forceinline__ unsigned xb_add(unsigned* p, unsigned v) { return __hip_atomic_fetch_add(p, v, __ATOMIC_RELAXED, __HIP_MEMORY_SCOPE_AGENT); }
__device__ __forceinline__ unsigned xb_xcc_id() { return (unsigned)__builtin_amdgcn_s_getreg((3 << 11) | 20) & 0xFu; }
#define XB_SPIN(cond, bar) do { unsigned _sp = 0; while (cond) { __builtin_amdgcn_s_sleep(1); \
    if ((++_sp & 255u) == 0u) { if (xb_ld(&(bar)[XB_TMO])) break; if (_sp > XB_SPIN_CAP) { atomicAdd(&(bar)[XB_TMO], 1u); break; } } } } while (0)
struct XcdBarrier { unsigned* bar; unsigned x; volatile LAS unsigned* st; };
__device__ __forceinline__ XcdBarrier xcd_barrier_post(unsigned* bar, volatile LAS unsigned* st) {
    XcdBarrier b; b.bar = bar; b.x = xb_xcc_id(); b.st = st;
    if (threadIdx.x == 0) (void)xb_add(&bar[XB_XCNT(b.x)], 1u);
    return b;
}
__device__ __forceinline__ void xcd_barrier_complete(unsigned* bar, unsigned x, unsigned& nloc, unsigned& nx) {
    const unsigned G = gridDim.x * gridDim.y * gridDim.z;
    unsigned sum, cnt, mine, sp = 0u;
    for (;;) {
        sum = 0u; cnt = 0u; mine = 0u;
#pragma unroll
        for (unsigned j = 0; j < 16; ++j) { const unsigned c = xb_ld(&bar[XB_XCNT(j)]); sum += c; cnt += (c > 0u) ? 1u : 0u; mine = (j == x) ? c : mine; }
        if (sum == G) break;
        __builtin_amdgcn_s_sleep(1);
        if ((++sp & 255u) == 0u) { if (xb_ld(&bar[XB_TMO])) break; if (sp > XB_SPIN_CAP) { atomicAdd(&bar[XB_TMO], 1u); break; } }
    }
    nloc = mine > 0u ? mine : 1u; nx = cnt > 0u ? cnt : 1u;
}
__device__ __forceinline__ void xcd_barrier(const XcdBarrier& b) {
    asm volatile("s_waitcnt vmcnt(0) lgkmcnt(0)" ::: "memory");
    __syncthreads();
    if (threadIdx.x == 0) {
        unsigned* bar = b.bar;
        __builtin_amdgcn_s_waitcnt(0);
        unsigned nloc = b.st[0], nx = b.st[1];
        if (nloc == 0u) { xcd_barrier_complete(bar, b.x, nloc, nx); b.st[0] = nloc; b.st[1] = nx; }
        const unsigned old = xb_add(&bar[XB_XSUB(b.x)], 1u);
        const unsigned gen = old / nloc;
        if (old + 1u == (gen + 1u) * nloc) {
            __builtin_amdgcn_fence(__ATOMIC_RELEASE, "agent");
            asm volatile("s_waitcnt vmcnt(0)" ::: "memory");
            const unsigned og = xb_add(&bar[XB_TOP], 1u);
            const unsigned tg = og / nx;
            if (og + 1u == (tg + 1u) * nx) xb_add(&bar[XB_TOPGEN], 1u);
            else XB_SPIN(xb_ld(&bar[XB_TOPGEN]) == tg, bar);
            __builtin_amdgcn_fence(__ATOMIC_ACQUIRE, "agent");
            xb_add(&bar[XB_XGEN(b.x)], 1u);
            asm volatile("s_waitcnt vmcnt(0)" ::: "memory");
        } else {
            XB_SPIN(xb_ld(&bar[XB_XGEN(b.x)]) == gen, bar);
            __builtin_amdgcn_fence(__ATOMIC_ACQUIRE, "agent");
            asm volatile("s_waitcnt vmcnt(0)" ::: "memory");
        }
    }
    __syncthreads();
}

__global__ void __launch_bounds__(512, 2) fwd_megakernel(KP p) {
    extern __shared__ __attribute__((aligned(16))) unsigned char shm[];
    LAS unsigned char* lds = (LAS unsigned char*)shm;
    cg::grid_group grid = cg::this_grid();
    { volatile LAS unsigned* st0 = (volatile LAS unsigned*)(lds + 143360); if (threadIdx.x < 4) st0[threadIdx.x] = 0u; }
    __syncthreads();
    const XcdBarrier xb = xcd_barrier_post((unsigned*)(p.ws + O_BAR), (volatile LAS unsigned*)(lds + 143360));
    if (p.out == nullptr) { asm volatile("s_waitcnt vmcnt(0) lgkmcnt(0)" ::: "memory"); grid.sync(); }
#define GSYNC() xcd_barrier(xb)
    unsigned char* ws = p.ws;
    bf16_t* BIG = (bf16_t*)(ws + O_BIG); bf16_t* XN = (bf16_t*)(ws + O_XN); bf16_t* XC = (bf16_t*)(ws + O_XC);
    bf16_t* Q = (bf16_t*)(ws + O_Q); bf16_t* KB = (bf16_t*)(ws + O_K); bf16_t* Z = (bf16_t*)(ws + O_Z); bf16_t* YS5 = (bf16_t*)(ws + O_YS5);
    float* MIXACC = (float*)(ws + O_CST); float* IFB = (float*)(ws + O_IF);
    float* xo = p.out;
    for (int l = 0; l < 4; ++l) {
        const float* xcur = (l == 0) ? p.in[0] : xo;
        for (int rep = 0; rep < REP_A; ++rep) { convert_phase(p, l, lds);
        rmsnorm_phase<false>(xcur, p.in[1] + l * 1024, XN, nullptr, nullptr, nullptr, lds); }
        GSYNC(); if (STOP_PHASE == 1) break;
        for (int rep = 0; rep < REP_G; ++rep) { pg8::Gemm g{XN, (const bf16_t*)(ws + W_GU1), MTOK, 2 * FF, 1024, 1024, 1024, 0}; pg8::EpiGated<0> e{BIG, FF}; pg8::gemm_phase(lds, g, e); }
        GSYNC(); if (STOP_PHASE == 2) break;
        { pg8::Gemm g{BIG, (const bf16_t*)(ws + W_D1), MTOK, 1024, FF, FF, FF, 0}; pg8::EpiResid e{xcur, xo, 0.5f}; pg8::gemm_phase(lds, g, e); }
        GSYNC(); if (STOP_PHASE == 3) break;
        for (int rep = 0; rep < REP_A; ++rep) { rmsnorm_phase<true>(xo, p.in[5] + l * 1024, XN, p.in[6] + (size_t)l * 1024 * INC, p.in[7] + l * 8, IFB, lds); __syncthreads(); }
        GSYNC(); if (STOP_PHASE == 4) break;
        for (int rep = 0; rep < REP_G; ++rep) { pg8::Gemm g{XN, (const bf16_t*)(ws + W_IN), MTOK, NPROJ, 1024, 1024, 1024, 0}; pg8::EpiBf16 e{BIG, BIG, NPROJ, 1000, 1.0f}; pg8::gemm_phase(lds, g, e); }
        GSYNC(); if (STOP_PHASE == 5) break;
        if (gridDim.x == 256) {
            s5_phase<false>(p, l, lds);
            conv_slice(p, l, (int)blockIdx.x >> 2, (int)blockIdx.x & 3);
            asm volatile("s_waitcnt vmcnt(0) lgkmcnt(0)" ::: "memory"); __syncthreads();
            { pg8::Gemm g{XC, (const bf16_t*)(ws + W_QK), MTOK, 2048, 256, 1024, 256, 256, nullptr, nullptr, 0, 1}; pg8::EpiBf16 e{Q, KB, 1024, 4, 0.0625f}; pg8::gemm_phase(lds, g, e); }
            asm volatile("s_waitcnt vmcnt(0) lgkmcnt(0)" ::: "memory"); __syncthreads();
            mlstm_s1_phase<true>(p, lds);
            GSYNC();
            s5_phase<true>(p, l, lds);
            mlstm_s2_phase(p);
            GSYNC();
            __syncthreads();
            { pg8::Gemm g{Z, (const bf16_t*)(ws + W_GLU), MTOK, 1024, 512, 512, 512, 0}; pg8::EpiGated<1> e{YS5, 1024}; pg8::gemm_phase(lds, g, e); }
            mlstm_s3_phase(p, l, lds);
            GSYNC();
        } else {
            conv_phase(p, l);
            s5_phase<false>(p, l, lds);
            GSYNC();
            { pg8::Gemm g{XC, (const bf16_t*)(ws + W_QK), MTOK, 2048, 256, 1024, 256, 256}; pg8::EpiBf16 e{Q, KB, 1024, 4, 0.0625f}; pg8::gemm_phase(lds, g, e); }
            GSYNC();
            mlstm_s1_phase<false>(p, lds);
            s5_phase<true>(p, l, lds);
            GSYNC();
            mlstm_s2_phase(p);
            { pg8::Gemm g{Z, (const bf16_t*)(ws + W_GLU), MTOK, 1024, 512, 512, 512, 0}; pg8::EpiGated<1> e{YS5, 1024}; pg8::gemm_phase(lds, g, e); }
            GSYNC();
            mlstm_s3_phase(p, l, lds);
            GSYNC();
        }
        { pg8::Gemm g{YS5, (const bf16_t*)(ws + W_BS5), MTOK, 1024, 512, 1024, 1024, 0, XN, (const bf16_t*)(ws + W_BML), 1024}; pg8::EpiMergeDual e{BIG + 3584, BIG + 4608, Q}; pg8::gemm_phase(lds, g, e); }
        GSYNC(); if (STOP_PHASE == 11) break;
        { pg8::Gemm g{Q, (const bf16_t*)(ws + W_OUT), MTOK, 1024, 1024, 1024, 1024, 0}; pg8::EpiResid e{xo, xo, 1.0f}; pg8::gemm_phase(lds, g, e); }
        GSYNC(); if (STOP_PHASE == 12) break;
        for (int rep = 0; rep < REP_A; ++rep) rmsnorm_phase<false>(xo, p.in[27] + l * 1024, XN, nullptr, nullptr, nullptr, lds);
        GSYNC(); if (STOP_PHASE == 13) break;
        for (int rep = 0; rep < REP_G; ++rep) { pg8::Gemm g{XN, (const bf16_t*)(ws + W_GU2), MTOK, 2 * FF, 1024, 1024, 1024, 0}; pg8::EpiGated<0> e{BIG, FF}; pg8::gemm_phase(lds, g, e); }
        GSYNC(); if (STOP_PHASE == 14) break;
        { pg8::Gemm g{BIG, (const bf16_t*)(ws + W_D2), MTOK, 1024, FF, FF, FF, 0}; pg8::EpiResid e{xo, xo, 0.5f}; pg8::gemm_phase(lds, g, e); }
        GSYNC(); if (STOP_PHASE == 15) break;
    }
#ifdef DUMP_OFF
    { const int gt = blockIdx.x * 512 + opaque_tid(); const int nthr = gridDim.x * 512;
      for (int i = gt; i < MTOK * DM; i += nthr) { float v;
          if (DUMP_KIND == 5) { v = bflo((unsigned)((const bf16_t*)(ws + O_BIG))[(size_t)(i >> 10) * NPROJ + DUMP_COL + (i & 1023)]); }
          else if (DUMP_KIND == 4) { v = 0.f; if (i < 512) v = ((const float*)(ws + O_G))[i]; else if (i < 1024) v = ((const float*)(ws + O_MLOC))[i - 512]; else if (i < 1024 + 131072) v = ((const float*)(ws + O_NLOC))[i - 1024]; }
          else if (DUMP_KIND == 2 && i < 131072) v = ((const float*)(ws + O_IF))[i];
          else if (DUMP_KIND == 3) v = bflo((unsigned)((const bf16_t*)(ws + (i < 8388608 ? O_Q : O_K)))[i & 8388607]);
          else if (DUMP_KIND == 1) v = ((const float*)(ws + DUMP_OFF))[i]; else v = bflo((unsigned)((const bf16_t*)(ws + DUMP_OFF))[i]);
          xo[i] = (fabsf(v) < 1e30f) ? v : 12345.0f; } }
#else
    final_norm_phase(xo, p.in[31]);
#endif
}

extern "C" void kernel_launch(void* const* d_in, const int* in_sizes, int n_in, void* d_out, int out_size, void* d_ws, size_t ws_size, hipStream_t stream) {
    static int grid_blocks = 0;
    if (grid_blocks == 0) {
        if (n_in != 32 || ws_size < WS_END) { fprintf(stderr, "kernel_launch: unexpected n_in %d or ws_size %zu (< %zu)\n", n_in, ws_size, (size_t)WS_END); grid_blocks = -1; return; }
        int dev = 0, cus = 0, per_cu = 0;
        hipGetDevice(&dev);
        hipDeviceGetAttribute(&cus, hipDeviceAttributeMultiprocessorCount, dev);
        if (hipFuncSetAttribute((const void*)fwd_megakernel, hipFuncAttributeMaxDynamicSharedMemorySize, LDS_BYTES) != hipSuccess) { fprintf(stderr, "kernel_launch: hipFuncSetAttribute failed\n"); grid_blocks = -1; return; }
        hipOccupancyMaxActiveBlocksPerMultiprocessor(&per_cu, (const void*)fwd_megakernel, 512, LDS_BYTES);
        if (per_cu < 1) { fprintf(stderr, "kernel_launch: occupancy query says %d blocks/CU\n", per_cu); per_cu = 1; }
        (void)hipGetLastError();
        grid_blocks = cus;
    }
    if (grid_blocks < 0) return;
    if (hipMemsetAsync((unsigned char*)d_ws + O_BAR, 0, 16384, stream) != hipSuccess) { fprintf(stderr, "kernel_launch: memset of barrier words failed\n"); return; }
    KP p{};
    for (int i = 0; i < 32; ++i) p.in[i] = (const float*)d_in[i];
    p.out = (float*)d_out; p.ws = (unsigned char*)d_ws;
    void* args[] = {&p};
    hipError_t e = hipLaunchCooperativeKernel((const void*)fwd_megakernel, dim3(grid_blocks), dim3(512), args, LDS_BYTES, stream);
    if (e != hipSuccess) fprintf(stderr, "cooperative launch failed: %s (grid %d)\n", hipGetErrorString(e), grid_blocks);
}
```

```cpp
#include <hip/hip_runtime.h>
#include <hip/hip_cooperative_groups.h>
#include <cstdio>
namespace cg = cooperative_groups;

#define LAS __attribute__((address_space(3)))
typedef unsigned short bf16_t;
typedef short bf16x8 __attribute__((ext_vector_type(8)));
typedef short s16x4 __attribute__((ext_vector_type(4)));
typedef float f32x4 __attribute__((ext_vector_type(4)));
typedef float f32x2 __attribute__((ext_vector_type(2)));
typedef unsigned u32x4 __attribute__((ext_vector_type(4)));
typedef unsigned u32x2 __attribute__((ext_vector_type(2)));

constexpr int MTOK = 16384, DM = 1024, FF = 2816, NPROJ = 5632, SEQ = 8192, INC = 5640;
constexpr float EPS = 1e-6f;
constexpr int LDS_BYTES = 147456;
#ifndef STOP_PHASE
#define STOP_PHASE 99
#define REP_A 1
#define REP_G 1
#define REP_B 1
#define REP_C 1
#define REP_D 1
#endif
constexpr int VEC_OFF = 131072;

constexpr size_t W_GU1 = 0;
constexpr size_t W_D1 = W_GU1 + (size_t)5632 * 1024 * 2;
constexpr size_t W_IN = W_D1 + (size_t)1024 * 2816 * 2;
constexpr size_t W_GLU = W_IN + (size_t)5632 * 1024 * 2;
constexpr size_t W_QK = W_GLU + (size_t)1024 * 512 * 2;
constexpr size_t W_BS5 = W_QK + (size_t)2048 * 256 * 2;
constexpr size_t W_BML = W_BS5 + (size_t)1024 * 1024 * 2;
constexpr size_t W_OUT = W_BML + (size_t)1024 * 1024 * 2;
constexpr size_t W_GU2 = W_OUT + (size_t)1024 * 1024 * 2;
constexpr size_t W_D2 = W_GU2 + (size_t)5632 * 1024 * 2;
constexpr size_t W_END = W_D2 + (size_t)1024 * 2816 * 2;
constexpr size_t O_BIG = W_END;
constexpr size_t O_XN = O_BIG + (size_t)MTOK * NPROJ * 2;
constexpr size_t O_XC = O_XN + (size_t)MTOK * 1024 * 2;
constexpr size_t O_Q = O_XC + (size_t)MTOK * 1024 * 2;
constexpr size_t O_K = O_Q + (size_t)MTOK * 1024 * 2;
constexpr size_t O_Z = O_K + (size_t)MTOK * 1024 * 2;
constexpr size_t O_YS5 = O_Z + (size_t)MTOK * 512 * 2;
constexpr size_t O_CST = O_YS5 + (size_t)MTOK * 1024 * 2;
constexpr size_t O_IF = O_CST + (size_t)512 * 65536 * 2;
constexpr size_t O_S5END = O_IF + (size_t)MTOK * 8 * 4;
constexpr size_t O_G = O_S5END + (size_t)64 * 64 * 64 * 8;
constexpr size_t O_MLOC = O_G + 2048;
constexpr size_t O_MST = O_MLOC + 2048;
constexpr size_t O_NLOC = O_MST + 2048;
constexpr size_t O_NST = O_NLOC + (size_t)512 * 256 * 4;
constexpr size_t O_BAR = O_NST + (size_t)512 * 256 * 4;
constexpr size_t WS_END = O_BAR + 16384;

struct KP { const float* in[32]; float* out; unsigned char* ws; };

typedef __bf16 bf16v2_t __attribute__((ext_vector_type(2)));
__device__ __forceinline__ unsigned cvt_pk_bf16(float lo, float hi) { const f32x2 v = {lo, hi}; const bf16v2_t b = __builtin_convertvector(v, bf16v2_t); return __builtin_bit_cast(unsigned, b); }
__device__ __forceinline__ float bflo(unsigned u) { return __uint_as_float(u << 16); }
__device__ __forceinline__ float bfhi(unsigned u) { return __uint_as_float(u & 0xffff0000u); }
__device__ __forceinline__ float sigmoidf_(float x) { return __builtin_amdgcn_rcpf(1.0f + __expf(-x)); }
__device__ __forceinline__ float siluf_(float x) { return x * __builtin_amdgcn_rcpf(1.0f + __expf(-x)); }
__device__ __forceinline__ float gelu_tanh(float y) { const float v = 0.7978845608028654f * (y + 0.044715f * y * y * y); const float th = 1.0f - 2.0f * __builtin_amdgcn_rcpf(1.0f + __expf(2.0f * v)); return 0.5f * y * (1.0f + th); }
__device__ __forceinline__ float logsigmoidf_(float x) { return fminf(x, 0.f) - log1pf(__expf(-fabsf(x))); }
__device__ __forceinline__ float wave_sum(float v) {
#pragma unroll
    for (int o = 1; o < 64; o <<= 1) v += __shfl_xor(v, o);
    return v;
}
__device__ __forceinline__ int opaque_tid() { int t = threadIdx.x; asm volatile("" : "+v"(t)); return t; }
#define WAVE_LDS_SYNC() asm volatile("s_waitcnt lgkmcnt(0)" ::: "memory")
__device__ __forceinline__ void sincos_acc(float x, float& s, float& c) {
    const float k = rintf(x * 0.63661977236758134f);
    float r = fmaf(-k, 1.5703125f, x); r = fmaf(-k, 4.837512969970703125e-4f, r); r = fmaf(-k, 7.54978995489188216e-8f, r);
    const float r2 = r * r;
    const float sp = r + r * r2 * (-1.6666654611e-1f + r2 * (8.3321608736e-3f + r2 * (-1.9515295891e-4f)));
    const float cp = 1.0f - 0.5f * r2 + r2 * r2 * (4.166664568298827e-2f + r2 * (-1.388731625493765e-3f + r2 * 2.443315711809948e-5f));
    const int q = ((int)k) & 3;
    s = (q == 0) ? sp : (q == 1) ? cp : (q == 2) ? -sp : -cp;
    c = (q == 0) ? cp : (q == 1) ? -sp : (q == 2) ? -cp : sp;
}

namespace pg8 {
constexpr int BM = 256, BK = 64, HALF = 128, HTB = HALF * BK * 2, STAGE_BYTES = 8 * HTB, NXCD = 8, WGM = 8;
__host__ __device__ __forceinline__ int lds_byte(int r, int c) { const int st = (r >> 4) * 2 + (c >> 5), rr = r & 15, cc = c & 31, ob = rr * 64 + cc * 2; return st * 1024 + (ob ^ (((ob >> 9) & 1) << 5)); }
__host__ __device__ __forceinline__ void stage_rc(int b, int& R, int& C) { const int st = b / 1024, sb = b % 1024, swz = sb ^ (((sb >> 9) & 1) << 5); R = (st >> 1) * 16 + swz / 64; C = (st & 1) * 32 + (swz % 64) / 2; }
__host__ __device__ __forceinline__ int perm32(int rho) { const int n = rho >> 4, i = rho & 15; return 8 * (i >> 2) + 4 * n + (i & 3); }
struct Unit { int pm, pn; };
struct Gemm { const bf16_t* A; const bf16_t* Bt; int M, N, K, lda, ldb, ahead; const bf16_t* A2; const bf16_t* Bt2; int K2; int pairmode; };
struct StaticOrder {
    int nM, nN, nwg, G, c;
    __device__ void init(int M, int N, int G_, int c_) { nM = M / BM; nN = N / BM; nwg = nM * nN; G = G_; c = c_; }
    __device__ bool next(int i, Unit& u) const {
        const long L = (long)i * G + c; if (L >= nwg) return false;
        int wgid = (int)L; { const int q = nwg / NXCD, r = nwg % NXCD, xcd = wgid % NXCD, off = wgid / NXCD; wgid = (xcd < r ? xcd * (q + 1) : r * (q + 1) + (xcd - r) * q) + off; }
        const int nig = WGM * nN, gid = wgid / nig, fm = gid * WGM, gsz = (nM - fm) < WGM ? (nM - fm) : WGM;
        u.pm = fm + ((wgid % nig) % gsz); u.pn = (wgid % nig) / gsz; return true;
    }
};

template <class Epi>
__device__ __forceinline__ void gemm_phase(LAS unsigned char* lds, const Gemm g, const Epi& E) {
    StaticOrder S; S.init(g.M, g.N, (int)gridDim.x, (int)blockIdx.x);
    const int tid = opaque_tid(), wid = __builtin_amdgcn_readfirstlane(tid >> 6), lane = tid & 63, wr = wid >> 2, wc = wid & 3, fr = lane & 15, fq = lane >> 4;
    const int K = g.K; int nt = K / BK; int seg = 0;
    unsigned voffA[2], voffB[2];
#pragma unroll
    for (int i = 0; i < 2; ++i) { int R, C; stage_rc(tid * 16 + i * 8192, R, C); const int Rb = Epi::PERM ? ((R & ~31) + perm32(R & 31)) : R;
        voffA[i] = (unsigned)(R * g.lda + C) * 2u; voffB[i] = (unsigned)(Rb * g.ldb + C) * 2u; }
    const size_t kstep = (size_t)(BK * 2);
    const size_t hstepA = (size_t)HALF * g.lda * 2, hstepB = (size_t)HALF * g.ldb * 2;
    const size_t tstepA = 2 * hstepA, tstepB = 2 * hstepB;
    const unsigned ldsw = (unsigned)wid * 1024u;
    const int aoff = lds_byte(wr * 64 + fr, fq * 8), boff = lds_byte(wc * 32 + fr, fq * 8);
#define PG8_SA(b, h) (((b) * 2 + (h)) * HTB)
#define PG8_SB(b, h) ((4 + (b) * 2 + (h)) * HTB)
#define PG8_STAGE(bufoff, gbase, voff) do { _Pragma("unroll") for (int _i = 0; _i < 2; ++_i) \
        __builtin_amdgcn_global_load_lds((const unsigned*)((const char*)(gbase) + (voff)[_i]), (LAS unsigned*)(lds + (bufoff) + ldsw + _i * 8192), 16, 0, 0); } while (0)
#define PG8_LDA(dst, b, h) do { _Pragma("unroll") for (int m = 0; m < 4; ++m) _Pragma("unroll") for (int k = 0; k < 2; ++k) dst[m][k] = *(const LAS bf16x8*)(lds + PG8_SA(b, h) + aoff + m * 2048 + k * 1024); } while (0)
#define PG8_LDB(dst, b, h) do { _Pragma("unroll") for (int n = 0; n < 2; ++n) _Pragma("unroll") for (int k = 0; k < 2; ++k) dst[n][k] = *(const LAS bf16x8*)(lds + PG8_SB(b, h) + boff + n * 2048 + k * 1024); } while (0)
#define PG8_MMA(ai, bj, At, Bt) do { __builtin_amdgcn_s_setprio(1); _Pragma("unroll") for (int m = 0; m < 4; ++m) _Pragma("unroll") for (int n = 0; n < 2; ++n) _Pragma("unroll") for (int k = 0; k < 2; ++k) \
        acc[ai][bj][m][n] = __builtin_amdgcn_mfma_f32_16x16x32_bf16(Bt[n][k], At[m][k], acc[ai][bj][m][n], 0, 0, 0); __builtin_amdgcn_s_setprio(0); } while (0)
#define PG8_WAIT_V(n) asm volatile("s_waitcnt vmcnt(" #n ")" ::: "memory")
#define PG8_WAIT_L(n) asm volatile("s_waitcnt lgkmcnt(" #n ")" ::: "memory")
#define PG8_BAR __builtin_amdgcn_s_barrier()
#define PG8_SCHED __builtin_amdgcn_sched_barrier(0)
    auto nextu = [&](int i, Unit& u) -> bool { if (g.pairmode) { if (i >= 2) return false; u.pm = (int)blockIdx.x >> 2; u.pn = ((int)blockIdx.x & 3) + 4 * i; return true; } return S.next(i, u); };
    Unit cur, nxt; int ui = 0;
    if (!nextu(0, cur)) return;
    f32x4 acc[2][2][4][2];
#pragma unroll
    for (int a = 0; a < 2; ++a)
#pragma unroll
        for (int b = 0; b < 2; ++b)
#pragma unroll
            for (int m = 0; m < 4; ++m)
#pragma unroll
                for (int n = 0; n < 2; ++n) acc[a][b][m][n] = (f32x4){0.f, 0.f, 0.f, 0.f};
    bf16x8 At[4][2], B0[2][2], B1[2][2];
    const char* cA = (const char*)g.A + (size_t)cur.pm * tstepA + (size_t)((cur.pn & 3) * g.ahead) * 2; const char* cB = (const char*)g.Bt + (size_t)cur.pn * tstepB;
    PG8_STAGE(PG8_SB(0, 0), cB, voffB); PG8_STAGE(PG8_SA(0, 0), cA, voffA); PG8_STAGE(PG8_SB(0, 1), cB + hstepB, voffB); PG8_STAGE(PG8_SA(0, 1), cA + hstepA, voffA);
    if (wr == 1) PG8_BAR;
    PG8_WAIT_V(4); PG8_BAR;
    PG8_STAGE(PG8_SB(1, 0), cB + kstep, voffB); PG8_STAGE(PG8_SA(1, 0), cA + kstep, voffA); PG8_STAGE(PG8_SB(1, 1), cB + hstepB + kstep, voffB);
    PG8_WAIT_V(6); PG8_BAR;
    for (;;) {
        bool has_next; const char* nA; const char* nB;
        if (Epi::DUAL && seg == 0) { has_next = true; nxt = cur; nA = (const char*)g.A2 + (size_t)cur.pm * tstepA; nB = (const char*)g.Bt2 + (size_t)cur.pn * tstepB; }
        else { has_next = nextu(ui + 1, nxt);
            nA = has_next ? (const char*)g.A + (size_t)nxt.pm * tstepA + (size_t)((nxt.pn & 3) * g.ahead) * 2 : cA; nB = has_next ? (const char*)g.Bt + (size_t)nxt.pn * tstepB : cB; }
        for (int t = 0; t < nt; t += 2) {
            const bool last = (t == nt - 2);
            const char* a1 = cA + (size_t)(t + 1) * kstep;
            const char* a2 = last ? nA : cA + (size_t)(t + 2) * kstep; const char* b2 = last ? nB : cB + (size_t)(t + 2) * kstep;
            const char* a3 = a2 + kstep; const char* b3 = b2 + kstep;
            PG8_LDB(B0, 0, 0); PG8_SCHED; PG8_LDA(At, 0, 0); PG8_STAGE(PG8_SA(1, 1), a1 + hstepA, voffA);
            PG8_WAIT_L(8); PG8_BAR; PG8_WAIT_L(0); PG8_MMA(0, 0, At, B0); PG8_BAR; PG8_SCHED;
            PG8_LDB(B1, 0, 1); PG8_STAGE(PG8_SB(0, 0), b2, voffB);
            PG8_BAR; PG8_WAIT_L(0); PG8_MMA(0, 1, At, B1); PG8_BAR;
            PG8_LDA(At, 0, 1); PG8_STAGE(PG8_SA(0, 0), a2, voffA);
            PG8_BAR; PG8_WAIT_L(0); PG8_MMA(1, 0, At, B0); PG8_BAR; PG8_SCHED;
            PG8_STAGE(PG8_SB(0, 1), b2 + hstepB, voffB);
            PG8_WAIT_V(6); PG8_BAR; PG8_MMA(1, 1, At, B1); PG8_BAR;
            PG8_LDB(B0, 1, 0); PG8_SCHED; PG8_LDA(At, 1, 0); PG8_STAGE(PG8_SA(0, 1), a2 + hstepA, voffA);
            PG8_WAIT_L(8); PG8_BAR; PG8_WAIT_L(0); PG8_MMA(0, 0, At, B0); PG8_BAR; PG8_SCHED;
            PG8_LDB(B1, 1, 1); PG8_STAGE(PG8_SB(1, 0), b3, voffB);
            PG8_BAR; PG8_WAIT_L(0); PG8_MMA(0, 1, At, B1); PG8_BAR;
            PG8_LDA(At, 1, 1); PG8_STAGE(PG8_SA(1, 0), a3, voffA);
            PG8_BAR; PG8_WAIT_L(0); PG8_MMA(1, 0, At, B0); PG8_BAR; PG8_SCHED;
            PG8_STAGE(PG8_SB(1, 1), b3 + hstepB, voffB);
            PG8_WAIT_V(6); PG8_BAR; PG8_MMA(1, 1, At, B1); PG8_BAR;
        }
        if constexpr (Epi::DUAL) { if (seg == 0) { E.mid(acc, cur, wr, wc, fr, fq); seg = 1; cA = nA; cB = nB; nt = g.K2 / BK; continue; } }
        E(acc, cur, wr, wc, fr, fq);
        if (Epi::DUAL) { seg = 0; nt = K / BK; }
        if (!has_next) break;
#pragma unroll
        for (int a = 0; a < 2; ++a)
#pragma unroll
            for (int b = 0; b < 2; ++b)
#pragma unroll
                for (int m = 0; m < 4; ++m)
#pragma unroll
                    for (int n = 0; n < 2; ++n) acc[a][b][m][n] = (f32x4){0.f, 0.f, 0.f, 0.f};
        cur = nxt; cA = nA; cB = nB; ++ui;
    }
    PG8_WAIT_V(0);
    if (wr == 0) PG8_BAR;
    PG8_BAR;
#undef PG8_SA
#undef PG8_SB
#undef PG8_STAGE
#undef PG8_LDA
#undef PG8_LDB
#undef PG8_MMA
#undef PG8_WAIT_V
#undef PG8_WAIT_L
#undef PG8_BAR
#undef PG8_SCHED
}

template <int ACT> struct EpiGated {
    static constexpr bool DUAL = false;
    static constexpr bool PERM = true;
    bf16_t* O; int ldo;
    __device__ __forceinline__ void operator()(const f32x4 (&acc)[2][2][4][2], const Unit& u, int wr, int wc, int fr, int fq) const {
        const int row0 = u.pm * BM + wr * 64 + fr, col0 = u.pn * 128 + wc * 32 + 8 * fq;
#pragma unroll
        for (int ai = 0; ai < 2; ++ai)
#pragma unroll
            for (int m = 0; m < 4; ++m) {
                bf16_t* rowp = O + (size_t)(row0 + ai * HALF + m * 16) * ldo + col0;
                float r[8];
#pragma unroll
                for (int n = 0; n < 2; ++n)
#pragma unroll
                    for (int j = 0; j < 4; ++j) { const float a0 = acc[ai][0][m][n][j], a1 = acc[ai][1][m][n][j]; r[n * 4 + j] = ACT == 0 ? siluf_(a0) * a1 : a0 * sigmoidf_(a1); }
                u32x4 o; o.x = cvt_pk_bf16(r[0], r[1]); o.y = cvt_pk_bf16(r[2], r[3]); o.z = cvt_pk_bf16(r[4], r[5]); o.w = cvt_pk_bf16(r[6], r[7]);
                *(u32x4*)rowp = o;
            }
    }
};
struct EpiResid {
    static constexpr bool DUAL = false;
    static constexpr bool PERM = false;
    const float* xin; float* xout; float scale;
    __device__ __forceinline__ void operator()(const f32x4 (&acc)[2][2][4][2], const Unit& u, int wr, int wc, int fr, int fq) const {
        const int row0 = u.pm * BM + wr * 64 + fr, col0 = u.pn * BM + wc * 32 + 4 * fq;
#pragma unroll
        for (int ai = 0; ai < 2; ++ai) {
            f32x4 xv[4][2][2];
#pragma unroll
            for (int m = 0; m < 4; ++m) { const size_t ro = (size_t)(row0 + ai * HALF + m * 16) * DM + col0;
#pragma unroll
                for (int bj = 0; bj < 2; ++bj)
#pragma unroll
                    for (int n = 0; n < 2; ++n) xv[m][bj][n] = *(const f32x4*)(xin + ro + bj * HALF + n * 16); }
            asm volatile("" ::: "memory");
#pragma unroll
            for (int m = 0; m < 4; ++m) { const size_t ro = (size_t)(row0 + ai * HALF + m * 16) * DM + col0;
#pragma unroll
                for (int bj = 0; bj < 2; ++bj)
#pragma unroll
                    for (int n = 0; n < 2; ++n) *(f32x4*)(xout + ro + bj * HALF + n * 16) = xv[m][bj][n] + scale * acc[ai][bj][m][n]; }
            asm volatile("" ::: "memory");
        }
    }
};
struct EpiBf16 {
    static constexpr bool DUAL = false;
    static constexpr bool PERM = true;
    bf16_t* O; bf16_t* O2; int ldo, split; float scale1;
    __device__ __forceinline__ void operator()(const f32x4 (&acc)[2][2][4][2], const Unit& u, int wr, int wc, int fr, int fq) const {
        const int row0 = u.pm * BM + wr * 64 + fr; int pn = u.pn; bf16_t* base = O; float sc = scale1;
        if (pn >= split) { pn -= split; base = O2; sc = 1.0f; }
        const int col0 = pn * BM + wc * 32 + 8 * fq;
#pragma unroll
        for (int ai = 0; ai < 2; ++ai)
#pragma unroll
            for (int m = 0; m < 4; ++m) { bf16_t* rowp = base + (size_t)(row0 + ai * HALF + m * 16) * ldo + col0;
#pragma unroll
                for (int bj = 0; bj < 2; ++bj) { const f32x4 v0 = acc[ai][bj][m][0] * sc, v1 = acc[ai][bj][m][1] * sc;
                    u32x4 o; o.x = cvt_pk_bf16(v0[0], v0[1]); o.y = cvt_pk_bf16(v0[2], v0[3]); o.z = cvt_pk_bf16(v1[0], v1[1]); o.w = cvt_pk_bf16(v1[2], v1[3]);
                    *(u32x4*)(rowp + bj * HALF) = o; } }
    }
};
template <int SECOND> struct EpiMerge {
    static constexpr bool DUAL = false;
    static constexpr bool PERM = true;
    const bf16_t* gate; float* mixacc; bf16_t* mix;
    __device__ __forceinline__ void operator()(const f32x4 (&acc)[2][2][4][2], const Unit& u, int wr, int wc, int fr, int fq) const {
        const int row0 = u.pm * BM + wr * 64 + fr, col0 = u.pn * BM + wc * 32 + 8 * fq;
#pragma unroll
        for (int ai = 0; ai < 2; ++ai)
#pragma unroll
            for (int mp = 0; mp < 2; ++mp) {
                u32x4 gv[2][2]; f32x4 pv[2][2][2];
#pragma unroll
                for (int mi = 0; mi < 2; ++mi)
#pragma unroll
                    for (int bj = 0; bj < 2; ++bj) { const size_t row = (size_t)(row0 + ai * HALF + (mp * 2 + mi) * 16); const int col = col0 + bj * HALF;
                        gv[mi][bj] = *(const u32x4*)(gate + row * NPROJ + col);
                        if (SECOND == 1) { pv[mi][bj][0] = *(const f32x4*)(mixacc + row * DM + col); pv[mi][bj][1] = *(const f32x4*)(mixacc + row * DM + col + 4); } }
                asm volatile("" ::: "memory");
#pragma unroll
                for (int mi = 0; mi < 2; ++mi)
#pragma unroll
                    for (int bj = 0; bj < 2; ++bj) { const int m = mp * 2 + mi; const size_t row = (size_t)(row0 + ai * HALF + m * 16); const int col = col0 + bj * HALF; const u32x4 g4 = gv[mi][bj];
                        float r[8];
                        r[0] = sigmoidf_(bflo(g4.x)) * acc[ai][bj][m][0][0]; r[1] = sigmoidf_(bfhi(g4.x)) * acc[ai][bj][m][0][1];
                        r[2] = sigmoidf_(bflo(g4.y)) * acc[ai][bj][m][0][2]; r[3] = sigmoidf_(bfhi(g4.y)) * acc[ai][bj][m][0][3];
                        r[4] = sigmoidf_(bflo(g4.z)) * acc[ai][bj][m][1][0]; r[5] = sigmoidf_(bfhi(g4.z)) * acc[ai][bj][m][1][1];
                        r[6] = sigmoidf_(bflo(g4.w)) * acc[ai][bj][m][1][2]; r[7] = sigmoidf_(bfhi(g4.w)) * acc[ai][bj][m][1][3];
                        if (SECOND == 0) { float* mp_ = mixacc + row * DM + col; *(f32x4*)mp_ = (f32x4){r[0], r[1], r[2], r[3]}; *(f32x4*)(mp_ + 4) = (f32x4){r[4], r[5], r[6], r[7]}; }
                        else { const f32x4 p0 = pv[mi][bj][0], p1 = pv[mi][bj][1];
                            u32x4 o; o.x = cvt_pk_bf16(r[0] + p0[0], r[1] + p0[1]); o.y = cvt_pk_bf16(r[2] + p0[2], r[3] + p0[3]); o.z = cvt_pk_bf16(r[4] + p1[0], r[5] + p1[1]); o.w = cvt_pk_bf16(r[6] + p1[2], r[7] + p1[3]);
                            *(u32x4*)(mix + row * DM + col) = o; } }
                asm volatile("" ::: "memory");
            }
    }
};
struct EpiMergeDual {
    static constexpr bool PERM = true, DUAL = true;
    const bf16_t* gate1; const bf16_t* gate2; bf16_t* mix;
    static __device__ __forceinline__ float em(float g) { return fminf(__expf(-g), 1e30f); }
    __device__ __forceinline__ void mid(f32x4 (&acc)[2][2][4][2], const Unit& u, int wr, int wc, int fr, int fq) const {
        const int row0 = u.pm * BM + wr * 64 + fr, col0 = u.pn * BM + wc * 32 + 8 * fq;
#pragma unroll
        for (int ai = 0; ai < 2; ++ai)
#pragma unroll
            for (int mp = 0; mp < 2; ++mp) {
                u32x4 g1v[2][2], g2v[2][2];
#pragma unroll
                for (int mi = 0; mi < 2; ++mi)
#pragma unroll
                    for (int bj = 0; bj < 2; ++bj) { const size_t row = (size_t)(row0 + ai * HALF + (mp * 2 + mi) * 16); const int col = col0 + bj * HALF;
                        g1v[mi][bj] = *(const u32x4*)(gate1 + row * NPROJ + col); g2v[mi][bj] = *(const u32x4*)(gate2 + row * NPROJ + col); }
#pragma unroll
                for (int mi = 0; mi < 2; ++mi)
#pragma unroll
                    for (int bj = 0; bj < 2; ++bj) { const int m = mp * 2 + mi; const u32x4 a = g1v[mi][bj], b = g2v[mi][bj];
                        const float ga[8] = {bflo(a.x), bfhi(a.x), bflo(a.y), bfhi(a.y), bflo(a.z), bfhi(a.z), bflo(a.w), bfhi(a.w)};
                        const float gb[8] = {bflo(b.x), bfhi(b.x), bflo(b.y), bfhi(b.y), bflo(b.z), bfhi(b.z), bflo(b.w), bfhi(b.w)};
#pragma unroll
                        for (int j = 0; j < 8; ++j) acc[ai][bj][m][j >> 2][j & 3] *= (1.0f + em(gb[j])) * __builtin_amdgcn_rcpf(1.0f + em(ga[j])); }
            }
    }
    __device__ __forceinline__ void operator()(const f32x4 (&acc)[2][2][4][2], const Unit& u, int wr, int wc, int fr, int fq) const {
        const int row0 = u.pm * BM + wr * 64 + fr, col0 = u.pn * BM + wc * 32 + 8 * fq;
#pragma unroll
        for (int ai = 0; ai < 2; ++ai)
#pragma unroll
            for (int mp = 0; mp < 2; ++mp) {
                u32x4 g2v[2][2];
#pragma unroll
                for (int mi = 0; mi < 2; ++mi)
#pragma unroll
                    for (int bj = 0; bj < 2; ++bj) { const size_t row = (size_t)(row0 + ai * HALF + (mp * 2 + mi) * 16); const int col = col0 + bj * HALF;
                        g2v[mi][bj] = *(const u32x4*)(gate2 + row * NPROJ + col); }
#pragma unroll
                for (int mi = 0; mi < 2; ++mi)
#pragma unroll
                    for (int bj = 0; bj < 2; ++bj) { const int m = mp * 2 + mi; const size_t row = (size_t)(row0 + ai * HALF + m * 16); const int col = col0 + bj * HALF; const u32x4 b = g2v[mi][bj];
                        const float gb[8] = {bflo(b.x), bfhi(b.x), bflo(b.y), bfhi(b.y), bflo(b.z), bfhi(b.z), bflo(b.w), bfhi(b.w)};
                        float r[8];
#pragma unroll
                        for (int j = 0; j < 8; ++j) r[j] = acc[ai][bj][m][j >> 2][j & 3] * __builtin_amdgcn_rcpf(1.0f + em(gb[j]));
                        u32x4 o; o.x = cvt_pk_bf16(r[0], r[1]); o.y = cvt_pk_bf16(r[2], r[3]); o.z = cvt_pk_bf16(r[4], r[5]); o.w = cvt_pk_bf16(r[6], r[7]);
                        *(u32x4*)(mix + row * DM + col) = o; }
            }
    }
};
}

__device__ __forceinline__ void tr_job(const float* W, int K, int ld, int c0, int NC, bf16_t* WT, int rowbase, int rs, LAS float* scr, int gw, int nw, int lane, int ldw = 0) {
    if (ldw == 0) ldw = K;
    const int nblk = NC / 32, nitems = (K / 64) * nblk;
    for (int item = gw; item < nitems; item += nw) {
        const int kb = item / nblk, nb = item % nblk, k0 = 64 * kb, n0 = 32 * nb;
        float wv[32];
#pragma unroll
        for (int i = 0; i < 32; ++i) { const int kk = 2 * i + (lane >> 5); wv[i] = W[(size_t)(k0 + kk) * ld + c0 + n0 + (lane & 31)]; }
#pragma unroll
        for (int i = 0; i < 32; ++i) { const int kk = 2 * i + (lane >> 5); scr[kk * 33 + (lane & 31)] = wv[i]; }
        WAVE_LDS_SYNC();
        const int c = lane & 7;
#pragma unroll
        for (int j = 0; j < 4; ++j) { const int n = (lane >> 3) + 8 * j; const LAS float* s = scr + (8 * c) * 33 + n;
            u32x4 o; o.x = cvt_pk_bf16(s[0 * 33], s[1 * 33]); o.y = cvt_pk_bf16(s[2 * 33], s[3 * 33]); o.z = cvt_pk_bf16(s[4 * 33], s[5 * 33]); o.w = cvt_pk_bf16(s[6 * 33], s[7 * 33]);
            const int nn = n0 + n, drow = rowbase + (nn >> 7) * rs + (nn & 127);
            *(u32x4*)(WT + (size_t)drow * ldw + k0 + 8 * c) = o; }
        WAVE_LDS_SYNC();
    }
}
__device__ __forceinline__ void convert_phase(const KP& p, int l, LAS unsigned char* lds, int mask, int part) {
    const int tid = opaque_tid(); const int wid = tid >> 6, lane = tid & 63;
    if (part && (int)blockIdx.x < 128) return;
    const int nw = part ? ((int)gridDim.x - 128) * 8 : (int)gridDim.x * 8;
    int gw = (part ? (int)blockIdx.x - 128 : (int)blockIdx.x) * 8 + wid;
    if (nw <= 0) return;
    LAS float* scr = (LAS float*)(lds + wid * 8448);
    unsigned char* ws = p.ws;
    const size_t ffw = (size_t)l * 1024 * 2816;
    bf16_t* gu1 = (bf16_t*)(ws + W_GU1); bf16_t* d1 = (bf16_t*)(ws + W_D1);
#define ROT(n) gw = (gw + (n)) % nw
    if (mask & 1) {
        tr_job(p.in[2] + ffw, 1024, 2816, 0, 2816, gu1, 0, 256, scr, gw, nw, lane);
        tr_job(p.in[3] + ffw, 1024, 2816, 0, 2816, gu1, 128, 256, scr, gw, nw, lane);
        tr_job(p.in[4] + ffw, 2816, 1024, 0, 1024, d1, 0, 128, scr, gw, nw, lane);
    }
    if (mask & 4) {
        tr_job(p.in[28] + ffw, 1024, 2816, 0, 2816, (bf16_t*)(ws + W_GU2), 0, 256, scr, gw, nw, lane);
        tr_job(p.in[29] + ffw, 1024, 2816, 0, 2816, (bf16_t*)(ws + W_GU2), 128, 256, scr, gw, nw, lane);
        tr_job(p.in[30] + ffw, 2816, 1024, 0, 1024, (bf16_t*)(ws + W_D2), 0, 128, scr, gw, nw, lane);
    }
    if (mask & 2) {
        tr_job(p.in[6] + (size_t)l * 1024 * INC, 1024, INC, 0, 3584, (bf16_t*)(ws + W_IN), 0, 128, scr, gw, nw, lane);
        tr_job(p.in[6] + (size_t)l * 1024 * INC, 1024, INC, 3592, 2048, (bf16_t*)(ws + W_IN), 3584, 128, scr, gw, nw, lane);
        ROT(768);
        tr_job(p.in[16] + (size_t)l * 512 * 512, 512, 512, 0, 512, (bf16_t*)(ws + W_GLU), 0, 256, scr, gw, nw, lane);
        ROT(128);
        tr_job(p.in[17] + (size_t)l * 512 * 512, 512, 512, 0, 512, (bf16_t*)(ws + W_GLU), 128, 256, scr, gw, nw, lane);
        ROT(128);
        tr_job(p.in[24] + (size_t)l * 512 * 1024, 512, 1024, 0, 1024, (bf16_t*)(ws + W_BS5), 0, 128, scr, gw, nw, lane, 1024);
        ROT(256);
        tr_job(p.in[25] + (size_t)l * 1024 * 1024, 1024, 1024, 0, 1024, (bf16_t*)(ws + W_BML), 0, 128, scr, gw, nw, lane);
        ROT(512);
        tr_job(p.in[26] + (size_t)l * 1024 * 1024, 1024, 1024, 0, 1024, (bf16_t*)(ws + W_OUT), 0, 128, scr, gw, nw, lane);
        ROT(512);
        for (int h = 0; h < 4; ++h) {
            tr_job(p.in[20] + ((size_t)l * 4 + h) * 65536, 256, 256, 0, 256, (bf16_t*)(ws + W_QK), h * 256, 128, scr, gw, nw, lane);
            ROT(32);
            tr_job(p.in[21] + ((size_t)l * 4 + h) * 65536, 256, 256, 0, 256, (bf16_t*)(ws + W_QK), 1024 + h * 256, 128, scr, gw, nw, lane);
            ROT(32);
        }
    }
#undef ROT
}

template <bool WITH_IF>
__device__ __forceinline__ void rmsnorm_phase(const float* x, const float* gain, bf16_t* xn, const float* win_l, const float* bif, float* ifbuf, LAS unsigned char* lds) {
    const int tid = opaque_tid(); const int wid = tid >> 6, lane = tid & 63;
    LAS float* ifw = (LAS float*)lds;
    if (WITH_IF) {
        for (int k = tid; k < 1024; k += 512) { const f32x4 a = *(const f32x4*)(win_l + (size_t)k * INC + 3584), b = *(const f32x4*)(win_l + (size_t)k * INC + 3588);
            *(LAS f32x4*)(ifw + k * 8) = a; *(LAS f32x4*)(ifw + k * 8 + 4) = b; }
        __syncthreads();
    }
    f32x4 gv[4];
#pragma unroll
    for (int i = 0; i < 4; ++i) gv[i] = *(const f32x4*)(gain + 4 * (lane + 64 * i));
    const int nw = gridDim.x * 8;
    constexpr int RPT = WITH_IF ? 4 : 8;
    for (int row0 = blockIdx.x * 8 + wid; row0 < MTOK; row0 += RPT * nw) {
        f32x4 v[RPT][4];
#pragma unroll
        for (int q = 0; q < RPT; ++q) { const int row = (row0 + q * nw < MTOK) ? row0 + q * nw : row0;
#pragma unroll
            for (int i = 0; i < 4; ++i) v[q][i] = *(const f32x4*)(x + (size_t)row * DM + 4 * (lane + 64 * i)); }
        asm volatile("" ::: "memory");
#pragma unroll
        for (int q = 0; q < RPT; ++q) { const int row = row0 + q * nw;
            float ss = 0.f;
#pragma unroll
            for (int i = 0; i < 4; ++i) ss += (v[q][i].x * v[q][i].x + v[q][i].y * v[q][i].y) + (v[q][i].z * v[q][i].z + v[q][i].w * v[q][i].w);
            ss = wave_sum(ss);
            const float r = rsqrtf(ss * (1.0f / DM) + EPS);
            float ga[8];
            if (WITH_IF) {
#pragma unroll
                for (int j = 0; j < 8; ++j) ga[j] = 0.f;
            }
            if (row < MTOK) {
#pragma unroll
                for (int i = 0; i < 4; ++i) { const f32x4 y = v[q][i] * r * gv[i];
                    u32x2 o; o.x = cvt_pk_bf16(y.x, y.y); o.y = cvt_pk_bf16(y.z, y.w);
                    *(u32x2*)(xn + (size_t)row * DM + 4 * (lane + 64 * i)) = o;
                    if (WITH_IF) {
#pragma unroll
                        for (int e = 0; e < 4; ++e) { const int k = 4 * (lane + 64 * i) + e; const f32x4 a = *(LAS f32x4*)(ifw + k * 8), b = *(LAS f32x4*)(ifw + k * 8 + 4); const float xv = y[e];
                            ga[0] += xv * a.x; ga[1] += xv * a.y; ga[2] += xv * a.z; ga[3] += xv * a.w; ga[4] += xv * b.x; ga[5] += xv * b.y; ga[6] += xv * b.z; ga[7] += xv * b.w; }
                        asm volatile("" ::: "memory");
                    }
                }
                if (WITH_IF) {
#pragma unroll
                    for (int j = 0; j < 8; ++j) ga[j] = wave_sum(ga[j]);
                    if (lane == 0) { *(f32x4*)(ifbuf + (size_t)row * 8) = (f32x4){ga[0] + bif[0], ga[1] + bif[1], ga[2] + bif[2], ga[3] + bif[3]};
                        *(f32x4*)(ifbuf + (size_t)row * 8 + 4) = (f32x4){ga[4] + bif[4], ga[5] + bif[5], ga[6] + bif[6], ga[7] + bif[7]}; }
                }
            }
        }
    }
}
__device__ __forceinline__ void final_norm_phase(float* x, const float* gain) {
    const int tid = opaque_tid(); const int wid = tid >> 6, lane = tid & 63;
    f32x4 gv[4];
#pragma unroll
    for (int i = 0; i < 4; ++i) gv[i] = *(const f32x4*)(gain + 4 * (lane + 64 * i));
    for (int row = blockIdx.x * 8 + wid; row < MTOK; row += gridDim.x * 8) {
        float* xr = x + (size_t)row * DM;
        f32x4 v[4]; float ss = 0.f;
#pragma unroll
        for (int i = 0; i < 4; ++i) { v[i] = *(const f32x4*)(xr + 4 * (lane + 64 * i)); ss += (v[i].x * v[i].x + v[i].y * v[i].y) + (v[i].z * v[i].z + v[i].w * v[i].w); }
        ss = wave_sum(ss);
        const float r = rsqrtf(ss * (1.0f / DM) + EPS);
#pragma unroll
        for (int i = 0; i < 4; ++i) *(f32x4*)(xr + 4 * (lane + 64 * i)) = v[i] * r * gv[i];
    }
}

__device__ __forceinline__ void conv_phase(const KP& p, int l) {
    const bf16_t* proj = (const bf16_t*)(p.ws + O_BIG); bf16_t* xc = (bf16_t*)(p.ws + O_XC);
    const int gt = blockIdx.x * 512 + opaque_tid(), c8 = gt & 127;
    const float* cw = p.in[18] + (size_t)l * 4 * 1024 + c8 * 8; const float* cb = p.in[19] + (size_t)l * 1024 + c8 * 8;
    float w[4][8], bias[8];
#pragma unroll
    for (int j = 0; j < 4; ++j) { const f32x4 a = *(const f32x4*)(cw + j * 1024), b = *(const f32x4*)(cw + j * 1024 + 4); w[j][0] = a.x; w[j][1] = a.y; w[j][2] = a.z; w[j][3] = a.w; w[j][4] = b.x; w[j][5] = b.y; w[j][6] = b.z; w[j][7] = b.w; }
    { const f32x4 a = *(const f32x4*)cb, b = *(const f32x4*)(cb + 4); bias[0] = a.x; bias[1] = a.y; bias[2] = a.z; bias[3] = a.w; bias[4] = b.x; bias[5] = b.y; bias[6] = b.z; bias[7] = b.w; }
    const int nthr = gridDim.x * 512;
    for (int idx0 = gt; idx0 < MTOK * 128; idx0 += 4 * nthr) {
        u32x4 v[4][4];
#pragma unroll
        for (int q = 0; q < 4; ++q) { const int idx = idx0 + q * nthr; const int t = idx >> 7, pos = t & (SEQ - 1);
#pragma unroll
            for (int j = 0; j < 4; ++j) { v[q][j] = (u32x4){0u, 0u, 0u, 0u}; if (idx < MTOK * 128 && pos - 3 + j >= 0) v[q][j] = *(const u32x4*)(proj + (size_t)(t - 3 + j) * NPROJ + 512 + c8 * 8); } }
        asm volatile("" ::: "memory");
#pragma unroll
        for (int q = 0; q < 4; ++q) { const int idx = idx0 + q * nthr; const int t = idx >> 7;
            float y[8];
#pragma unroll
            for (int e = 0; e < 8; ++e) y[e] = bias[e];
#pragma unroll
            for (int j = 0; j < 4; ++j) { const u32x4 vv = v[q][j];
                y[0] += w[j][0] * bflo(vv.x); y[1] += w[j][1] * bfhi(vv.x); y[2] += w[j][2] * bflo(vv.y); y[3] += w[j][3] * bfhi(vv.y);
                y[4] += w[j][4] * bflo(vv.z); y[5] += w[j][5] * bfhi(vv.z); y[6] += w[j][6] * bflo(vv.w); y[7] += w[j][7] * bfhi(vv.w); }
            u32x4 o; o.x = cvt_pk_bf16(siluf_(y[0]), siluf_(y[1])); o.y = cvt_pk_bf16(siluf_(y[2]), siluf_(y[3])); o.z = cvt_pk_bf16(siluf_(y[4]), siluf_(y[5])); o.w = cvt_pk_bf16(siluf_(y[6]), siluf_(y[7]));
            if (idx < MTOK * 128) *(u32x4*)(xc + (size_t)t * DM + c8 * 8) = o; }
    }
}

__device__ __forceinline__ void conv_slice(const KP& p, int l, int pm, int head) {
    const bf16_t* proj = (const bf16_t*)(p.ws + O_BIG); bf16_t* xc = (bf16_t*)(p.ws + O_XC);
    const int tid = opaque_tid(); const int c8 = head * 32 + (tid & 31), rsub = tid >> 5;
    const float* cw = p.in[18] + (size_t)l * 4 * 1024 + c8 * 8; const float* cb = p.in[19] + (size_t)l * 1024 + c8 * 8;
    float w[4][8], bias[8];
#pragma unroll
    for (int j = 0; j < 4; ++j) { const f32x4 a = *(const f32x4*)(cw + j * 1024), b = *(const f32x4*)(cw + j * 1024 + 4); w[j][0] = a.x; w[j][1] = a.y; w[j][2] = a.z; w[j][3] = a.w; w[j][4] = b.x; w[j][5] = b.y; w[j][6] = b.z; w[j][7] = b.w; }
    { const f32x4 a = *(const f32x4*)cb, b = *(const f32x4*)(cb + 4); bias[0] = a.x; bias[1] = a.y; bias[2] = a.z; bias[3] = a.w; bias[4] = b.x; bias[5] = b.y; bias[6] = b.z; bias[7] = b.w; }
    for (int j0 = 0; j0 < 16; j0 += 4) {
        u32x4 v[4][4];
#pragma unroll
        for (int q = 0; q < 4; ++q) { const int t = pm * 256 + rsub + 16 * (j0 + q), pos = t & (SEQ - 1);
#pragma unroll
            for (int j = 0; j < 4; ++j) { v[q][j] = (u32x4){0u, 0u, 0u, 0u}; if (pos - 3 + j >= 0) v[q][j] = *(const u32x4*)(proj + (size_t)(t - 3 + j) * NPROJ + 512 + c8 * 8); } }
        asm volatile("" ::: "memory");
#pragma unroll
        for (int q = 0; q < 4; ++q) { const int t = pm * 256 + rsub + 16 * (j0 + q);
            float y[8];
#pragma unroll
            for (int e = 0; e < 8; ++e) y[e] = bias[e];
#pragma unroll
            for (int j = 0; j < 4; ++j) { const u32x4 vv = v[q][j];
                y[0] += w[j][0] * bflo(vv.x); y[1] += w[j][1] * bfhi(vv.x); y[2] += w[j][2] * bflo(vv.y); y[3] += w[j][3] * bfhi(vv.y);
                y[4] += w[j][4] * bflo(vv.z); y[5] += w[j][5] * bfhi(vv.z); y[6] += w[j][6] * bflo(vv.w); y[7] += w[j][7] * bfhi(vv.w); }
            u32x4 o; o.x = cvt_pk_bf16(siluf_(y[0]), siluf_(y[1])); o.y = cvt_pk_bf16(siluf_(y[2]), siluf_(y[3])); o.z = cvt_pk_bf16(siluf_(y[4]), siluf_(y[5])); o.w = cvt_pk_bf16(siluf_(y[6]), siluf_(y[7]));
            *(u32x4*)(xc + (size_t)t * DM + c8 * 8) = o; }
    }
}

template <bool PASSC>
__device__ __forceinline__ void s5_phase(const KP& p, int l, LAS unsigned char* lds) {
    const int tid = opaque_tid(); const int wid = tid >> 6, lane = tid & 63, fr = lane & 15, fq = lane >> 4;
    LAS float* buS = (LAS float*)(lds + wid * 12800);
    LAS unsigned char* sS = lds + wid * 12800 + 8448;
    const bf16_t* proj = (const bf16_t*)(p.ws + O_BIG); bf16_t* z = (bf16_t*)(p.ws + O_Z);
    f32x2* s5end = (f32x2*)(p.ws + O_S5END);
    for (int task = blockIdx.x * 8 + wid; task < 2048; task += gridDim.x * 8) {
        const int seq = task >> 5, c = task & 31, b = seq >> 5, g = seq & 31, n = lane, lg = l * 32 + g;
        const float dt = expf(p.in[10][lg]);
        float ar, ai;
        { const float lr = fminf(p.in[8][lg * 64 + n], -1e-4f), li = p.in[9][lg * 64 + n];
          const float mag = expf(lr * dt); float sn, cs; sincos_acc(li * dt, sn, cs); ar = mag * cs; ai = mag * sn; }
        bf16x8 bx[8];
#pragma unroll
        for (int q4 = 0; q4 < 4; ++q4) { const int n2 = q4 * 16 + fr;
            const float lr = fminf(p.in[8][lg * 64 + n2], -1e-4f), li = p.in[9][lg * 64 + n2];
            const float mag = expf(lr * dt); float sn, cs; sincos_acc(li * dt, sn, cs);
            const float a_r = mag * cs, a_i = mag * sn, den = lr * lr + li * li;
            float qr = ((a_r - 1.0f) * lr + a_i * li) / den, qi = (a_i * lr - (a_r - 1.0f) * li) / den;
            if (fq >= 2) { qr = 0.f; qi = 0.f; }
            const float* brp = p.in[11] + (size_t)(lg * 64 + n2) * 16 + (fq & 1) * 8; const float* bip = p.in[12] + (size_t)(lg * 64 + n2) * 16 + (fq & 1) * 8;
            const f32x4 br0 = *(const f32x4*)brp, br1 = *(const f32x4*)(brp + 4), bi0 = *(const f32x4*)bip, bi1 = *(const f32x4*)(bip + 4);
            const f32x4 re0 = qr * br0 - qi * bi0, re1 = qr * br1 - qi * bi1, im0 = qr * bi0 + qi * br0, im1 = qr * bi1 + qi * br1;
            u32x4 o; o.x = cvt_pk_bf16(re0.x, re0.y); o.y = cvt_pk_bf16(re0.z, re0.w); o.z = cvt_pk_bf16(re1.x, re1.y); o.w = cvt_pk_bf16(re1.z, re1.w);
            bx[q4] = __builtin_bit_cast(bf16x8, o);
            o.x = cvt_pk_bf16(im0.x, im0.y); o.y = cvt_pk_bf16(im0.z, im0.w); o.z = cvt_pk_bf16(im1.x, im1.y); o.w = cvt_pk_bf16(im1.z, im1.w);
            bx[4 + q4] = __builtin_bit_cast(bf16x8, o); }
        float sr = 0.f, si = 0.f;
        bf16x8 cm[4]; f32x4 d4 = (f32x4){0.f, 0.f, 0.f, 0.f};
        if (PASSC) {
            float xr = ar, xi = ai;
#pragma unroll
            for (int q = 0; q < 8; ++q) { const float t0 = xr * xr - xi * xi, t1 = 2.0f * xr * xi; xr = t0; xi = t1; }
            for (int c0 = 0; c0 < c; c0 += 16) {
                f32x2 ev[16];
#pragma unroll
                for (int j = 0; j < 16; ++j) { const int cc = (c0 + j < c) ? c0 + j : c - 1; ev[j] = s5end[(size_t)(seq * 32 + cc) * 64 + n]; }
#pragma unroll
                for (int j = 0; j < 16; ++j) { const bool on = c0 + j < c; const float t0 = sr * xr - si * xi + ev[j].x, t1 = sr * xi + si * xr + ev[j].y; sr = on ? t0 : sr; si = on ? t1 : si; }
            }
#pragma unroll
            for (int kb = 0; kb < 4; ++kb) { const float* src = (kb < 2 ? p.in[13] : p.in[14]) + (size_t)(lg * 16 + fr) * 64 + (kb & 1) * 32 + fq * 8;
                const f32x4 a = *(const f32x4*)src, bq = *(const f32x4*)(src + 4); const float sg = kb < 2 ? 1.0f : -1.0f;
                u32x4 o; o.x = cvt_pk_bf16(sg * a.x, sg * a.y); o.y = cvt_pk_bf16(sg * a.z, sg * a.w); o.z = cvt_pk_bf16(sg * bq.x, sg * bq.y); o.w = cvt_pk_bf16(sg * bq.z, sg * bq.w);
                cm[kb] = __builtin_bit_cast(bf16x8, o); }
            d4 = *(const f32x4*)(p.in[15] + (size_t)l * 512 + g * 16 + fq * 4);
        }
        const int tok0 = b * SEQ + c * 256;
        const bf16_t* urow0 = proj + (size_t)(tok0 + fr) * NPROJ + g * 16;
        u32x4 unext = *(const u32x4*)(urow0 + (fq & 1) * 8); u32x2 u4next = *(const u32x2*)(urow0 + fq * 4);
        for (int sub = 0; sub < 16; ++sub) {
            u32x4 uraw = unext; const u32x2 u4 = u4next;
            if (sub < 15) { const bf16_t* urow = urow0 + (size_t)(sub + 1) * 16 * NPROJ; unext = *(const u32x4*)(urow + (fq & 1) * 8); u4next = *(const u32x2*)(urow + fq * 4); }
            if (fq >= 2) uraw = (u32x4){0u, 0u, 0u, 0u};
            const bf16x8 yu = __builtin_bit_cast(bf16x8, uraw);
#pragma unroll
            for (int kb = 0; kb < 8; ++kb) { const f32x4 acc = __builtin_amdgcn_mfma_f32_16x16x32_bf16(bx[kb], yu, (f32x4){0.f, 0.f, 0.f, 0.f}, 0, 0, 0);
                *(LAS f32x4*)(buS + fr * 132 + kb * 16 + fq * 4) = acc; }
            WAVE_LDS_SYNC();
            float burv[16], buiv[16];
#pragma unroll
            for (int tt = 0; tt < 16; ++tt) { burv[tt] = buS[tt * 132 + n]; buiv[tt] = buS[tt * 132 + 64 + n]; }
#pragma unroll
            for (int tt = 0; tt < 16; ++tt) {
                const float bur = burv[tt], bui = buiv[tt];
                const float t0 = ar * sr - ai * si + bur, t1 = ar * si + ai * sr + bui; sr = t0; si = t1;
                if (PASSC) { const unsigned pk = cvt_pk_bf16(sr, si); *(LAS unsigned short*)(sS + tt * 272 + n * 2) = (unsigned short)(pk & 0xffffu); *(LAS unsigned short*)(sS + tt * 272 + 128 + n * 2) = (unsigned short)(pk >> 16); }
            }
            if (PASSC) {
                WAVE_LDS_SYNC();
                f32x4 acc = (f32x4){0.f, 0.f, 0.f, 0.f};
#pragma unroll
                for (int kb = 0; kb < 4; ++kb) { const bf16x8 yf = *(LAS bf16x8*)(sS + fr * 272 + (kb * 32 + fq * 8) * 2); acc = __builtin_amdgcn_mfma_f32_16x16x32_bf16(cm[kb], yf, acc, 0, 0, 0); }
                const f32x4 uv = (f32x4){bflo(u4.x), bfhi(u4.x), bflo(u4.y), bfhi(u4.y)};
                const f32x4 y = acc + d4 * uv;
                u32x2 o; o.x = cvt_pk_bf16(gelu_tanh(y.x), gelu_tanh(y.y)); o.y = cvt_pk_bf16(gelu_tanh(y.z), gelu_tanh(y.w));
                *(u32x2*)(z + (size_t)(tok0 + sub * 16 + fr) * 512 + g * 16 + fq * 4) = o;
            }
            WAVE_LDS_SYNC();
        }
        if (!PASSC) s5end[(size_t)(seq * 32 + c) * 64 + n] = (f32x2){sr, si};
    }
}

__device__ __forceinline__ float scan_sum128(float v, int tid, LAS float* tmp) {
    const int lane = tid & 63; float x = v;
#pragma unroll
    for (int o = 1; o < 64; o <<= 1) { const float y = __shfl_up(x, o); if (lane >= o) x += y; }
    if (tid == 63) tmp[0] = x;
    __syncthreads();
    if (tid >= 64 && tid < 128) x += tmp[0];
    return x;
}
__device__ __forceinline__ float scan_max128(float v, int tid, LAS float* tmp) {
    const int lane = tid & 63; float x = v;
#pragma unroll
    for (int o = 1; o < 64; o <<= 1) { const float y = __shfl_up(x, o); if (lane >= o) x = fmaxf(x, y); }
    if (tid == 63) tmp[1] = x;
    __syncthreads();
    if (tid >= 64 && tid < 128) x = fmaxf(x, tmp[1]);
    return x;
}
__device__ __forceinline__ bf16x8 tr_frag(LAS unsigned char* a0, int second_off) {
    const s16x4 lo = __builtin_amdgcn_ds_read_tr16_b64_v4i16((LAS s16x4*)a0);
    const s16x4 hi = __builtin_amdgcn_ds_read_tr16_b64_v4i16((LAS s16x4*)(a0 + second_off));
    return __builtin_shufflevector(lo, hi, 0, 1, 2, 3, 4, 5, 6, 7);
}
template <bool OWN> __device__ __forceinline__ void mlstm_s1_phase(const KP& p, LAS unsigned char* lds) {
    const int tid = opaque_tid(), wid = tid >> 6, lane = tid & 63, fr = lane & 15, fq = lane >> 4;
    const bf16_t* proj = (const bf16_t*)(p.ws + O_BIG); const bf16_t* kbuf = (const bf16_t*)(p.ws + O_K);
    const float* ifb = (const float*)(p.ws + O_IF); bf16_t* cst = (bf16_t*)(p.ws + O_CST);
    float* gout = (float*)(p.ws + O_G); float* mlout = (float*)(p.ws + O_MLOC); float* nloc = (float*)(p.ws + O_NLOC);
    LAS unsigned char* Ks = lds; LAS unsigned char* Vs = lds + 69632;
    LAS float* vlf = (LAS float*)(lds + VEC_OFF); LAS float* vi = vlf + 128; LAS float* vb = vlf + 256; LAS float* vdec = vlf + 384;
    const int own_pm = (int)blockIdx.x >> 2, own_bhc0 = (((own_pm >> 5) * 4 + ((int)blockIdx.x & 3)) * 64) + (own_pm & 31) * 2;
    for (int tk = OWN ? 0 : (int)blockIdx.x; tk < (OWN ? 4 : 1024); tk += OWN ? 1 : (int)gridDim.x) {
        const int task = OWN ? (((own_bhc0 + (tk >> 1)) << 1) | (tk & 1)) : tk;
        const int eh = task & 1, bhc = task >> 1, c = bhc & 63, bh = bhc >> 6, h = bh & 3, b = bh >> 2;
        const int tok0 = b * SEQ + c * 128;
        const bool newk = !OWN || eh == 0;
        u32x4 kv[8], vv[4];
        if (newk) {
#pragma unroll
            for (int it = 0; it < 8; ++it) { const int id = it * 512 + tid, s = id >> 5, ch = id & 31; kv[it] = *(const u32x4*)(kbuf + (unsigned)(tok0 + s) * DM + h * 256 + ch * 8); }
        }
#pragma unroll
        for (int it = 0; it < 4; ++it) { const int id = it * 512 + tid, s = id >> 4, ch = id & 15; vv[it] = *(const u32x4*)(proj + (unsigned)(tok0 + s) * NPROJ + 1536 + h * 256 + eh * 128 + ch * 8); }
        LAS float* tmp = vlf;
        float gg = 0.f, mloc = 0.f;
        if (newk) {
        float gi = 0.f, glf = 0.f;
        if (tid < 128) { gi = ifb[(size_t)(tok0 + tid) * 8 + h]; glf = logsigmoidf_(ifb[(size_t)(tok0 + tid) * 8 + 4 + h]); }
        const float bsum = scan_sum128(glf, tid, tmp);
        if (tid == 127) tmp[2] = bsum;
        __syncthreads();
        gg = tmp[2];
        float dec = -INFINITY;
        if (tid < 128) { dec = gg - bsum + gi; vdec[tid] = dec; }
        { float x = dec;
#pragma unroll
          for (int o = 1; o < 64; o <<= 1) x = fmaxf(x, __shfl_xor(x, o));
          if (lane == 0 && wid < 2) tmp[4 + wid] = x; }
        __syncthreads();
        mloc = fmaxf(tmp[4], tmp[5]);
        asm volatile("" ::: "memory");
#pragma unroll
        for (int it = 0; it < 8; ++it) { const int id = it * 512 + tid, s = id >> 5, ch = id & 31;
            const u32x4 v = kv[it]; const float w = __expf(vdec[s] - mloc);
            u32x4 o; o.x = cvt_pk_bf16(bflo(v.x) * w, bfhi(v.x) * w); o.y = cvt_pk_bf16(bflo(v.y) * w, bfhi(v.y) * w); o.z = cvt_pk_bf16(bflo(v.z) * w, bfhi(v.z) * w); o.w = cvt_pk_bf16(bflo(v.w) * w, bfhi(v.w) * w);
            *(LAS u32x4*)(Ks + s * 544 + ch * 16) = o; }
        }
#pragma unroll
        for (int it = 0; it < 4; ++it) { const int id = it * 512 + tid, s = id >> 4, ch = id & 15;
            *(LAS u32x4*)(Vs + s * 288 + ch * 16) = vv[it]; }
        __syncthreads();
        f32x4 acc[2][8];
#pragma unroll
        for (int a = 0; a < 2; ++a)
#pragma unroll
            for (int e = 0; e < 8; ++e) acc[a][e] = (f32x4){0.f, 0.f, 0.f, 0.f};
#pragma unroll
        for (int kb = 0; kb < 4; ++kb) {
            bf16x8 X[2];
#pragma unroll
            for (int db = 0; db < 2; ++db) X[db] = tr_frag(Ks + (kb * 32 + fq * 4 + (fr >> 2)) * 544 + (32 * wid + db * 16 + (fr & 3) * 4) * 2, 16 * 544);
#pragma unroll
            for (int eb = 0; eb < 8; ++eb) { const bf16x8 Y = tr_frag(Vs + (kb * 32 + fq * 4 + (fr >> 2)) * 288 + (eb * 16 + (fr & 3) * 4) * 2, 16 * 288);
#pragma unroll
                for (int db = 0; db < 2; ++db) acc[db][eb] = __builtin_amdgcn_mfma_f32_16x16x32_bf16(X[db], Y, acc[db][eb], 0, 0, 0); }
        }
#pragma unroll
        for (int db = 0; db < 2; ++db)
#pragma unroll
            for (int eb = 0; eb < 8; ++eb) { u32x2 o; o.x = cvt_pk_bf16(acc[db][eb][0], acc[db][eb][1]); o.y = cvt_pk_bf16(acc[db][eb][2], acc[db][eb][3]);
                *(u32x2*)(cst + (size_t)bhc * 65536 + (size_t)(eh * 128 + eb * 16 + fr) * 256 + 32 * wid + db * 16 + fq * 4) = o; }
        if (eh == 0) {
            if (tid < 256) { float sn = 0.f;
                for (int s0 = 0; s0 < 128; s0 += 16) { unsigned short tv[16];
#pragma unroll
                    for (int j = 0; j < 16; ++j) tv[j] = *(LAS unsigned short*)(Ks + (s0 + j) * 544 + tid * 2);
#pragma unroll
                    for (int j = 0; j < 16; ++j) sn += bflo((unsigned)tv[j]); }
                nloc[(size_t)bhc * 256 + tid] = sn; }
            if (tid == 0) { gout[bhc] = gg; mlout[bhc] = mloc; }
        }
        __syncthreads();
    }
}
__device__ __forceinline__ void mlstm_s2_phase(const KP& p) {
    const int tid = opaque_tid();
    bf16_t* cst = (bf16_t*)(p.ws + O_CST);
    const float* gin = (const float*)(p.ws + O_G); const float* mlin = (const float*)(p.ws + O_MLOC); float* mst = (float*)(p.ws + O_MST);
    const float* nloc = (const float*)(p.ws + O_NLOC); float* nst = (float*)(p.ws + O_NST);
    for (int slot = blockIdx.x; slot < 256; slot += gridDim.x) {
        const int bh = slot >> 5, part = slot & 31; const size_t e0 = (size_t)(part * 512 + tid) * 4;
        float m = 0.f, C0 = 0.f, C1 = 0.f, C2 = 0.f, C3 = 0.f, nv = 0.f;
        const bool do_n = (part == 0) && (tid < 256);
        for (int c8 = 0; c8 < 64; c8 += 8) {
            u32x2 loc[8]; float nl[8];
#pragma unroll
            for (int j = 0; j < 8; ++j) { loc[j] = *(const u32x2*)(cst + (size_t)(bh * 64 + c8 + j) * 65536 + e0); nl[j] = do_n ? nloc[(size_t)(bh * 64 + c8 + j) * 256 + tid] : 0.f; }
#pragma unroll
            for (int j = 0; j < 8; ++j) { const int idx = bh * 64 + c8 + j;
                const float g = gin[idx], ml = mlin[idx]; const float mnew = fmaxf(g + m, ml); const float wo = __expf(g + m - mnew), wl = __expf(ml - mnew);
                u32x2 o; o.x = cvt_pk_bf16(C0, C1); o.y = cvt_pk_bf16(C2, C3);
                *(u32x2*)(cst + (size_t)idx * 65536 + e0) = o;
                C0 = wo * C0 + wl * bflo(loc[j].x); C1 = wo * C1 + wl * bfhi(loc[j].x); C2 = wo * C2 + wl * bflo(loc[j].y); C3 = wo * C3 + wl * bfhi(loc[j].y);
                if (do_n) { nst[(size_t)idx * 256 + tid] = nv; nv = wo * nv + wl * nl[j]; if (tid == 0) mst[idx] = m; }
                m = mnew; }
        }
    }
}
__device__ __forceinline__ void mlstm_s3_phase(const KP& p, int l, LAS unsigned char* lds) {
    const int tid = opaque_tid(), wid = tid >> 6, lane = tid & 63, fr = lane & 15, fq = lane >> 4;
    const bf16_t* proj = (const bf16_t*)(p.ws + O_BIG); const bf16_t* qbuf = (const bf16_t*)(p.ws + O_Q); const bf16_t* kbuf = (const bf16_t*)(p.ws + O_K);
    const bf16_t* xc = (const bf16_t*)(p.ws + O_XC); const float* ifb = (const float*)(p.ws + O_IF); const bf16_t* cst = (const bf16_t*)(p.ws + O_CST);
    const float* mst = (const float*)(p.ws + O_MST); const float* nst = (const float*)(p.ws + O_NST); bf16_t* yml = (bf16_t*)(p.ws + O_XN);
    const float* normg = p.in[22] + (unsigned)l * 1024; const float* skipg = p.in[23] + (unsigned)l * 1024;
    LAS unsigned char* Vh = lds;
    LAS unsigned char* Qs = lds + 36864;
    LAS unsigned char* Kt = lds + 55296;
    LAS unsigned char* CTs = lds + 73728;
    LAS unsigned char* Ss = lds + 92160;
    LAS float* vlf = (LAS float*)(lds + VEC_OFF); LAS float* va = vlf + 128; LAS float* vb = vlf + 256; LAS float* vM = vlf + 384; LAS float* nvec = vlf + 512;
    for (int task = blockIdx.x; task < 512; task += gridDim.x) {
        const int bhc = task, c = bhc & 63, bh = bhc >> 6, h = bh & 3, b = bh >> 2;
        const int tok0 = b * SEQ + c * 128;
        const float m0 = mst[bhc];
        float gi = 0.f, glf = 0.f;
        if (tid < 128) { gi = ifb[(unsigned)(tok0 + tid) * 8 + h]; glf = logsigmoidf_(ifb[(unsigned)(tok0 + tid) * 8 + 4 + h]); }
        if (tid < 256) nvec[tid] = nst[(unsigned)bhc * 256 + tid];
        const float bs = scan_sum128(glf, tid, vlf);
        const float av = (tid < 128) ? gi - bs : -INFINITY;
        const float mm = scan_max128(av, tid, vlf);
        if (tid < 128) { vb[tid] = bs; va[tid] = av; vM[tid] = fmaxf(m0, mm); }
        const int t = 16 * wid + fr;
        const unsigned tok = (unsigned)(tok0 + t);
        u32x2 hc0[8];
        float qn = 0.f, ss = 0.f, inv = 0.f, winter = 0.f;
#pragma unroll
        for (int eh = 0; eh < 2; ++eh) {
            f32x4 accS[8], accO[8];
#pragma unroll
            for (int i = 0; i < 8; ++i) { accS[i] = (f32x4){0.f, 0.f, 0.f, 0.f}; accO[i] = (f32x4){0.f, 0.f, 0.f, 0.f}; }
            u32x4 pq[2], pk[2], pc[2];
#define S3_LOAD(DB) do { _Pragma("unroll") for (int it = 0; it < 2; ++it) { const int id = it * 512 + tid, row = id >> 3, ch = id & 7; \
                    pq[it] = *(const u32x4*)(qbuf + (unsigned)(tok0 + row) * DM + h * 256 + (DB) * 64 + ch * 8); \
                    if (eh == 0) pk[it] = *(const u32x4*)(kbuf + (unsigned)(tok0 + row) * DM + h * 256 + (DB) * 64 + ch * 8); \
                    pc[it] = *(const u32x4*)(cst + (unsigned)bhc * 65536 + (unsigned)(eh * 128 + row) * 256 + (DB) * 64 + ch * 8); } } while (0)
            S3_LOAD(0);
            for (int db4 = 0; db4 < 4; ++db4) {
                __syncthreads();
#pragma unroll
                for (int it = 0; it < 2; ++it) { const int id = it * 512 + tid, row = id >> 3, ch = id & 7;
                    *(LAS u32x4*)(Qs + row * 144 + ch * 16) = pq[it];
                    if (eh == 0) *(LAS u32x4*)(Kt + row * 144 + ch * 16) = pk[it];
                    *(LAS u32x4*)(CTs + row * 144 + ch * 16) = pc[it]; }
                if (db4 < 3) S3_LOAD(db4 + 1);
                __syncthreads();
#pragma unroll
                for (int kk = 0; kk < 2; ++kk) {
                    const bf16x8 Qf = *(LAS bf16x8*)(Qs + (16 * wid + fr) * 144 + (kk * 32 + fq * 8) * 2);
                    if (eh == 0) {
                        const u32x4 qu = __builtin_bit_cast(u32x4, Qf); const LAS float* nvp = nvec + db4 * 64 + kk * 32 + fq * 8; const f32x4 n0 = *(LAS f32x4*)nvp, n1 = *(LAS f32x4*)(nvp + 4);
                        qn += bflo(qu.x) * n0.x + bfhi(qu.x) * n0.y + bflo(qu.y) * n0.z + bfhi(qu.y) * n0.w + bflo(qu.z) * n1.x + bfhi(qu.z) * n1.y + bflo(qu.w) * n1.z + bfhi(qu.w) * n1.w;
#pragma unroll
                        for (int sb = 0; sb < 8; ++sb) { if (sb <= wid) { const bf16x8 Kf = *(LAS bf16x8*)(Kt + (sb * 16 + fr) * 144 + (kk * 32 + fq * 8) * 2); accS[sb] = __builtin_amdgcn_mfma_f32_16x16x32_bf16(Kf, Qf, accS[sb], 0, 0, 0); } if ((sb & 3) == 3) { asm volatile("" ::: "memory"); __builtin_amdgcn_sched_barrier(0); } }
                    }
#pragma unroll
                    for (int eb = 0; eb < 8; ++eb) { const bf16x8 Cf = *(LAS bf16x8*)(CTs + (eb * 16 + fr) * 144 + (kk * 32 + fq * 8) * 2); accO[eb] = __builtin_amdgcn_mfma_f32_16x16x32_bf16(Cf, Qf, accO[eb], 0, 0, 0); if ((eb & 3) == 3) { asm volatile("" ::: "memory"); __builtin_amdgcn_sched_barrier(0); } }
                }
            }
            u32x4 vt[4];
#pragma unroll
            for (int it = 0; it < 4; ++it) { const int id = it * 512 + tid, s = id >> 4, ch = id & 15; vt[it] = *(const u32x4*)(proj + (unsigned)(tok0 + s) * NPROJ + 1536 + h * 256 + eh * 128 + ch * 8); }
            asm volatile("" ::: "memory");
#pragma unroll
            for (int it = 0; it < 4; ++it) { const int id = it * 512 + tid, s = id >> 4, ch = id & 15; *(LAS u32x4*)(Vh + s * 288 + ch * 16) = vt[it]; }
            if (eh == 0) {
                const float Mt = vM[t]; winter = __expf(m0 - Mt);
                float rowsum = 0.f;
#pragma unroll
                for (int sb = 0; sb < 8; ++sb) if (sb <= (wid | 1)) {
                    const f32x4 a4 = *(LAS f32x4*)(va + sb * 16 + fq * 4);
                    float sv[4];
#pragma unroll
                    for (int j = 0; j < 4; ++j) { const int s = sb * 16 + fq * 4 + j; const float v0 = accS[sb][j] * __expf(fminf(a4[j] - Mt, 0.f)); const float v = (s <= t) ? v0 : 0.f; sv[j] = v; rowsum += v; }
                    u32x2 o; o.x = cvt_pk_bf16(sv[0], sv[1]); o.y = cvt_pk_bf16(sv[2], sv[3]);
                    *(LAS u32x2*)(Ss + t * 272 + (sb * 16 + fq * 4) * 2) = o;
                }
                rowsum += __shfl_xor(rowsum, 16); rowsum += __shfl_xor(rowsum, 32);
                qn += __shfl_xor(qn, 16); qn += __shfl_xor(qn, 32);
                const float den = winter * qn + rowsum, mt = vb[t] + Mt;
                inv = 1.0f / fmaxf(fabsf(den), __expf(-mt));
            }
#pragma unroll
            for (int eb = 0; eb < 8; ++eb) accO[eb] = accO[eb] * winter;
            __syncthreads();
            for (int kb = 0; kb <= (wid >> 1); ++kb) {
                const s16x4 s0 = *(LAS s16x4*)(Ss + t * 272 + (kb * 32 + fq * 4) * 2), s1 = *(LAS s16x4*)(Ss + t * 272 + (kb * 32 + 16 + fq * 4) * 2);
                const bf16x8 Sf = __builtin_shufflevector(s0, s1, 0, 1, 2, 3, 4, 5, 6, 7);
#pragma unroll
                for (int eb = 0; eb < 8; ++eb) { const bf16x8 Vf = tr_frag(Vh + (kb * 32 + fq * 4 + (fr >> 2)) * 288 + (eb * 16 + (fr & 3) * 4) * 2, 16 * 288);
                    accO[eb] = __builtin_amdgcn_mfma_f32_16x16x32_bf16(Vf, Sf, accO[eb], 0, 0, 0); if ((eb & 3) == 3) { asm volatile("" ::: "memory"); __builtin_amdgcn_sched_barrier(0); } }
            }
            u32x2 ovv[8];
#pragma unroll
            for (int eb = 0; eb < 8; ++eb) ovv[eb] = *(const u32x2*)(proj + tok * NPROJ + 2560 + h * 256 + eh * 128 + eb * 16 + fq * 4);
            asm volatile("" ::: "memory");
#pragma unroll
            for (int eb = 0; eb < 8; ++eb) { const u32x2 ov = ovv[eb];
                f32x4 hc; hc.x = sigmoidf_(bflo(ov.x)) * accO[eb].x * inv; hc.y = sigmoidf_(bfhi(ov.x)) * accO[eb].y * inv; hc.z = sigmoidf_(bflo(ov.y)) * accO[eb].z * inv; hc.w = sigmoidf_(bfhi(ov.y)) * accO[eb].w * inv;
                ss += (hc.x * hc.x + hc.y * hc.y) + (hc.z * hc.z + hc.w * hc.w);
                if (eh == 0) { hc0[eb].x = cvt_pk_bf16(hc.x, hc.y); hc0[eb].y = cvt_pk_bf16(hc.z, hc.w); } else accO[eb] = hc;
                if ((eb & 3) == 3) { asm volatile("" ::: "memory"); __builtin_amdgcn_sched_barrier(0); } }
            if (eh == 1) {
                ss += __shfl_xor(ss, 16); ss += __shfl_xor(ss, 32);
                const float rs = rsqrtf(ss * (1.0f / 256.0f) + EPS);
#pragma unroll
                for (int e4 = 0; e4 < 8; ++e4) {
                    f32x4 ngv[2], skv[2]; u32x2 xvv[2];
#pragma unroll
                    for (int q = 0; q < 2; ++q) { const int col = h * 256 + (e4 * 2 + q) * 16 + fq * 4; ngv[q] = *(const f32x4*)(normg + col); skv[q] = *(const f32x4*)(skipg + col); xvv[q] = *(const u32x2*)(xc + tok * DM + col); }
                    asm volatile("" ::: "memory");
#pragma unroll
                    for (int q = 0; q < 2; ++q) { const int e2 = e4 * 2 + q, col = h * 256 + e2 * 16 + fq * 4;
                        const f32x4 ng = ngv[q], sk = skv[q]; const u32x2 xv = xvv[q];
                        f32x4 hc; if (e2 < 8) { const u32x2 hp = hc0[e2 & 7]; hc = (f32x4){bflo(hp.x), bfhi(hp.x), bflo(hp.y), bfhi(hp.y)}; } else hc = accO[e2 & 7];
                        u32x2 o; o.x = cvt_pk_bf16(hc.x * rs * ng.x + sk.x * bflo(xv.x), hc.y * rs * ng.y + sk.y * bfhi(xv.x)); o.y = cvt_pk_bf16(hc.z * rs * ng.z + sk.z * bflo(xv.y), hc.w * rs * ng.w + sk.w * bfhi(xv.y));
                        *(u32x2*)(yml + tok * DM + col) = o; }
                    asm volatile("" ::: "memory"); __builtin_amdgcn_sched_barrier(0);
                }
            }
        }
        __syncthreads();
    }
}

#define XB_TMO      128
#define XB_XCNT(j)  (256  + 64 * (j))
#define XB_XSUB(j)  (1280 + 64 * (j))
#define XB_XGEN(j)  (2304 + 64 * (j))
#define XB_TOP      3328
#define XB_TOPGEN   3392
#define XCD_BAR_WORDS 3456
#define XB_SPIN_CAP (1u << 22)
__device__ __forceinline__ unsigned xb_ld(unsigned* p)              { return __hip_atomic_load(p, __ATOMIC_RELAXED, __HIP_MEMORY_SCOPE_AGENT); }
__device__ __forceinline__ unsigned xb_add(unsigned* p, unsigned v) { return __hip_atomic_fetch_add(p, v, __ATOMIC_RELAXED, __HIP_MEMORY_SCOPE_AGENT); }
__device__ __forceinline__ unsigned xb_xcc_id() { return (unsigned)__builtin_amdgcn_s_getreg((3 << 11) | 20) & 0xFu; }
#define XB_SPIN(cond, bar) do { unsigned _sp = 0; while (cond) { __builtin_amdgcn_s_sleep(1); \
    if ((++_sp & 255u) == 0u) { if (xb_ld(&(bar)[XB_TMO])) break; if (_sp > XB_SPIN_CAP) { atomicAdd(&(bar)[XB_TMO], 1u); break; } } } } while (0)
struct XcdBarrier { unsigned* bar; unsigned x; volatile LAS unsigned* st; };
__device__ __forceinline__ XcdBarrier xcd_barrier_post(unsigned* bar, volatile LAS unsigned* st) {
    XcdBarrier b; b.bar = bar; b.x = xb_xcc_id(); b.st = st;
    if (threadIdx.x == 0) (void)xb_add(&bar[XB_XCNT(b.x)], 1u);
    return b;
}
__device__ __forceinline__ void xcd_barrier_complete(unsigned* bar, unsigned x, unsigned& nloc, unsigned& nx) {
    const unsigned G = gridDim.x * gridDim.y * gridDim.z;
    unsigned sum, cnt, mine, sp = 0u;
    for (;;) {
        sum = 0u; cnt = 0u; mine = 0u;
#pragma unroll
        for (unsigned j = 0; j < 16; ++j) { const unsigned c = xb_ld(&bar[XB_XCNT(j)]); sum += c; cnt += (c > 0u) ? 1u : 0u; mine = (j == x) ? c : mine; }
        if (sum == G) break;
        __builtin_amdgcn_s_sleep(1);
        if ((++sp & 255u) == 0u) { if (xb_ld(&bar[XB_TMO])) break; if (sp > XB_SPIN_CAP) { atomicAdd(&bar[XB_TMO], 1u); break; } }
    }
    nloc = mine > 0u ? mine : 1u; nx = cnt > 0u ? cnt : 1u;
}
__device__ __forceinline__ void xcd_barrier(const XcdBarrier& b) {
    asm volatile("s_waitcnt vmcnt(0) lgkmcnt(0)" ::: "memory");
    __syncthreads();
    if (threadIdx.x == 0) {
        unsigned* bar = b.bar;
        __builtin_amdgcn_s_waitcnt(0);
        unsigned nloc = b.st[0], nx = b.st[1];
        if (nloc == 0u) { xcd_barrier_complete(bar, b.x, nloc, nx); b.st[0] = nloc; b.st[1] = nx; }
        const unsigned old = xb_add(&bar[XB_XSUB(b.x)], 1u);
        const unsigned gen = old / nloc;
        if (old + 1u == (gen + 1u) * nloc) {
            __builtin_amdgcn_fence(__ATOMIC_RELEASE, "agent");
            asm volatile("s_waitcnt vmcnt(0)" ::: "memory");
            const unsigned og = xb_add(&bar[XB_TOP], 1u);
            const unsigned tg = og / nx;
            if (og + 1u == (tg + 1u) * nx) xb_add(&bar[XB_TOPGEN], 1u);
            else XB_SPIN(xb_ld(&bar[XB_TOPGEN]) == tg, bar);
            __builtin_amdgcn_fence(__ATOMIC_ACQUIRE, "agent");
            xb_add(&bar[XB_XGEN(b.x)], 1u);
            asm volatile("s_waitcnt vmcnt(0)" ::: "memory");
        } else {
            XB_SPIN(xb_ld(&bar[XB_XGEN(b.x)]) == gen, bar);
            __builtin_amdgcn_fence(__ATOMIC_ACQUIRE, "agent");
            asm volatile("s_waitcnt vmcnt(0)" ::: "memory");
        }
    }
    __syncthreads();
}

__global__ void __launch_bounds__(512, 2) fwd_megakernel(KP p) {
    extern __shared__ __attribute__((aligned(16))) unsigned char shm[];
    LAS unsigned char* lds = (LAS unsigned char*)shm;
    cg::grid_group grid = cg::this_grid();
    { volatile LAS unsigned* st0 = (volatile LAS unsigned*)(lds + 143360); if (threadIdx.x < 4) st0[threadIdx.x] = 0u; }
    __syncthreads();
    const XcdBarrier xb = xcd_barrier_post((unsigned*)(p.ws + O_BAR), (volatile LAS unsigned*)(lds + 143360));
    if (p.out == nullptr) { asm volatile("s_waitcnt vmcnt(0) lgkmcnt(0)" ::: "memory"); grid.sync(); }
#define GSYNC() xcd_barrier(xb)
    unsigned char* ws = p.ws;
    bf16_t* BIG = (bf16_t*)(ws + O_BIG); bf16_t* XN = (bf16_t*)(ws + O_XN); bf16_t* XC = (bf16_t*)(ws + O_XC);
    bf16_t* Q = (bf16_t*)(ws + O_Q); bf16_t* KB = (bf16_t*)(ws + O_K); bf16_t* Z = (bf16_t*)(ws + O_Z); bf16_t* YS5 = (bf16_t*)(ws + O_YS5);
    float* MIXACC = (float*)(ws + O_CST); float* IFB = (float*)(ws + O_IF);
    float* xo = p.out;
    for (int l = 0; l < 4; ++l) {
        const float* xcur = (l == 0) ? p.in[0] : xo;
        for (int rep = 0; rep < REP_A; ++rep) { if (l == 0) convert_phase(p, 0, lds, 1, 0);
        rmsnorm_phase<false>(xcur, p.in[1] + l * 1024, XN, nullptr, nullptr, nullptr, lds); }
        GSYNC(); if (STOP_PHASE == 1) break;
        { pg8::Gemm g{XN, (const bf16_t*)(ws + W_GU1), MTOK, 2 * FF, 1024, 1024, 1024, 0}; pg8::EpiGated<0> e{BIG, FF}; pg8::gemm_phase(lds, g, e); }
        convert_phase(p, l, lds, l == 0 ? 2 : 4, 1);
        GSYNC(); if (STOP_PHASE == 2) break;
        { pg8::Gemm g{BIG, (const bf16_t*)(ws + W_D1), MTOK, 1024, FF, FF, FF, 0}; pg8::EpiResid e{xcur, xo, 0.5f}; pg8::gemm_phase(lds, g, e); }
        GSYNC(); if (STOP_PHASE == 3) break;
        for (int rep = 0; rep < REP_A; ++rep) { rmsnorm_phase<true>(xo, p.in[5] + l * 1024, XN, p.in[6] + (size_t)l * 1024 * INC, p.in[7] + l * 8, IFB, lds); __syncthreads(); }
        GSYNC(); if (STOP_PHASE == 4) break;
        { pg8::Gemm g{XN, (const bf16_t*)(ws + W_IN), MTOK, NPROJ, 1024, 1024, 1024, 0}; pg8::EpiBf16 e{BIG, BIG, NPROJ, 1000, 1.0f}; pg8::gemm_phase(lds, g, e); }
        if (l == 0) convert_phase(p, 0, lds, 4, 1);
        if (l < 3) convert_phase(p, l + 1, lds, 1, 1);
        GSYNC(); if (STOP_PHASE == 5) break;
        if (gridDim.x == 256) {
            s5_phase<false>(p, l, lds);
            conv_slice(p, l, (int)blockIdx.x >> 2, (int)blockIdx.x & 3);
            asm volatile("s_waitcnt vmcnt(0) lgkmcnt(0)" ::: "memory"); __syncthreads();
            { pg8::Gemm g{XC, (const bf16_t*)(ws + W_QK), MTOK, 2048, 256, 1024, 256, 256, nullptr, nullptr, 0, 1}; pg8::EpiBf16 e{Q, KB, 1024, 4, 0.0625f}; pg8::gemm_phase(lds, g, e); }
            asm volatile("s_waitcnt vmcnt(0) lgkmcnt(0)" ::: "memory"); __syncthreads();
            mlstm_s1_phase<true>(p, lds);
            GSYNC();
            s5_phase<true>(p, l, lds);
            mlstm_s2_phase(p);
            GSYNC();
            __syncthreads();
            { pg8::Gemm g{Z, (const bf16_t*)(ws + W_GLU), MTOK, 1024, 512, 512, 512, 0}; pg8::EpiGated<1> e{YS5, 1024}; pg8::gemm_phase(lds, g, e); }
            mlstm_s3_phase(p, l, lds);
            GSYNC();
        } else {
            conv_phase(p, l);
            s5_phase<false>(p, l, lds);
            GSYNC();
            { pg8::Gemm g{XC, (const bf16_t*)(ws + W_QK), MTOK, 2048, 256, 1024, 256, 256}; pg8::EpiBf16 e{Q, KB, 1024, 4, 0.0625f}; pg8::gemm_phase(lds, g, e); }
            GSYNC();
            mlstm_s1_phase<false>(p, lds);
            s5_phase<true>(p, l, lds);
            GSYNC();
            mlstm_s2_phase(p);
            { pg8::Gemm g{Z, (const bf16_t*)(ws + W_GLU), MTOK, 1024, 512, 512, 512, 0}; pg8::EpiGated<1> e{YS5, 1024}; pg8::gemm_phase(lds, g, e); }
            GSYNC();
            mlstm_s3_phase(p, l, lds);
            GSYNC();
        }
        { pg8::Gemm g{YS5, (const bf16_t*)(ws + W_BS5), MTOK, 1024, 512, 1024, 1024, 0, XN, (const bf16_t*)(ws + W_BML), 1024}; pg8::EpiMergeDual e{BIG + 3584, BIG + 4608, Q}; pg8::gemm_phase(lds, g, e); }
        GSYNC(); if (STOP_PHASE == 11) break;
        { pg8::Gemm g{Q, (const bf16_t*)(ws + W_OUT), MTOK, 1024, 1024, 1024, 1024, 0}; pg8::EpiResid e{xo, xo, 1.0f}; pg8::gemm_phase(lds, g, e); }
        GSYNC(); if (STOP_PHASE == 12) break;
        for (int rep = 0; rep < REP_A; ++rep) rmsnorm_phase<false>(xo, p.in[27] + l * 1024, XN, nullptr, nullptr, nullptr, lds);
        GSYNC(); if (STOP_PHASE == 13) break;
        { pg8::Gemm g{XN, (const bf16_t*)(ws + W_GU2), MTOK, 2 * FF, 1024, 1024, 1024, 0}; pg8::EpiGated<0> e{BIG, FF}; pg8::gemm_phase(lds, g, e); }
        if (l < 3) convert_phase(p, l + 1, lds, 2, 1);
        GSYNC(); if (STOP_PHASE == 14) break;
        { pg8::Gemm g{BIG, (const bf16_t*)(ws + W_D2), MTOK, 1024, FF, FF, FF, 0}; pg8::EpiResid e{xo, xo, 0.5f}; pg8::gemm_phase(lds, g, e); }
        GSYNC(); if (STOP_PHASE == 15) break;
    }
#ifdef DUMP_OFF
    { const int gt = blockIdx.x * 512 + opaque_tid(); const int nthr = gridDim.x * 512;
      for (int i = gt; i < MTOK * DM; i += nthr) { float v;
          if (DUMP_KIND == 5) { v = bflo((unsigned)((const bf16_t*)(ws + O_BIG))[(size_t)(i >> 10) * NPROJ + DUMP_COL + (i & 1023)]); }
          else if (DUMP_KIND == 4) { v = 0.f; if (i < 512) v = ((const float*)(ws + O_G))[i]; else if (i < 1024) v = ((const float*)(ws + O_MLOC))[i - 512]; else if (i < 1024 + 131072) v = ((const float*)(ws + O_NLOC))[i - 1024]; }
          else if (DUMP_KIND == 2 && i < 131072) v = ((const float*)(ws + O_IF))[i];
          else if (DUMP_KIND == 3) v = bflo((unsigned)((const bf16_t*)(ws + (i < 8388608 ? O_Q : O_K)))[i & 8388607]);
          else if (DUMP_KIND == 1) v = ((const float*)(ws + DUMP_OFF))[i]; else v = bflo((unsigned)((const bf16_t*)(ws + DUMP_OFF))[i]);
          xo[i] = (fabsf(v) < 1e30f) ? v : 12345.0f; } }
#else
    final_norm_phase(xo, p.in[31]);
#endif
}

extern "C" void kernel_launch(void* const* d_in, const int* in_sizes, int n_in, void* d_out, int out_size, void* d_ws, size_t ws_size, hipStream_t stream) {
    static int grid_blocks = 0;
    if (grid_blocks == 0) {
        if (n_in != 32 || ws_size < WS_END) { fprintf(stderr, "kernel_launch: unexpected n_in %d or ws_size %zu (< %zu)\n", n_in, ws_size, (size_t)WS_END); grid_blocks = -1; return; }
        int dev = 0, cus = 0, per_cu = 0;
        hipGetDevice(&dev);
        hipDeviceGetAttribute(&cus, hipDeviceAttributeMultiprocessorCount, dev);
        if (hipFuncSetAttribute((const void*)fwd_megakernel, hipFuncAttributeMaxDynamicSharedMemorySize, LDS_BYTES) != hipSuccess) { fprintf(stderr, "kernel_launch: hipFuncSetAttribute failed\n"); grid_blocks = -1; return; }
        hipOccupancyMaxActiveBlocksPerMultiprocessor(&per_cu, (const void*)fwd_megakernel, 512, LDS_BYTES);
        if (per_cu < 1) { fprintf(stderr, "kernel_launch: occupancy query says %d blocks/CU\n", per_cu); per_cu = 1; }
        (void)hipGetLastError();
        grid_blocks = cus;
    }
    if (grid_blocks < 0) return;
    if (hipMemsetAsync((unsigned char*)d_ws + O_BAR, 0, 16384, stream) != hipSuccess) { fprintf(stderr, "kernel_launch: memset of barrier words failed\n"); return; }
    KP p{};
    for (int i = 0; i < 32; ++i) p.in[i] = (const float*)d_in[i];
    p.out = (float*)d_out; p.ws = (unsigned char*)d_ws;
    void* args[] = {&p};
    hipError_t e = hipLaunchCooperativeKernel((const void*)fwd_megakernel, dim3(grid_blocks), dim3(512), args, LDS_BYTES, stream);
    if (e != hipSuccess) fprintf(stderr, "cooperative launch failed: %s (grid %d)\n", hipGetErrorString(e), grid_blocks);
}
```

```cpp
#include <hip/hip_runtime.h>
#include <hip/hip_cooperative_groups.h>
#include <cstdio>
namespace cg = cooperative_groups;

#define LAS __attribute__((address_space(3)))
typedef unsigned short bf16_t;
typedef short bf16x8 __attribute__((ext_vector_type(8)));
typedef short s16x4 __attribute__((ext_vector_type(4)));
typedef float f32x4 __attribute__((ext_vector_type(4)));
typedef float f32x2 __attribute__((ext_vector_type(2)));
typedef unsigned u32x4 __attribute__((ext_vector_type(4)));
typedef unsigned u32x2 __attribute__((ext_vector_type(2)));

constexpr int MTOK = 16384, DM = 1024, FF = 2816, NPROJ = 5632, SEQ = 8192, INC = 5640;
constexpr float EPS = 1e-6f;
constexpr int LDS_BYTES = 147456;
#ifndef STOP_PHASE
#define STOP_PHASE 99
#define REP_A 1
#define REP_G 1
#define REP_B 1
#define REP_C 1
#define REP_D 1
#endif
constexpr int VEC_OFF = 131072;

constexpr size_t W_GU1 = 0;
constexpr size_t W_D1 = W_GU1 + (size_t)5632 * 1024 * 2;
constexpr size_t W_IN = W_D1 + (size_t)1024 * 2816 * 2;
constexpr size_t W_GLU = W_IN + (size_t)5632 * 1024 * 2;
constexpr size_t W_QK = W_GLU + (size_t)1024 * 512 * 2;
constexpr size_t W_BS5 = W_QK + (size_t)2048 * 256 * 2;
constexpr size_t W_BML = W_BS5 + (size_t)1024 * 1024 * 2;
constexpr size_t W_OUT = W_BML + (size_t)1024 * 1024 * 2;
constexpr size_t W_GU2 = W_OUT + (size_t)1024 * 1024 * 2;
constexpr size_t W_D2 = W_GU2 + (size_t)5632 * 1024 * 2;
constexpr size_t W_END = W_D2 + (size_t)1024 * 2816 * 2;
constexpr size_t O_BIG = W_END;
constexpr size_t O_XN = O_BIG + (size_t)MTOK * NPROJ * 2;
constexpr size_t O_XC = O_XN + (size_t)MTOK * 1024 * 2;
constexpr size_t O_Q = O_XC + (size_t)MTOK * 1024 * 2;
constexpr size_t O_K = O_Q + (size_t)MTOK * 1024 * 2;
constexpr size_t O_Z = O_K + (size_t)MTOK * 1024 * 2;
constexpr size_t O_YS5 = O_Z + (size_t)MTOK * 512 * 2;
constexpr size_t O_CST = O_YS5 + (size_t)MTOK * 1024 * 2;
constexpr size_t O_IF = O_CST + (size_t)512 * 65536 * 2;
constexpr size_t O_S5END = O_IF + (size_t)MTOK * 8 * 4;
constexpr size_t O_G = O_S5END + (size_t)64 * 64 * 64 * 8;
constexpr size_t O_MLOC = O_G + 2048;
constexpr size_t O_MST = O_MLOC + 2048;
constexpr size_t O_NLOC = O_MST + 2048;
constexpr size_t O_NST = O_NLOC + (size_t)512 * 256 * 4;
constexpr size_t O_BAR = O_NST + (size_t)512 * 256 * 4;
constexpr size_t WS_END = O_BAR + 16384;

struct KP { const float* in[32]; float* out; unsigned char* ws; };

typedef __bf16 bf16v2_t __attribute__((ext_vector_type(2)));
__device__ __forceinline__ unsigned cvt_pk_bf16(float lo, float hi) { const f32x2 v = {lo, hi}; const bf16v2_t b = __builtin_convertvector(v, bf16v2_t); return __builtin_bit_cast(unsigned, b); }
__device__ __forceinline__ float bflo(unsigned u) { return __uint_as_float(u << 16); }
__device__ __forceinline__ float bfhi(unsigned u) { return __uint_as_float(u & 0xffff0000u); }
__device__ __forceinline__ float sigmoidf_(float x) { return __builtin_amdgcn_rcpf(1.0f + __expf(-x)); }
__device__ __forceinline__ float siluf_(float x) { return x * __builtin_amdgcn_rcpf(1.0f + __expf(-x)); }
__device__ __forceinline__ float gelu_tanh(float y) { const float v = 0.7978845608028654f * (y + 0.044715f * y * y * y); const float th = 1.0f - 2.0f * __builtin_amdgcn_rcpf(1.0f + __expf(2.0f * v)); return 0.5f * y * (1.0f + th); }
__device__ __forceinline__ float logsigmoidf_(float x) { return fminf(x, 0.f) - log1pf(__expf(-fabsf(x))); }
__device__ __forceinline__ float wave_sum(float v) {
#pragma unroll
    for (int o = 1; o < 64; o <<= 1) v += __shfl_xor(v, o);
    return v;
}
__device__ __forceinline__ int opaque_tid() { int t = threadIdx.x; asm volatile("" : "+v"(t)); return t; }
#define WAVE_LDS_SYNC() asm volatile("s_waitcnt lgkmcnt(0)" ::: "memory")
__device__ __forceinline__ void sincos_acc(float x, float& s, float& c) {
    const float k = rintf(x * 0.63661977236758134f);
    float r = fmaf(-k, 1.5703125f, x); r = fmaf(-k, 4.837512969970703125e-4f, r); r = fmaf(-k, 7.54978995489188216e-8f, r);
    const float r2 = r * r;
    const float sp = r + r * r2 * (-1.6666654611e-1f + r2 * (8.3321608736e-3f + r2 * (-1.9515295891e-4f)));
    const float cp = 1.0f - 0.5f * r2 + r2 * r2 * (4.166664568298827e-2f + r2 * (-1.388731625493765e-3f + r2 * 2.443315711809948e-5f));
    const int q = ((int)k) & 3;
    s = (q == 0) ? sp : (q == 1) ? cp : (q == 2) ? -sp : -cp;
    c = (q == 0) ? cp : (q == 1) ? -sp : (q == 2) ? -cp : sp;
}

namespace pg8 {
constexpr int BM = 256, BK = 64, HALF = 128, HTB = HALF * BK * 2, STAGE_BYTES = 8 * HTB, NXCD = 8, WGM = 8;
__host__ __device__ __forceinline__ int lds_byte(int r, int c) { const int st = (r >> 4) * 2 + (c >> 5), rr = r & 15, cc = c & 31, ob = rr * 64 + cc * 2; return st * 1024 + (ob ^ (((ob >> 9) & 1) << 5)); }
__host__ __device__ __forceinline__ void stage_rc(int b, int& R, int& C) { const int st = b / 1024, sb = b % 1024, swz = sb ^ (((sb >> 9) & 1) << 5); R = (st >> 1) * 16 + swz / 64; C = (st & 1) * 32 + (swz % 64) / 2; }
__host__ __device__ __forceinline__ int perm32(int rho) { const int n = rho >> 4, i = rho & 15; return 8 * (i >> 2) + 4 * n + (i & 3); }
struct Unit { int pm, pn; };
struct Gemm { const bf16_t* A; const bf16_t* Bt; int M, N, K, lda, ldb, ahead; const bf16_t* A2; const bf16_t* Bt2; int K2; int pairmode; };
struct StaticOrder {
    int nM, nN, nwg, G, c;
    __device__ void init(int M, int N, int G_, int c_) { nM = M / BM; nN = N / BM; nwg = nM * nN; G = G_; c = c_; }
    __device__ bool next(int i, Unit& u) const {
        const long L = (long)i * G + c; if (L >= nwg) return false;
        int wgid = (int)L; { const int q = nwg / NXCD, r = nwg % NXCD, xcd = wgid % NXCD, off = wgid / NXCD; wgid = (xcd < r ? xcd * (q + 1) : r * (q + 1) + (xcd - r) * q) + off; }
        const int nig = WGM * nN, gid = wgid / nig, fm = gid * WGM, gsz = (nM - fm) < WGM ? (nM - fm) : WGM;
        u.pm = fm + ((wgid % nig) % gsz); u.pn = (wgid % nig) / gsz; return true;
    }
};

template <class Epi>
__device__ __forceinline__ void gemm_phase(LAS unsigned char* lds, const Gemm g, const Epi& E) {
    StaticOrder S; S.init(g.M, g.N, (int)gridDim.x, (int)blockIdx.x);
    const int tid = opaque_tid(), wid = __builtin_amdgcn_readfirstlane(tid >> 6), lane = tid & 63, wr = wid >> 2, wc = wid & 3, fr = lane & 15, fq = lane >> 4;
    const int K = g.K; int nt = K / BK; int seg = 0;
    unsigned voffA[2], voffB[2];
#pragma unroll
    for (int i = 0; i < 2; ++i) { int R, C; stage_rc(tid * 16 + i * 8192, R, C); const int Rb = Epi::PERM ? ((R & ~31) + perm32(R & 31)) : R;
        voffA[i] = (unsigned)(R * g.lda + C) * 2u; voffB[i] = (unsigned)(Rb * g.ldb + C) * 2u; }
    const size_t kstep = (size_t)(BK * 2);
    const size_t hstepA = (size_t)HALF * g.lda * 2, hstepB = (size_t)HALF * g.ldb * 2;
    const size_t tstepA = 2 * hstepA, tstepB = 2 * hstepB;
    const unsigned ldsw = (unsigned)wid * 1024u;
    const int aoff = lds_byte(wr * 64 + fr, fq * 8), boff = lds_byte(wc * 32 + fr, fq * 8);
#define PG8_SA(b, h) (((b) * 2 + (h)) * HTB)
#define PG8_SB(b, h) ((4 + (b) * 2 + (h)) * HTB)
#define PG8_STAGE(bufoff, gbase, voff) do { _Pragma("unroll") for (int _i = 0; _i < 2; ++_i) \
        __builtin_amdgcn_global_load_lds((const unsigned*)((const char*)(gbase) + (voff)[_i]), (LAS unsigned*)(lds + (bufoff) + ldsw + _i * 8192), 16, 0, 0); } while (0)
#define PG8_LDA(dst, b, h) do { _Pragma("unroll") for (int m = 0; m < 4; ++m) _Pragma("unroll") for (int k = 0; k < 2; ++k) dst[m][k] = *(const LAS bf16x8*)(lds + PG8_SA(b, h) + aoff + m * 2048 + k * 1024); } while (0)
#define PG8_LDB(dst, b, h) do { _Pragma("unroll") for (int n = 0; n < 2; ++n) _Pragma("unroll") for (int k = 0; k < 2; ++k) dst[n][k] = *(const LAS bf16x8*)(lds + PG8_SB(b, h) + boff + n * 2048 + k * 1024); } while (0)
#define PG8_MMA(ai, bj, At, Bt) do { __builtin_amdgcn_s_setprio(1); _Pragma("unroll") for (int m = 0; m < 4; ++m) _Pragma("unroll") for (int n = 0; n < 2; ++n) _Pragma("unroll") for (int k = 0; k < 2; ++k) \
        acc[ai][bj][m][n] = __builtin_amdgcn_mfma_f32_16x16x32_bf16(Bt[n][k], At[m][k], acc[ai][bj][m][n], 0, 0, 0); __builtin_amdgcn_s_setprio(0); } while (0)
#define PG8_WAIT_V(n) asm volatile("s_waitcnt vmcnt(" #n ")" ::: "memory")
#define PG8_WAIT_L(n) asm volatile("s_waitcnt lgkmcnt(" #n ")" ::: "memory")
#define PG8_BAR __builtin_amdgcn_s_barrier()
#define PG8_SCHED __builtin_amdgcn_sched_barrier(0)
    auto nextu = [&](int i, Unit& u) -> bool { if (g.pairmode) { if (i >= 2) return false; u.pm = (int)blockIdx.x >> 2; u.pn = ((int)blockIdx.x & 3) + 4 * i; return true; } return S.next(i, u); };
    Unit cur, nxt; int ui = 0;
    if (!nextu(0, cur)) return;
    f32x4 acc[2][2][4][2];
#pragma unroll
    for (int a = 0; a < 2; ++a)
#pragma unroll
        for (int b = 0; b < 2; ++b)
#pragma unroll
            for (int m = 0; m < 4; ++m)
#pragma unroll
                for (int n = 0; n < 2; ++n) acc[a][b][m][n] = (f32x4){0.f, 0.f, 0.f, 0.f};
    bf16x8 At[4][2], B0[2][2], B1[2][2];
    const char* cA = (const char*)g.A + (size_t)cur.pm * tstepA + (size_t)((cur.pn & 3) * g.ahead) * 2; const char* cB = (const char*)g.Bt + (size_t)cur.pn * tstepB;
    PG8_STAGE(PG8_SB(0, 0), cB, voffB); PG8_STAGE(PG8_SA(0, 0), cA, voffA); PG8_STAGE(PG8_SB(0, 1), cB + hstepB, voffB); PG8_STAGE(PG8_SA(0, 1), cA + hstepA, voffA);
    if (wr == 1) PG8_BAR;
    PG8_WAIT_V(4); PG8_BAR;
    PG8_STAGE(PG8_SB(1, 0), cB + kstep, voffB); PG8_STAGE(PG8_SA(1, 0), cA + kstep, voffA); PG8_STAGE(PG8_SB(1, 1), cB + hstepB + kstep, voffB);
    PG8_WAIT_V(6); PG8_BAR;
    for (;;) {
        bool has_next; const char* nA; const char* nB;
        if (Epi::DUAL && seg == 0) { has_next = true; nxt = cur; nA = (const char*)g.A2 + (size_t)cur.pm * tstepA; nB = (const char*)g.Bt2 + (size_t)cur.pn * tstepB; }
        else { has_next = nextu(ui + 1, nxt);
            nA = has_next ? (const char*)g.A + (size_t)nxt.pm * tstepA + (size_t)((nxt.pn & 3) * g.ahead) * 2 : cA; nB = has_next ? (const char*)g.Bt + (size_t)nxt.pn * tstepB : cB; }
        for (int t = 0; t < nt; t += 2) {
            const bool last = (t == nt - 2);
            const char* a1 = cA + (size_t)(t + 1) * kstep;
            const char* a2 = last ? nA : cA + (size_t)(t + 2) * kstep; const char* b2 = last ? nB : cB + (size_t)(t + 2) * kstep;
            const char* a3 = a2 + kstep; const char* b3 = b2 + kstep;
            PG8_LDB(B0, 0, 0); PG8_SCHED; PG8_LDA(At, 0, 0); PG8_STAGE(PG8_SA(1, 1), a1 + hstepA, voffA);
            PG8_WAIT_L(8); PG8_BAR; PG8_WAIT_L(0); PG8_MMA(0, 0, At, B0); PG8_BAR; PG8_SCHED;
            PG8_LDB(B1, 0, 1); PG8_STAGE(PG8_SB(0, 0), b2, voffB);
            PG8_BAR; PG8_WAIT_L(0); PG8_MMA(0, 1, At, B1); PG8_BAR;
            PG8_LDA(At, 0, 1); PG8_STAGE(PG8_SA(0, 0), a2, voffA);
            PG8_BAR; PG8_WAIT_L(0); PG8_MMA(1, 0, At, B0); PG8_BAR; PG8_SCHED;
            PG8_STAGE(PG8_SB(0, 1), b2 + hstepB, voffB);
            PG8_WAIT_V(6); PG8_BAR; PG8_MMA(1, 1, At, B1); PG8_BAR;
            PG8_LDB(B0, 1, 0); PG8_SCHED; PG8_LDA(At, 1, 0); PG8_STAGE(PG8_SA(0, 1), a2 + hstepA, voffA);
            PG8_WAIT_L(8); PG8_BAR; PG8_WAIT_L(0); PG8_MMA(0, 0, At, B0); PG8_BAR; PG8_SCHED;
            PG8_LDB(B1, 1, 1); PG8_STAGE(PG8_SB(1, 0), b3, voffB);
            PG8_BAR; PG8_WAIT_L(0); PG8_MMA(0, 1, At, B1); PG8_BAR;
            PG8_LDA(At, 1, 1); PG8_STAGE(PG8_SA(1, 0), a3, voffA);
            PG8_BAR; PG8_WAIT_L(0); PG8_MMA(1, 0, At, B0); PG8_BAR; PG8_SCHED;
            PG8_STAGE(PG8_SB(1, 1), b3 + hstepB, voffB);
            PG8_WAIT_V(6); PG8_BAR; PG8_MMA(1, 1, At, B1); PG8_BAR;
        }
        if constexpr (Epi::DUAL) { if (seg == 0) { E.mid(acc, cur, wr, wc, fr, fq); seg = 1; cA = nA; cB = nB; nt = g.K2 / BK; continue; } }
        E(acc, cur, wr, wc, fr, fq);
        if (Epi::DUAL) { seg = 0; nt = K / BK; }
        if (!has_next) break;
#pragma unroll
        for (int a = 0; a < 2; ++a)
#pragma unroll
            for (int b = 0; b < 2; ++b)
#pragma unroll
                for (int m = 0; m < 4; ++m)
#pragma unroll
                    for (int n = 0; n < 2; ++n) acc[a][b][m][n] = (f32x4){0.f, 0.f, 0.f, 0.f};
        cur = nxt; cA = nA; cB = nB; ++ui;
    }
    PG8_WAIT_V(0);
    if (wr == 0) PG8_BAR;
    PG8_BAR;
#undef PG8_SA
#undef PG8_SB
#undef PG8_STAGE
#undef PG8_LDA
#undef PG8_LDB
#undef PG8_MMA
#undef PG8_WAIT_V
#undef PG8_WAIT_L
#undef PG8_BAR
#undef PG8_SCHED
}

template <int ACT> struct EpiGated {
    static constexpr bool DUAL = false;
    static constexpr bool PERM = true;
    bf16_t* O; int ldo;
    __device__ __forceinline__ void operator()(const f32x4 (&acc)[2][2][4][2], const Unit& u, int wr, int wc, int fr, int fq) const {
        const int row0 = u.pm * BM + wr * 64 + fr, col0 = u.pn * 128 + wc * 32 + 8 * fq;
#pragma unroll
        for (int ai = 0; ai < 2; ++ai)
#pragma unroll
            for (int m = 0; m < 4; ++m) {
                bf16_t* rowp = O + (size_t)(row0 + ai * HALF + m * 16) * ldo + col0;
                float r[8];
#pragma unroll
                for (int n = 0; n < 2; ++n)
#pragma unroll
                    for (int j = 0; j < 4; ++j) { const float a0 = acc[ai][0][m][n][j], a1 = acc[ai][1][m][n][j]; r[n * 4 + j] = ACT == 0 ? siluf_(a0) * a1 : a0 * sigmoidf_(a1); }
                u32x4 o; o.x = cvt_pk_bf16(r[0], r[1]); o.y = cvt_pk_bf16(r[2], r[3]); o.z = cvt_pk_bf16(r[4], r[5]); o.w = cvt_pk_bf16(r[6], r[7]);
                *(u32x4*)rowp = o;
            }
    }
};
struct EpiResid {
    static constexpr bool DUAL = false;
    static constexpr bool PERM = false;
    const float* xin; float* xout; float scale;
    __device__ __forceinline__ void operator()(const f32x4 (&acc)[2][2][4][2], const Unit& u, int wr, int wc, int fr, int fq) const {
        const int row0 = u.pm * BM + wr * 64 + fr, col0 = u.pn * BM + wc * 32 + 4 * fq;
#pragma unroll
        for (int ai = 0; ai < 2; ++ai) {
            f32x4 xv[4][2][2];
#pragma unroll
            for (int m = 0; m < 4; ++m) { const size_t ro = (size_t)(row0 + ai * HALF + m * 16) * DM + col0;
#pragma unroll
                for (int bj = 0; bj < 2; ++bj)
#pragma unroll
                    for (int n = 0; n < 2; ++n) xv[m][bj][n] = *(const f32x4*)(xin + ro + bj * HALF + n * 16); }
            asm volatile("" ::: "memory");
#pragma unroll
            for (int m = 0; m < 4; ++m) { const size_t ro = (size_t)(row0 + ai * HALF + m * 16) * DM + col0;
#pragma unroll
                for (int bj = 0; bj < 2; ++bj)
#pragma unroll
                    for (int n = 0; n < 2; ++n) *(f32x4*)(xout + ro + bj * HALF + n * 16) = xv[m][bj][n] + scale * acc[ai][bj][m][n]; }
            asm volatile("" ::: "memory");
        }
    }
};
struct EpiBf16 {
    static constexpr bool DUAL = false;
    static constexpr bool PERM = true;
    bf16_t* O; bf16_t* O2; int ldo, split; float scale1;
    __device__ __forceinline__ void operator()(const f32x4 (&acc)[2][2][4][2], const Unit& u, int wr, int wc, int fr, int fq) const {
        const int row0 = u.pm * BM + wr * 64 + fr; int pn = u.pn; bf16_t* base = O; float sc = scale1;
        if (pn >= split) { pn -= split; base = O2; sc = 1.0f; }
        const int col0 = pn * BM + wc * 32 + 8 * fq;
#pragma unroll
        for (int ai = 0; ai < 2; ++ai)
#pragma unroll
            for (int m = 0; m < 4; ++m) { bf16_t* rowp = base + (size_t)(row0 + ai * HALF + m * 16) * ldo + col0;
#pragma unroll
                for (int bj = 0; bj < 2; ++bj) { const f32x4 v0 = acc[ai][bj][m][0] * sc, v1 = acc[ai][bj][m][1] * sc;
                    u32x4 o; o.x = cvt_pk_bf16(v0[0], v0[1]); o.y = cvt_pk_bf16(v0[2], v0[3]); o.z = cvt_pk_bf16(v1[0], v1[1]); o.w = cvt_pk_bf16(v1[2], v1[3]);
                    *(u32x4*)(rowp + bj * HALF) = o; } }
    }
};
template <int SECOND> struct EpiMerge {
    static constexpr bool DUAL = false;
    static constexpr bool PERM = true;
    const bf16_t* gate; float* mixacc; bf16_t* mix;
    __device__ __forceinline__ void operator()(const f32x4 (&acc)[2][2][4][2], const Unit& u, int wr, int wc, int fr, int fq) const {
        const int row0 = u.pm * BM + wr * 64 + fr, col0 = u.pn * BM + wc * 32 + 8 * fq;
#pragma unroll
        for (int ai = 0; ai < 2; ++ai)
#pragma unroll
            for (int mp = 0; mp < 2; ++mp) {
                u32x4 gv[2][2]; f32x4 pv[2][2][2];
#pragma unroll
                for (int mi = 0; mi < 2; ++mi)
#pragma unroll
                    for (int bj = 0; bj < 2; ++bj) { const size_t row = (size_t)(row0 + ai * HALF + (mp * 2 + mi) * 16); const int col = col0 + bj * HALF;
                        gv[mi][bj] = *(const u32x4*)(gate + row * NPROJ + col);
                        if (SECOND == 1) { pv[mi][bj][0] = *(const f32x4*)(mixacc + row * DM + col); pv[mi][bj][1] = *(const f32x4*)(mixacc + row * DM + col + 4); } }
                asm volatile("" ::: "memory");
#pragma unroll
                for (int mi = 0; mi < 2; ++mi)
#pragma unroll
                    for (int bj = 0; bj < 2; ++bj) { const int m = mp * 2 + mi; const size_t row = (size_t)(row0 + ai * HALF + m * 16); const int col = col0 + bj * HALF; const u32x4 g4 = gv[mi][bj];
                        float r[8];
                        r[0] = sigmoidf_(bflo(g4.x)) * acc[ai][bj][m][0][0]; r[1] = sigmoidf_(bfhi(g4.x)) * acc[ai][bj][m][0][1];
                        r[2] = sigmoidf_(bflo(g4.y)) * acc[ai][bj][m][0][2]; r[3] = sigmoidf_(bfhi(g4.y)) * acc[ai][bj][m][0][3];
                        r[4] = sigmoidf_(bflo(g4.z)) * acc[ai][bj][m][1][0]; r[5] = sigmoidf_(bfhi(g4.z)) * acc[ai][bj][m][1][1];
                        r[6] = sigmoidf_(bflo(g4.w)) * acc[ai][bj][m][1][2]; r[7] = sigmoidf_(bfhi(g4.w)) * acc[ai][bj][m][1][3];
                        if (SECOND == 0) { float* mp_ = mixacc + row * DM + col; *(f32x4*)mp_ = (f32x4){r[0], r[1], r[2], r[3]}; *(f32x4*)(mp_ + 4) = (f32x4){r[4], r[5], r[6], r[7]}; }
                        else { const f32x4 p0 = pv[mi][bj][0], p1 = pv[mi][bj][1];
                            u32x4 o; o.x = cvt_pk_bf16(r[0] + p0[0], r[1] + p0[1]); o.y = cvt_pk_bf16(r[2] + p0[2], r[3] + p0[3]); o.z = cvt_pk_bf16(r[4] + p1[0], r[5] + p1[1]); o.w = cvt_pk_bf16(r[6] + p1[2], r[7] + p1[3]);
                            *(u32x4*)(mix + row * DM + col) = o; } }
                asm volatile("" ::: "memory");
            }
    }
};
struct EpiMergeDual {
    static constexpr bool PERM = true, DUAL = true;
    const bf16_t* gate1; const bf16_t* gate2; bf16_t* mix;
    static __device__ __forceinline__ float em(float g) { return fminf(__expf(-g), 1e30f); }
    __device__ __forceinline__ void mid(f32x4 (&acc)[2][2][4][2], const Unit& u, int wr, int wc, int fr, int fq) const {
        const int row0 = u.pm * BM + wr * 64 + fr, col0 = u.pn * BM + wc * 32 + 8 * fq;
#pragma unroll
        for (int ai = 0; ai < 2; ++ai)
#pragma unroll
            for (int mp = 0; mp < 2; ++mp) {
                u32x4 g1v[2][2], g2v[2][2];
#pragma unroll
                for (int mi = 0; mi < 2; ++mi)
#pragma unroll
                    for (int bj = 0; bj < 2; ++bj) { const size_t row = (size_t)(row0 + ai * HALF + (mp * 2 + mi) * 16); const int col = col0 + bj * HALF;
                        g1v[mi][bj] = *(const u32x4*)(gate1 + row * NPROJ + col); g2v[mi][bj] = *(const u32x4*)(gate2 + row * NPROJ + col); }
#pragma unroll
                for (int mi = 0; mi < 2; ++mi)
#pragma unroll
                    for (int bj = 0; bj < 2; ++bj) { const int m = mp * 2 + mi; const u32x4 a = g1v[mi][bj], b = g2v[mi][bj];
                        const float ga[8] = {bflo(a.x), bfhi(a.x), bflo(a.y), bfhi(a.y), bflo(a.z), bfhi(a.z), bflo(a.w), bfhi(a.w)};
                        const float gb[8] = {bflo(b.x), bfhi(b.x), bflo(b.y), bfhi(b.y), bflo(b.z), bfhi(b.z), bflo(b.w), bfhi(b.w)};
#pragma unroll
                        for (int j = 0; j < 8; ++j) acc[ai][bj][m][j >> 2][j & 3] *= (1.0f + em(gb[j])) * __builtin_amdgcn_rcpf(1.0f + em(ga[j])); }
            }
    }
    __device__ __forceinline__ void operator()(const f32x4 (&acc)[2][2][4][2], const Unit& u, int wr, int wc, int fr, int fq) const {
        const int row0 = u.pm * BM + wr * 64 + fr, col0 = u.pn * BM + wc * 32 + 8 * fq;
#pragma unroll
        for (int ai = 0; ai < 2; ++ai)
#pragma unroll
            for (int mp = 0; mp < 2; ++mp) {
                u32x4 g2v[2][2];
#pragma unroll
                for (int mi = 0; mi < 2; ++mi)
#pragma unroll
                    for (int bj = 0; bj < 2; ++bj) { const size_t row = (size_t)(row0 + ai * HALF + (mp * 2 + mi) * 16); const int col = col0 + bj * HALF;
                        g2v[mi][bj] = *(const u32x4*)(gate2 + row * NPROJ + col); }
#pragma unroll
                for (int mi = 0; mi < 2; ++mi)
#pragma unroll
                    for (int bj = 0; bj < 2; ++bj) { const int m = mp * 2 + mi; const size_t row = (size_t)(row0 + ai * HALF + m * 16); const int col = col0 + bj * HALF; const u32x4 b = g2v[mi][bj];
                        const float gb[8] = {bflo(b.x), bfhi(b.x), bflo(b.y), bfhi(b.y), bflo(b.z), bfhi(b.z), bflo(b.w), bfhi(b.w)};
                        float r[8];
#pragma unroll
                        for (int j = 0; j < 8; ++j) r[j] = acc[ai][bj][m][j >> 2][j & 3] * __builtin_amdgcn_rcpf(1.0f + em(gb[j]));
                        u32x4 o; o.x = cvt_pk_bf16(r[0], r[1]); o.y = cvt_pk_bf16(r[2], r[3]); o.z = cvt_pk_bf16(r[4], r[5]); o.w = cvt_pk_bf16(r[6], r[7]);
                        *(u32x4*)(mix + row * DM + col) = o; }
            }
    }
};
}

__device__ __forceinline__ void tr_job(const float* W, int K, int ld, int c0, int NC, bf16_t* WT, int rowbase, int rs, LAS float* scr, int gw, int nw, int lane, int ldw = 0) {
    if (ldw == 0) ldw = K;
    const int nblk = NC / 32, nitems = (K / 64) * nblk;
    for (int item = gw; item < nitems; item += nw) {
        const int kb = item / nblk, nb = item % nblk, k0 = 64 * kb, n0 = 32 * nb;
        float wv[32];
#pragma unroll
        for (int i = 0; i < 32; ++i) { const int kk = 2 * i + (lane >> 5); wv[i] = W[(size_t)(k0 + kk) * ld + c0 + n0 + (lane & 31)]; }
#pragma unroll
        for (int i = 0; i < 32; ++i) { const int kk = 2 * i + (lane >> 5); scr[kk * 33 + (lane & 31)] = wv[i]; }
        WAVE_LDS_SYNC();
        const int c = lane & 7;
#pragma unroll
        for (int j = 0; j < 4; ++j) { const int n = (lane >> 3) + 8 * j; const LAS float* s = scr + (8 * c) * 33 + n;
            u32x4 o; o.x = cvt_pk_bf16(s[0 * 33], s[1 * 33]); o.y = cvt_pk_bf16(s[2 * 33], s[3 * 33]); o.z = cvt_pk_bf16(s[4 * 33], s[5 * 33]); o.w = cvt_pk_bf16(s[6 * 33], s[7 * 33]);
            const int nn = n0 + n, drow = rowbase + (nn >> 7) * rs + (nn & 127);
            *(u32x4*)(WT + (size_t)drow * ldw + k0 + 8 * c) = o; }
        WAVE_LDS_SYNC();
    }
}
__device__ __forceinline__ void convert_phase(const KP& p, int l, LAS unsigned char* lds, int mask, int part) {
    const int tid = opaque_tid(); const int wid = tid >> 6, lane = tid & 63;
    if (part && (int)blockIdx.x < 128) return;
    const int nw = part ? ((int)gridDim.x - 128) * 8 : (int)gridDim.x * 8;
    int gw = (part ? (int)blockIdx.x - 128 : (int)blockIdx.x) * 8 + wid;
    if (nw <= 0) return;
    LAS float* scr = (LAS float*)(lds + wid * 8448);
    unsigned char* ws = p.ws;
    const size_t ffw = (size_t)l * 1024 * 2816;
    bf16_t* gu1 = (bf16_t*)(ws + W_GU1); bf16_t* d1 = (bf16_t*)(ws + W_D1);
#define ROT(n) gw = (gw + (n)) % nw
    if (mask & 1) {
        tr_job(p.in[2] + ffw, 1024, 2816, 0, 2816, gu1, 0, 256, scr, gw, nw, lane);
        tr_job(p.in[3] + ffw, 1024, 2816, 0, 2816, gu1, 128, 256, scr, gw, nw, lane);
        tr_job(p.in[4] + ffw, 2816, 1024, 0, 1024, d1, 0, 128, scr, gw, nw, lane);
    }
    if (mask & 4) {
        tr_job(p.in[28] + ffw, 1024, 2816, 0, 2816, (bf16_t*)(ws + W_GU2), 0, 256, scr, gw, nw, lane);
        tr_job(p.in[29] + ffw, 1024, 2816, 0, 2816, (bf16_t*)(ws + W_GU2), 128, 256, scr, gw, nw, lane);
        tr_job(p.in[30] + ffw, 2816, 1024, 0, 1024, (bf16_t*)(ws + W_D2), 0, 128, scr, gw, nw, lane);
    }
    if (mask & 2) {
        tr_job(p.in[6] + (size_t)l * 1024 * INC, 1024, INC, 0, 3584, (bf16_t*)(ws + W_IN), 0, 128, scr, gw, nw, lane);
        tr_job(p.in[6] + (size_t)l * 1024 * INC, 1024, INC, 3592, 2048, (bf16_t*)(ws + W_IN), 3584, 128, scr, gw, nw, lane);
        ROT(768);
        tr_job(p.in[16] + (size_t)l * 512 * 512, 512, 512, 0, 512, (bf16_t*)(ws + W_GLU), 0, 256, scr, gw, nw, lane);
        ROT(128);
        tr_job(p.in[17] + (size_t)l * 512 * 512, 512, 512, 0, 512, (bf16_t*)(ws + W_GLU), 128, 256, scr, gw, nw, lane);
        ROT(128);
        tr_job(p.in[24] + (size_t)l * 512 * 1024, 512, 1024, 0, 1024, (bf16_t*)(ws + W_BS5), 0, 128, scr, gw, nw, lane, 1024);
        ROT(256);
        tr_job(p.in[25] + (size_t)l * 1024 * 1024, 1024, 1024, 0, 1024, (bf16_t*)(ws + W_BML), 0, 128, scr, gw, nw, lane);
        ROT(512);
        tr_job(p.in[26] + (size_t)l * 1024 * 1024, 1024, 1024, 0, 1024, (bf16_t*)(ws + W_OUT), 0, 128, scr, gw, nw, lane);
        ROT(512);
        for (int h = 0; h < 4; ++h) {
            tr_job(p.in[20] + ((size_t)l * 4 + h) * 65536, 256, 256, 0, 256, (bf16_t*)(ws + W_QK), h * 256, 128, scr, gw, nw, lane);
            ROT(32);
            tr_job(p.in[21] + ((size_t)l * 4 + h) * 65536, 256, 256, 0, 256, (bf16_t*)(ws + W_QK), 1024 + h * 256, 128, scr, gw, nw, lane);
            ROT(32);
        }
    }
#undef ROT
}

template <bool WITH_IF>
__device__ __forceinline__ void rmsnorm_phase(const float* x, const float* gain, bf16_t* xn, const float* win_l, const float* bif, float* ifbuf, LAS unsigned char* lds) {
    const int tid = opaque_tid(); const int wid = tid >> 6, lane = tid & 63;
    LAS float* ifw = (LAS float*)lds;
    if (WITH_IF) {
        for (int k = tid; k < 1024; k += 512) { const f32x4 a = *(const f32x4*)(win_l + (size_t)k * INC + 3584), b = *(const f32x4*)(win_l + (size_t)k * INC + 3588);
            *(LAS f32x4*)(ifw + k * 8) = a; *(LAS f32x4*)(ifw + k * 8 + 4) = b; }
        __syncthreads();
    }
    f32x4 gv[4];
#pragma unroll
    for (int i = 0; i < 4; ++i) gv[i] = *(const f32x4*)(gain + 4 * (lane + 64 * i));
    const int nw = gridDim.x * 8;
    constexpr int RPT = WITH_IF ? 4 : 8;
    for (int row0 = blockIdx.x * 8 + wid; row0 < MTOK; row0 += RPT * nw) {
        f32x4 v[RPT][4];
#pragma unroll
        for (int q = 0; q < RPT; ++q) { const int row = (row0 + q * nw < MTOK) ? row0 + q * nw : row0;
#pragma unroll
            for (int i = 0; i < 4; ++i) v[q][i] = *(const f32x4*)(x + (size_t)row * DM + 4 * (lane + 64 * i)); }
        asm volatile("" ::: "memory");
#pragma unroll
        for (int q = 0; q < RPT; ++q) { const int row = row0 + q * nw;
            float ss = 0.f;
#pragma unroll
            for (int i = 0; i < 4; ++i) ss += (v[q][i].x * v[q][i].x + v[q][i].y * v[q][i].y) + (v[q][i].z * v[q][i].z + v[q][i].w * v[q][i].w);
            ss = wave_sum(ss);
            const float r = rsqrtf(ss * (1.0f / DM) + EPS);
            float ga[8];
            if (WITH_IF) {
#pragma unroll
                for (int j = 0; j < 8; ++j) ga[j] = 0.f;
            }
            if (row < MTOK) {
#pragma unroll
                for (int i = 0; i < 4; ++i) { const f32x4 y = v[q][i] * r * gv[i];
                    u32x2 o; o.x = cvt_pk_bf16(y.x, y.y); o.y = cvt_pk_bf16(y.z, y.w);
                    *(u32x2*)(xn + (size_t)row * DM + 4 * (lane + 64 * i)) = o;
                    if (WITH_IF) {
#pragma unroll
                        for (int e = 0; e < 4; ++e) { const int k = 4 * (lane + 64 * i) + e; const f32x4 a = *(LAS f32x4*)(ifw + k * 8), b = *(LAS f32x4*)(ifw + k * 8 + 4); const float xv = y[e];
                            ga[0] += xv * a.x; ga[1] += xv * a.y; ga[2] += xv * a.z; ga[3] += xv * a.w; ga[4] += xv * b.x; ga[5] += xv * b.y; ga[6] += xv * b.z; ga[7] += xv * b.w; }
                        asm volatile("" ::: "memory");
                    }
                }
                if (WITH_IF) {
#pragma unroll
                    for (int j = 0; j < 8; ++j) ga[j] = wave_sum(ga[j]);
                    if (lane == 0) { *(f32x4*)(ifbuf + (size_t)row * 8) = (f32x4){ga[0] + bif[0], ga[1] + bif[1], ga[2] + bif[2], ga[3] + bif[3]};
                        *(f32x4*)(ifbuf + (size_t)row * 8 + 4) = (f32x4){ga[4] + bif[4], ga[5] + bif[5], ga[6] + bif[6], ga[7] + bif[7]}; }
                }
            }
        }
    }
}
__device__ __forceinline__ void final_norm_phase(float* x, const float* gain) {
    const int tid = opaque_tid(); const int wid = tid >> 6, lane = tid & 63;
    f32x4 gv[4];
#pragma unroll
    for (int i = 0; i < 4; ++i) gv[i] = *(const f32x4*)(gain + 4 * (lane + 64 * i));
    for (int row = blockIdx.x * 8 + wid; row < MTOK; row += gridDim.x * 8) {
        float* xr = x + (size_t)row * DM;
        f32x4 v[4]; float ss = 0.f;
#pragma unroll
        for (int i = 0; i < 4; ++i) { v[i] = *(const f32x4*)(xr + 4 * (lane + 64 * i)); ss += (v[i].x * v[i].x + v[i].y * v[i].y) + (v[i].z * v[i].z + v[i].w * v[i].w); }
        ss = wave_sum(ss);
        const float r = rsqrtf(ss * (1.0f / DM) + EPS);
#pragma unroll
        for (int i = 0; i < 4; ++i) *(f32x4*)(xr + 4 * (lane + 64 * i)) = v[i] * r * gv[i];
    }
}

__device__ __forceinline__ void conv_phase(const KP& p, int l) {
    const bf16_t* proj = (const bf16_t*)(p.ws + O_BIG); bf16_t* xc = (bf16_t*)(p.ws + O_XC);
    const int gt = blockIdx.x * 512 + opaque_tid(), c8 = gt & 127;
    const float* cw = p.in[18] + (size_t)l * 4 * 1024 + c8 * 8; const float* cb = p.in[19] + (size_t)l * 1024 + c8 * 8;
    float w[4][8], bias[8];
#pragma unroll
    for (int j = 0; j < 4; ++j) { const f32x4 a = *(const f32x4*)(cw + j * 1024), b = *(const f32x4*)(cw + j * 1024 + 4); w[j][0] = a.x; w[j][1] = a.y; w[j][2] = a.z; w[j][3] = a.w; w[j][4] = b.x; w[j][5] = b.y; w[j][6] = b.z; w[j][7] = b.w; }
    { const f32x4 a = *(const f32x4*)cb, b = *(const f32x4*)(cb + 4); bias[0] = a.x; bias[1] = a.y; bias[2] = a.z; bias[3] = a.w; bias[4] = b.x; bias[5] = b.y; bias[6] = b.z; bias[7] = b.w; }
    const int nthr = gridDim.x * 512;
    for (int idx0 = gt; idx0 < MTOK * 128; idx0 += 4 * nthr) {
        u32x4 v[4][4];
#pragma unroll
        for (int q = 0; q < 4; ++q) { const int idx = idx0 + q * nthr; const int t = idx >> 7, pos = t & (SEQ - 1);
#pragma unroll
            for (int j = 0; j < 4; ++j) { v[q][j] = (u32x4){0u, 0u, 0u, 0u}; if (idx < MTOK * 128 && pos - 3 + j >= 0) v[q][j] = *(const u32x4*)(proj + (size_t)(t - 3 + j) * NPROJ + 512 + c8 * 8); } }
        asm volatile("" ::: "memory");
#pragma unroll
        for (int q = 0; q < 4; ++q) { const int idx = idx0 + q * nthr; const int t = idx >> 7;
            float y[8];
#pragma unroll
            for (int e = 0; e < 8; ++e) y[e] = bias[e];
#pragma unroll
            for (int j = 0; j < 4; ++j) { const u32x4 vv = v[q][j];
                y[0] += w[j][0] * bflo(vv.x); y[1] += w[j][1] * bfhi(vv.x); y[2] += w[j][2] * bflo(vv.y); y[3] += w[j][3] * bfhi(vv.y);
                y[4] += w[j][4] * bflo(vv.z); y[5] += w[j][5] * bfhi(vv.z); y[6] += w[j][6] * bflo(vv.w); y[7] += w[j][7] * bfhi(vv.w); }
            u32x4 o; o.x = cvt_pk_bf16(siluf_(y[0]), siluf_(y[1])); o.y = cvt_pk_bf16(siluf_(y[2]), siluf_(y[3])); o.z = cvt_pk_bf16(siluf_(y[4]), siluf_(y[5])); o.w = cvt_pk_bf16(siluf_(y[6]), siluf_(y[7]));
            if (idx < MTOK * 128) *(u32x4*)(xc + (size_t)t * DM + c8 * 8) = o; }
    }
}

__device__ __forceinline__ void conv_slice(const KP& p, int l, int pm, int head) {
    const bf16_t* proj = (const bf16_t*)(p.ws + O_BIG); bf16_t* xc = (bf16_t*)(p.ws + O_XC);
    const int tid = opaque_tid(); const int c8 = head * 32 + (tid & 31), rsub = tid >> 5;
    const float* cw = p.in[18] + (size_t)l * 4 * 1024 + c8 * 8; const float* cb = p.in[19] + (size_t)l * 1024 + c8 * 8;
    float w[4][8], bias[8];
#pragma unroll
    for (int j = 0; j < 4; ++j) { const f32x4 a = *(const f32x4*)(cw + j * 1024), b = *(const f32x4*)(cw + j * 1024 + 4); w[j][0] = a.x; w[j][1] = a.y; w[j][2] = a.z; w[j][3] = a.w; w[j][4] = b.x; w[j][5] = b.y; w[j][6] = b.z; w[j][7] = b.w; }
    { const f32x4 a = *(const f32x4*)cb, b = *(const f32x4*)(cb + 4); bias[0] = a.x; bias[1] = a.y; bias[2] = a.z; bias[3] = a.w; bias[4] = b.x; bias[5] = b.y; bias[6] = b.z; bias[7] = b.w; }
    for (int j0 = 0; j0 < 16; j0 += 4) {
        u32x4 v[4][4];
#pragma unroll
        for (int q = 0; q < 4; ++q) { const int t = pm * 256 + rsub + 16 * (j0 + q), pos = t & (SEQ - 1);
#pragma unroll
            for (int j = 0; j < 4; ++j) { v[q][j] = (u32x4){0u, 0u, 0u, 0u}; if (pos - 3 + j >= 0) v[q][j] = *(const u32x4*)(proj + (size_t)(t - 3 + j) * NPROJ + 512 + c8 * 8); } }
        asm volatile("" ::: "memory");
#pragma unroll
        for (int q = 0; q < 4; ++q) { const int t = pm * 256 + rsub + 16 * (j0 + q);
            float y[8];
#pragma unroll
            for (int e = 0; e < 8; ++e) y[e] = bias[e];
#pragma unroll
            for (int j = 0; j < 4; ++j) { const u32x4 vv = v[q][j];
                y[0] += w[j][0] * bflo(vv.x); y[1] += w[j][1] * bfhi(vv.x); y[2] += w[j][2] * bflo(vv.y); y[3] += w[j][3] * bfhi(vv.y);
                y[4] += w[j][4] * bflo(vv.z); y[5] += w[j][5] * bfhi(vv.z); y[6] += w[j][6] * bflo(vv.w); y[7] += w[j][7] * bfhi(vv.w); }
            u32x4 o; o.x = cvt_pk_bf16(siluf_(y[0]), siluf_(y[1])); o.y = cvt_pk_bf16(siluf_(y[2]), siluf_(y[3])); o.z = cvt_pk_bf16(siluf_(y[4]), siluf_(y[5])); o.w = cvt_pk_bf16(siluf_(y[6]), siluf_(y[7]));
            *(u32x4*)(xc + (size_t)t * DM + c8 * 8) = o; }
    }
}

template <bool PASSC>
__device__ __forceinline__ void s5_phase(const KP& p, int l, LAS unsigned char* lds) {
    const int tid = opaque_tid(); const int wid = tid >> 6, lane = tid & 63, fr = lane & 15, fq = lane >> 4;
    LAS float* buS = (LAS float*)(lds + wid * 12800);
    LAS unsigned char* sS = lds + wid * 12800 + 8448;
    const bf16_t* proj = (const bf16_t*)(p.ws + O_BIG); bf16_t* z = (bf16_t*)(p.ws + O_Z);
    f32x2* s5end = (f32x2*)(p.ws + O_S5END);
    for (int task = blockIdx.x * 8 + wid; task < 2048; task += gridDim.x * 8) {
        const int seq = task >> 5, c = task & 31, b = seq >> 5, g = seq & 31, n = lane, lg = l * 32 + g;
        const float dt = expf(p.in[10][lg]);
        float ar, ai;
        { const float lr = fminf(p.in[8][lg * 64 + n], -1e-4f), li = p.in[9][lg * 64 + n];
          const float mag = expf(lr * dt); float sn, cs; sincos_acc(li * dt, sn, cs); ar = mag * cs; ai = mag * sn; }
        bf16x8 bx[8];
#pragma unroll
        for (int q4 = 0; q4 < 4; ++q4) { const int n2 = q4 * 16 + fr;
            const float lr = fminf(p.in[8][lg * 64 + n2], -1e-4f), li = p.in[9][lg * 64 + n2];
            const float mag = expf(lr * dt); float sn, cs; sincos_acc(li * dt, sn, cs);
            const float a_r = mag * cs, a_i = mag * sn, den = lr * lr + li * li;
            float qr = ((a_r - 1.0f) * lr + a_i * li) / den, qi = (a_i * lr - (a_r - 1.0f) * li) / den;
            if (fq >= 2) { qr = 0.f; qi = 0.f; }
            const float* brp = p.in[11] + (size_t)(lg * 64 + n2) * 16 + (fq & 1) * 8; const float* bip = p.in[12] + (size_t)(lg * 64 + n2) * 16 + (fq & 1) * 8;
            const f32x4 br0 = *(const f32x4*)brp, br1 = *(const f32x4*)(brp + 4), bi0 = *(const f32x4*)bip, bi1 = *(const f32x4*)(bip + 4);
            const f32x4 re0 = qr * br0 - qi * bi0, re1 = qr * br1 - qi * bi1, im0 = qr * bi0 + qi * br0, im1 = qr * bi1 + qi * br1;
            u32x4 o; o.x = cvt_pk_bf16(re0.x, re0.y); o.y = cvt_pk_bf16(re0.z, re0.w); o.z = cvt_pk_bf16(re1.x, re1.y); o.w = cvt_pk_bf16(re1.z, re1.w);
            bx[q4] = __builtin_bit_cast(bf16x8, o);
            o.x = cvt_pk_bf16(im0.x, im0.y); o.y = cvt_pk_bf16(im0.z, im0.w); o.z = cvt_pk_bf16(im1.x, im1.y); o.w = cvt_pk_bf16(im1.z, im1.w);
            bx[4 + q4] = __builtin_bit_cast(bf16x8, o); }
        float sr = 0.f, si = 0.f;
        bf16x8 cm[4]; f32x4 d4 = (f32x4){0.f, 0.f, 0.f, 0.f};
        if (PASSC) {
            float xr = ar, xi = ai;
#pragma unroll
            for (int q = 0; q < 8; ++q) { const float t0 = xr * xr - xi * xi, t1 = 2.0f * xr * xi; xr = t0; xi = t1; }
            for (int c0 = 0; c0 < c; c0 += 16) {
                f32x2 ev[16];
#pragma unroll
                for (int j = 0; j < 16; ++j) { const int cc = (c0 + j < c) ? c0 + j : c - 1; ev[j] = s5end[(size_t)(seq * 32 + cc) * 64 + n]; }
#pragma unroll
                for (int j = 0; j < 16; ++j) { const bool on = c0 + j < c; const float t0 = sr * xr - si * xi + ev[j].x, t1 = sr * xi + si * xr + ev[j].y; sr = on ? t0 : sr; si = on ? t1 : si; }
            }
#pragma unroll
            for (int kb = 0; kb < 4; ++kb) { const float* src = (kb < 2 ? p.in[13] : p.in[14]) + (size_t)(lg * 16 + fr) * 64 + (kb & 1) * 32 + fq * 8;
                const f32x4 a = *(const f32x4*)src, bq = *(const f32x4*)(src + 4); const float sg = kb < 2 ? 1.0f : -1.0f;
                u32x4 o; o.x = cvt_pk_bf16(sg * a.x, sg * a.y); o.y = cvt_pk_bf16(sg * a.z, sg * a.w); o.z = cvt_pk_bf16(sg * bq.x, sg * bq.y); o.w = cvt_pk_bf16(sg * bq.z, sg * bq.w);
                cm[kb] = __builtin_bit_cast(bf16x8, o); }
            d4 = *(const f32x4*)(p.in[15] + (size_t)l * 512 + g * 16 + fq * 4);
        }
        const int tok0 = b * SEQ + c * 256;
        const bf16_t* urow0 = proj + (size_t)(tok0 + fr) * NPROJ + g * 16;
        u32x4 unext = *(const u32x4*)(urow0 + (fq & 1) * 8); u32x2 u4next = *(const u32x2*)(urow0 + fq * 4);
        for (int sub = 0; sub < 16; ++sub) {
            u32x4 uraw = unext; const u32x2 u4 = u4next;
            if (sub < 15) { const bf16_t* urow = urow0 + (size_t)(sub + 1) * 16 * NPROJ; unext = *(const u32x4*)(urow + (fq & 1) * 8); u4next = *(const u32x2*)(urow + fq * 4); }
            if (fq >= 2) uraw = (u32x4){0u, 0u, 0u, 0u};
            const bf16x8 yu = __builtin_bit_cast(bf16x8, uraw);
#pragma unroll
            for (int kb = 0; kb < 8; ++kb) { const f32x4 acc = __builtin_amdgcn_mfma_f32_16x16x32_bf16(bx[kb], yu, (f32x4){0.f, 0.f, 0.f, 0.f}, 0, 0, 0);
                *(LAS f32x4*)(buS + fr * 132 + kb * 16 + fq * 4) = acc; }
            WAVE_LDS_SYNC();
            float burv[16], buiv[16];
#pragma unroll
            for (int tt = 0; tt < 16; ++tt) { burv[tt] = buS[tt * 132 + n]; buiv[tt] = buS[tt * 132 + 64 + n]; }
#pragma unroll
            for (int tt = 0; tt < 16; ++tt) {
                const float bur = burv[tt], bui = buiv[tt];
                const float t0 = ar * sr - ai * si + bur, t1 = ar * si + ai * sr + bui; sr = t0; si = t1;
                if (PASSC) { const unsigned pk = cvt_pk_bf16(sr, si); *(LAS unsigned short*)(sS + tt * 272 + n * 2) = (unsigned short)(pk & 0xffffu); *(LAS unsigned short*)(sS + tt * 272 + 128 + n * 2) = (unsigned short)(pk >> 16); }
            }
            if (PASSC) {
                WAVE_LDS_SYNC();
                f32x4 acc = (f32x4){0.f, 0.f, 0.f, 0.f};
#pragma unroll
                for (int kb = 0; kb < 4; ++kb) { const bf16x8 yf = *(LAS bf16x8*)(sS + fr * 272 + (kb * 32 + fq * 8) * 2); acc = __builtin_amdgcn_mfma_f32_16x16x32_bf16(cm[kb], yf, acc, 0, 0, 0); }
                const f32x4 uv = (f32x4){bflo(u4.x), bfhi(u4.x), bflo(u4.y), bfhi(u4.y)};
                const f32x4 y = acc + d4 * uv;
                u32x2 o; o.x = cvt_pk_bf16(gelu_tanh(y.x), gelu_tanh(y.y)); o.y = cvt_pk_bf16(gelu_tanh(y.z), gelu_tanh(y.w));
                *(u32x2*)(z + (size_t)(tok0 + sub * 16 + fr) * 512 + g * 16 + fq * 4) = o;
            }
            WAVE_LDS_SYNC();
        }
        if (!PASSC) s5end[(size_t)(seq * 32 + c) * 64 + n] = (f32x2){sr, si};
    }
}

__device__ __forceinline__ float scan_sum128(float v, int tid, LAS float* tmp) {
    const int lane = tid & 63; float x = v;
#pragma unroll
    for (int o = 1; o < 64; o <<= 1) { const float y = __shfl_up(x, o); if (lane >= o) x += y; }
    if (tid == 63) tmp[0] = x;
    __syncthreads();
    if (tid >= 64 && tid < 128) x += tmp[0];
    return x;
}
__device__ __forceinline__ float scan_max128(float v, int tid, LAS float* tmp) {
    const int lane = tid & 63; float x = v;
#pragma unroll
    for (int o = 1; o < 64; o <<= 1) { const float y = __shfl_up(x, o); if (lane >= o) x = fmaxf(x, y); }
    if (tid == 63) tmp[1] = x;
    __syncthreads();
    if (tid >= 64 && tid < 128) x = fmaxf(x, tmp[1]);
    return x;
}
__device__ __forceinline__ bf16x8 tr_frag(LAS unsigned char* a0, int second_off) {
    const s16x4 lo = __builtin_amdgcn_ds_read_tr16_b64_v4i16((LAS s16x4*)a0);
    const s16x4 hi = __builtin_amdgcn_ds_read_tr16_b64_v4i16((LAS s16x4*)(a0 + second_off));
    return __builtin_shufflevector(lo, hi, 0, 1, 2, 3, 4, 5, 6, 7);
}
template <bool OWN> __device__ __forceinline__ void mlstm_s1_phase(const KP& p, LAS unsigned char* lds) {
    const int tid = opaque_tid(), wid = tid >> 6, lane = tid & 63, fr = lane & 15, fq = lane >> 4;
    const bf16_t* proj = (const bf16_t*)(p.ws + O_BIG); const bf16_t* kbuf = (const bf16_t*)(p.ws + O_K);
    const float* ifb = (const float*)(p.ws + O_IF); bf16_t* cst = (bf16_t*)(p.ws + O_CST);
    float* gout = (float*)(p.ws + O_G); float* mlout = (float*)(p.ws + O_MLOC); float* nloc = (float*)(p.ws + O_NLOC);
    LAS unsigned char* Ks = lds; LAS unsigned char* Vs = lds + 69632;
    LAS float* vlf = (LAS float*)(lds + VEC_OFF); LAS float* vi = vlf + 128; LAS float* vb = vlf + 256; LAS float* vdec = vlf + 384;
    const int own_pm = (int)blockIdx.x >> 2, own_bhc0 = (((own_pm >> 5) * 4 + ((int)blockIdx.x & 3)) * 64) + (own_pm & 31) * 2;
    for (int tk = OWN ? 0 : (int)blockIdx.x; tk < (OWN ? 4 : 1024); tk += OWN ? 1 : (int)gridDim.x) {
        const int task = OWN ? (((own_bhc0 + (tk >> 1)) << 1) | (tk & 1)) : tk;
        const int eh = task & 1, bhc = task >> 1, c = bhc & 63, bh = bhc >> 6, h = bh & 3, b = bh >> 2;
        const int tok0 = b * SEQ + c * 128;
        const bool newk = !OWN || eh == 0;
        u32x4 kv[8], vv[4];
        if (newk) {
#pragma unroll
            for (int it = 0; it < 8; ++it) { const int id = it * 512 + tid, s = id >> 5, ch = id & 31; kv[it] = *(const u32x4*)(kbuf + (unsigned)(tok0 + s) * DM + h * 256 + ch * 8); }
        }
#pragma unroll
        for (int it = 0; it < 4; ++it) { const int id = it * 512 + tid, s = id >> 4, ch = id & 15; vv[it] = *(const u32x4*)(proj + (unsigned)(tok0 + s) * NPROJ + 1536 + h * 256 + eh * 128 + ch * 8); }
        LAS float* tmp = vlf;
        float gg = 0.f, mloc = 0.f;
        if (newk) {
        float gi = 0.f, glf = 0.f;
        if (tid < 128) { gi = ifb[(size_t)(tok0 + tid) * 8 + h]; glf = logsigmoidf_(ifb[(size_t)(tok0 + tid) * 8 + 4 + h]); }
        const float bsum = scan_sum128(glf, tid, tmp);
        if (tid == 127) tmp[2] = bsum;
        __syncthreads();
        gg = tmp[2];
        float dec = -INFINITY;
        if (tid < 128) { dec = gg - bsum + gi; vdec[tid] = dec; }
        { float x = dec;
#pragma unroll
          for (int o = 1; o < 64; o <<= 1) x = fmaxf(x, __shfl_xor(x, o));
          if (lane == 0 && wid < 2) tmp[4 + wid] = x; }
        __syncthreads();
        mloc = fmaxf(tmp[4], tmp[5]);
        asm volatile("" ::: "memory");
#pragma unroll
        for (int it = 0; it < 8; ++it) { const int id = it * 512 + tid, s = id >> 5, ch = id & 31;
            const u32x4 v = kv[it]; const float w = __expf(vdec[s] - mloc);
            u32x4 o; o.x = cvt_pk_bf16(bflo(v.x) * w, bfhi(v.x) * w); o.y = cvt_pk_bf16(bflo(v.y) * w, bfhi(v.y) * w); o.z = cvt_pk_bf16(bflo(v.z) * w, bfhi(v.z) * w); o.w = cvt_pk_bf16(bflo(v.w) * w, bfhi(v.w) * w);
            *(LAS u32x4*)(Ks + s * 544 + ch * 16) = o; }
        }
#pragma unroll
        for (int it = 0; it < 4; ++it) { const int id = it * 512 + tid, s = id >> 4, ch = id & 15;
            *(LAS u32x4*)(Vs + s * 288 + ch * 16) = vv[it]; }
        __syncthreads();
        f32x4 acc[2][8];
#pragma unroll
        for (int a = 0; a < 2; ++a)
#pragma unroll
            for (int e = 0; e < 8; ++e) acc[a][e] = (f32x4){0.f, 0.f, 0.f, 0.f};
#pragma unroll
        for (int kb = 0; kb < 4; ++kb) {
            bf16x8 X[2];
#pragma unroll
            for (int db = 0; db < 2; ++db) X[db] = tr_frag(Ks + (kb * 32 + fq * 4 + (fr >> 2)) * 544 + (32 * wid + db * 16 + (fr & 3) * 4) * 2, 16 * 544);
#pragma unroll
            for (int eb = 0; eb < 8; ++eb) { const bf16x8 Y = tr_frag(Vs + (kb * 32 + fq * 4 + (fr >> 2)) * 288 + (eb * 16 + (fr & 3) * 4) * 2, 16 * 288);
#pragma unroll
                for (int db = 0; db < 2; ++db) acc[db][eb] = __builtin_amdgcn_mfma_f32_16x16x32_bf16(X[db], Y, acc[db][eb], 0, 0, 0); }
        }
#pragma unroll
        for (int db = 0; db < 2; ++db)
#pragma unroll
            for (int eb = 0; eb < 8; ++eb) { u32x2 o; o.x = cvt_pk_bf16(acc[db][eb][0], acc[db][eb][1]); o.y = cvt_pk_bf16(acc[db][eb][2], acc[db][eb][3]);
                *(u32x2*)(cst + (size_t)bhc * 65536 + (size_t)(eh * 128 + eb * 16 + fr) * 256 + 32 * wid + db * 16 + fq * 4) = o; }
        if (eh == 0) {
            if (tid < 256) { float sn = 0.f;
                for (int s0 = 0; s0 < 128; s0 += 16) { unsigned short tv[16];
#pragma unroll
                    for (int j = 0; j < 16; ++j) tv[j] = *(LAS unsigned short*)(Ks + (s0 + j) * 544 + tid * 2);
#pragma unroll
                    for (int j = 0; j < 16; ++j) sn += bflo((unsigned)tv[j]); }
                nloc[(size_t)bhc * 256 + tid] = sn; }
            if (tid == 0) { gout[bhc] = gg; mlout[bhc] = mloc; }
        }
        __syncthreads();
    }
}
__device__ __forceinline__ void mlstm_s2_phase(const KP& p) {
    const int tid = opaque_tid();
    bf16_t* cst = (bf16_t*)(p.ws + O_CST);
    const float* gin = (const float*)(p.ws + O_G); const float* mlin = (const float*)(p.ws + O_MLOC); float* mst = (float*)(p.ws + O_MST);
    const float* nloc = (const float*)(p.ws + O_NLOC); float* nst = (float*)(p.ws + O_NST);
    for (int slot = blockIdx.x; slot < 256; slot += gridDim.x) {
        const int bh = slot >> 5, part = slot & 31; const size_t e0 = (size_t)(part * 512 + tid) * 4;
        float m = 0.f, C0 = 0.f, C1 = 0.f, C2 = 0.f, C3 = 0.f, nv = 0.f;
        const bool do_n = (part == 0) && (tid < 256);
        for (int c8 = 0; c8 < 64; c8 += 8) {
            u32x2 loc[8]; float nl[8];
#pragma unroll
            for (int j = 0; j < 8; ++j) { loc[j] = *(const u32x2*)(cst + (size_t)(bh * 64 + c8 + j) * 65536 + e0); nl[j] = do_n ? nloc[(size_t)(bh * 64 + c8 + j) * 256 + tid] : 0.f; }
#pragma unroll
            for (int j = 0; j < 8; ++j) { const int idx = bh * 64 + c8 + j;
                const float g = gin[idx], ml = mlin[idx]; const float mnew = fmaxf(g + m, ml); const float wo = __expf(g + m - mnew), wl = __expf(ml - mnew);
                u32x2 o; o.x = cvt_pk_bf16(C0, C1); o.y = cvt_pk_bf16(C2, C3);
                *(u32x2*)(cst + (size_t)idx * 65536 + e0) = o;
                C0 = wo * C0 + wl * bflo(loc[j].x); C1 = wo * C1 + wl * bfhi(loc[j].x); C2 = wo * C2 + wl * bflo(loc[j].y); C3 = wo * C3 + wl * bfhi(loc[j].y);
                if (do_n) { nst[(size_t)idx * 256 + tid] = nv; nv = wo * nv + wl * nl[j]; if (tid == 0) mst[idx] = m; }
                m = mnew; }
        }
    }
}
__device__ __forceinline__ void mlstm_s3_phase(const KP& p, int l, LAS unsigned char* lds) {
    const int tid = opaque_tid(), wid = tid >> 6, lane = tid & 63, fr = lane & 15, fq = lane >> 4;
    const bf16_t* proj = (const bf16_t*)(p.ws + O_BIG); const bf16_t* qbuf = (const bf16_t*)(p.ws + O_Q); const bf16_t* kbuf = (const bf16_t*)(p.ws + O_K);
    const bf16_t* xc = (const bf16_t*)(p.ws + O_XC); const float* ifb = (const float*)(p.ws + O_IF); const bf16_t* cst = (const bf16_t*)(p.ws + O_CST);
    const float* mst = (const float*)(p.ws + O_MST); const float* nst = (const float*)(p.ws + O_NST); bf16_t* yml = (bf16_t*)(p.ws + O_XN);
    const float* normg = p.in[22] + (unsigned)l * 1024; const float* skipg = p.in[23] + (unsigned)l * 1024;
    LAS unsigned char* Vh = lds;
    LAS unsigned char* Qs = lds + 36864;
    LAS unsigned char* Kt = lds + 55296;
    LAS unsigned char* CTs = lds + 73728;
    LAS unsigned char* Ss = lds + 92160;
    LAS float* vlf = (LAS float*)(lds + VEC_OFF); LAS float* va = vlf + 128; LAS float* vb = vlf + 256; LAS float* vM = vlf + 384; LAS float* nvec = vlf + 512; LAS float* ngs = vlf + 768; LAS float* sks = vlf + 1024;
    for (int task = blockIdx.x; task < 512; task += gridDim.x) {
        const int bhc = task, c = bhc & 63, bh = bhc >> 6, h = bh & 3, b = bh >> 2;
        const int tok0 = b * SEQ + c * 128;
        const float m0 = mst[bhc];
        float gi = 0.f, glf = 0.f;
        if (tid < 128) { gi = ifb[(unsigned)(tok0 + tid) * 8 + h]; glf = logsigmoidf_(ifb[(unsigned)(tok0 + tid) * 8 + 4 + h]); }
        if (tid < 256) { nvec[tid] = nst[(unsigned)bhc * 256 + tid]; ngs[tid] = normg[h * 256 + tid]; sks[tid] = skipg[h * 256 + tid]; }
        const float bs = scan_sum128(glf, tid, vlf);
        const float av = (tid < 128) ? gi - bs : -INFINITY;
        const float mm = scan_max128(av, tid, vlf);
        if (tid < 128) { vb[tid] = bs; va[tid] = av; vM[tid] = fmaxf(m0, mm); }
        const int t = 16 * wid + fr;
        const unsigned tok = (unsigned)(tok0 + t);
        u32x2 hc0[8];
        float qn = 0.f, ss = 0.f, inv = 0.f, winter = 0.f;
#pragma unroll
        for (int eh = 0; eh < 2; ++eh) {
            f32x4 accS[8], accO[8];
#pragma unroll
            for (int i = 0; i < 8; ++i) { accS[i] = (f32x4){0.f, 0.f, 0.f, 0.f}; accO[i] = (f32x4){0.f, 0.f, 0.f, 0.f}; }
            u32x4 pq[2], pk[2], pc[2];
#define S3_LOAD(DB) do { _Pragma("unroll") for (int it = 0; it < 2; ++it) { const int id = it * 512 + tid, row = id >> 3, ch = id & 7; \
                    pq[it] = *(const u32x4*)(qbuf + (unsigned)(tok0 + row) * DM + h * 256 + (DB) * 64 + ch * 8); \
                    if (eh == 0) pk[it] = *(const u32x4*)(kbuf + (unsigned)(tok0 + row) * DM + h * 256 + (DB) * 64 + ch * 8); \
                    pc[it] = *(const u32x4*)(cst + (unsigned)bhc * 65536 + (unsigned)(eh * 128 + row) * 256 + (DB) * 64 + ch * 8); } } while (0)
            S3_LOAD(0);
            for (int db4 = 0; db4 < 4; ++db4) {
                __syncthreads();
#pragma unroll
                for (int it = 0; it < 2; ++it) { const int id = it * 512 + tid, row = id >> 3, ch = id & 7;
                    *(LAS u32x4*)(Qs + row * 144 + ch * 16) = pq[it];
                    if (eh == 0) *(LAS u32x4*)(Kt + row * 144 + ch * 16) = pk[it];
                    *(LAS u32x4*)(CTs + row * 144 + ch * 16) = pc[it]; }
                if (db4 < 3) S3_LOAD(db4 + 1);
                __syncthreads();
#pragma unroll
                for (int kk = 0; kk < 2; ++kk) {
                    const bf16x8 Qf = *(LAS bf16x8*)(Qs + (16 * wid + fr) * 144 + (kk * 32 + fq * 8) * 2);
                    if (eh == 0) {
                        const u32x4 qu = __builtin_bit_cast(u32x4, Qf); const LAS float* nvp = nvec + db4 * 64 + kk * 32 + fq * 8; const f32x4 n0 = *(LAS f32x4*)nvp, n1 = *(LAS f32x4*)(nvp + 4);
                        qn += bflo(qu.x) * n0.x + bfhi(qu.x) * n0.y + bflo(qu.y) * n0.z + bfhi(qu.y) * n0.w + bflo(qu.z) * n1.x + bfhi(qu.z) * n1.y + bflo(qu.w) * n1.z + bfhi(qu.w) * n1.w;
#pragma unroll
                        for (int sb = 0; sb < 8; ++sb) { if (sb <= wid) { const bf16x8 Kf = *(LAS bf16x8*)(Kt + (sb * 16 + fr) * 144 + (kk * 32 + fq * 8) * 2); accS[sb] = __builtin_amdgcn_mfma_f32_16x16x32_bf16(Kf, Qf, accS[sb], 0, 0, 0); } if ((sb & 3) == 3) { asm volatile("" ::: "memory"); __builtin_amdgcn_sched_barrier(0); } }
                    }
#pragma unroll
                    for (int eb = 0; eb < 8; ++eb) { const bf16x8 Cf = *(LAS bf16x8*)(CTs + (eb * 16 + fr) * 144 + (kk * 32 + fq * 8) * 2); accO[eb] = __builtin_amdgcn_mfma_f32_16x16x32_bf16(Cf, Qf, accO[eb], 0, 0, 0); if ((eb & 3) == 3) { asm volatile("" ::: "memory"); __builtin_amdgcn_sched_barrier(0); } }
                }
            }
            u32x4 vt[4];
#pragma unroll
            for (int it = 0; it < 4; ++it) { const int id = it * 512 + tid, s = id >> 4, ch = id & 15; vt[it] = *(const u32x4*)(proj + (unsigned)(tok0 + s) * NPROJ + 1536 + h * 256 + eh * 128 + ch * 8); }
            asm volatile("" ::: "memory");
#pragma unroll
            for (int it = 0; it < 4; ++it) { const int id = it * 512 + tid, s = id >> 4, ch = id & 15; *(LAS u32x4*)(Vh + s * 288 + ch * 16) = vt[it]; }
            if (eh == 0) {
                const float Mt = vM[t]; winter = __expf(m0 - Mt);
                float rowsum = 0.f;
#pragma unroll
                for (int sb = 0; sb < 8; ++sb) if (sb <= (wid | 1)) {
                    const f32x4 a4 = *(LAS f32x4*)(va + sb * 16 + fq * 4);
                    float sv[4];
#pragma unroll
                    for (int j = 0; j < 4; ++j) { const int s = sb * 16 + fq * 4 + j; const float v0 = accS[sb][j] * __expf(fminf(a4[j] - Mt, 0.f)); const float v = (s <= t) ? v0 : 0.f; sv[j] = v; rowsum += v; }
                    u32x2 o; o.x = cvt_pk_bf16(sv[0], sv[1]); o.y = cvt_pk_bf16(sv[2], sv[3]);
                    *(LAS u32x2*)(Ss + t * 272 + (sb * 16 + fq * 4) * 2) = o;
                }
                rowsum += __shfl_xor(rowsum, 16); rowsum += __shfl_xor(rowsum, 32);
                qn += __shfl_xor(qn, 16); qn += __shfl_xor(qn, 32);
                const float den = winter * qn + rowsum, mt = vb[t] + Mt;
                inv = 1.0f / fmaxf(fabsf(den), __expf(-mt));
            }
#pragma unroll
            for (int eb = 0; eb < 8; ++eb) accO[eb] = accO[eb] * winter;
            __syncthreads();
            for (int kb = 0; kb <= (wid >> 1); ++kb) {
                const s16x4 s0 = *(LAS s16x4*)(Ss + t * 272 + (kb * 32 + fq * 4) * 2), s1 = *(LAS s16x4*)(Ss + t * 272 + (kb * 32 + 16 + fq * 4) * 2);
                const bf16x8 Sf = __builtin_shufflevector(s0, s1, 0, 1, 2, 3, 4, 5, 6, 7);
#pragma unroll
                for (int eb = 0; eb < 8; ++eb) { const bf16x8 Vf = tr_frag(Vh + (kb * 32 + fq * 4 + (fr >> 2)) * 288 + (eb * 16 + (fr & 3) * 4) * 2, 16 * 288);
                    accO[eb] = __builtin_amdgcn_mfma_f32_16x16x32_bf16(Vf, Sf, accO[eb], 0, 0, 0); if ((eb & 3) == 3) { asm volatile("" ::: "memory"); __builtin_amdgcn_sched_barrier(0); } }
            }
            u32x2 ovv[8];
#pragma unroll
            for (int eb = 0; eb < 8; ++eb) ovv[eb] = *(const u32x2*)(proj + tok * NPROJ + 2560 + h * 256 + eh * 128 + eb * 16 + fq * 4);
            asm volatile("" ::: "memory");
#pragma unroll
            for (int eb = 0; eb < 8; ++eb) { const u32x2 ov = ovv[eb];
                f32x4 hc; hc.x = sigmoidf_(bflo(ov.x)) * accO[eb].x * inv; hc.y = sigmoidf_(bfhi(ov.x)) * accO[eb].y * inv; hc.z = sigmoidf_(bflo(ov.y)) * accO[eb].z * inv; hc.w = sigmoidf_(bfhi(ov.y)) * accO[eb].w * inv;
                ss += (hc.x * hc.x + hc.y * hc.y) + (hc.z * hc.z + hc.w * hc.w);
                if (eh == 0) { hc0[eb].x = cvt_pk_bf16(hc.x, hc.y); hc0[eb].y = cvt_pk_bf16(hc.z, hc.w); } else accO[eb] = hc;
                if ((eb & 3) == 3) { asm volatile("" ::: "memory"); __builtin_amdgcn_sched_barrier(0); } }
            if (eh == 1) {
                ss += __shfl_xor(ss, 16); ss += __shfl_xor(ss, 32);
                const float rs = rsqrtf(ss * (1.0f / 256.0f) + EPS);
#pragma unroll
                for (int e4 = 0; e4 < 4; ++e4) {
                    u32x2 xvv[4];
#pragma unroll
                    for (int q = 0; q < 4; ++q) { const int col = h * 256 + (e4 * 4 + q) * 16 + fq * 4; xvv[q] = *(const u32x2*)(xc + tok * DM + col); }
                    asm volatile("" ::: "memory");
#pragma unroll
                    for (int q = 0; q < 4; ++q) { const int e2 = e4 * 4 + q, col = h * 256 + e2 * 16 + fq * 4;
                        const f32x4 ng = *(LAS f32x4*)(ngs + e2 * 16 + fq * 4), sk = *(LAS f32x4*)(sks + e2 * 16 + fq * 4); const u32x2 xv = xvv[q];
                        f32x4 hc; if (e2 < 8) { const u32x2 hp = hc0[e2 & 7]; hc = (f32x4){bflo(hp.x), bfhi(hp.x), bflo(hp.y), bfhi(hp.y)}; } else hc = accO[e2 & 7];
                        u32x2 o; o.x = cvt_pk_bf16(hc.x * rs * ng.x + sk.x * bflo(xv.x), hc.y * rs * ng.y + sk.y * bfhi(xv.x)); o.y = cvt_pk_bf16(hc.z * rs * ng.z + sk.z * bflo(xv.y), hc.w * rs * ng.w + sk.w * bfhi(xv.y));
                        *(u32x2*)(yml + tok * DM + col) = o; }
                    asm volatile("" ::: "memory"); __builtin_amdgcn_sched_barrier(0);
                }
            }
        }
        __syncthreads();
    }
}

#define XB_TMO      128
#define XB_XCNT(j)  (256  + 64 * (j))
#define XB_XSUB(j)  (1280 + 64 * (j))
#define XB_XGEN(j)  (2304 + 64 * (j))
#define XB_TOP      3328
#define XB_TOPGEN   3392
#define XCD_BAR_WORDS 3456
#define XB_SPIN_CAP (1u << 22)
__device__ __forceinline__ unsigned xb_ld(unsigned* p)              { return __hip_atomic_load(p, __ATOMIC_RELAXED, __HIP_MEMORY_SCOPE_AGENT); }
__device__ __forceinline__ unsigned xb_add(unsigned* p, unsigned v) { return __hip_atomic_fetch_add(p, v, __ATOMIC_RELAXED, __HIP_MEMORY_SCOPE_AGENT); }
__device__ __forceinline__ unsigned xb_xcc_id() { return (unsigned)__builtin_amdgcn_s_getreg((3 << 11) | 20) & 0xFu; }
#define XB_SPIN(cond, bar) do { unsigned _sp = 0; while (cond) { __builtin_amdgcn_s_sleep(1); \
    if ((++_sp & 255u) == 0u) { if (xb_ld(&(bar)[XB_TMO])) break; if (_sp > XB_SPIN_CAP) { atomicAdd(&(bar)[XB_TMO], 1u); break; } } } } while (0)
struct XcdBarrier { unsigned* bar; unsigned x; volatile LAS unsigned* st; };
__device__ __forceinline__ XcdBarrier xcd_barrier_post(unsigned* bar, volatile LAS unsigned* st) {
    XcdBarrier b; b.bar = bar; b.x = xb_xcc_id(); b.st = st;
    if (threadIdx.x == 0) (void)xb_add(&bar[XB_XCNT(b.x)], 1u);
    return b;
}
__device__ __forceinline__ void xcd_barrier_complete(unsigned* bar, unsigned x, unsigned& nloc, unsigned& nx) {
    const unsigned G = gridDim.x * gridDim.y * gridDim.z;
    unsigned sum, cnt, mine, sp = 0u;
    for (;;) {
        sum = 0u; cnt = 0u; mine = 0u;
#pragma unroll
        for (unsigned j = 0; j < 16; ++j) { const unsigned c = xb_ld(&bar[XB_XCNT(j)]); sum += c; cnt += (c > 0u) ? 1u : 0u; mine = (j == x) ? c : mine; }
        if (sum == G) break;
        __builtin_amdgcn_s_sleep(1);
        if ((++sp & 255u) == 0u) { if (xb_ld(&bar[XB_TMO])) break; if (sp > XB_SPIN_CAP) { atomicAdd(&bar[XB_TMO], 1u); break; } }
    }
    nloc = mine > 0u ? mine : 1u; nx = cnt > 0u ? cnt : 1u;
}
__device__ __forceinline__ void xcd_barrier(const XcdBarrier& b) {
    asm volatile("s_waitcnt vmcnt(0) lgkmcnt(0)" ::: "memory");
    __syncthreads();
    if (threadIdx.x == 0) {
        unsigned* bar = b.bar;
        __builtin_amdgcn_s_waitcnt(0);
        unsigned nloc = b.st[0], nx = b.st[1];
        if (nloc == 0u) { xcd_barrier_complete(bar, b.x, nloc, nx); b.st[0] = nloc; b.st[1] = nx; }
        const unsigned old = xb_add(&bar[XB_XSUB(b.x)], 1u);
        const unsigned gen = old / nloc;
        if (old + 1u == (gen + 1u) * nloc) {
            __builtin_amdgcn_fence(__ATOMIC_RELEASE, "agent");
            asm volatile("s_waitcnt vmcnt(0)" ::: "memory");
            const unsigned og = xb_add(&bar[XB_TOP], 1u);
            const unsigned tg = og / nx;
            if (og + 1u == (tg + 1u) * nx) xb_add(&bar[XB_TOPGEN], 1u);
            else XB_SPIN(xb_ld(&bar[XB_TOPGEN]) == tg, bar);
            __builtin_amdgcn_fence(__ATOMIC_ACQUIRE, "agent");
            xb_add(&bar[XB_XGEN(b.x)], 1u);
            asm volatile("s_waitcnt vmcnt(0)" ::: "memory");
        } else {
            XB_SPIN(xb_ld(&bar[XB_XGEN(b.x)]) == gen, bar);
            __builtin_amdgcn_fence(__ATOMIC_ACQUIRE, "agent");
            asm volatile("s_waitcnt vmcnt(0)" ::: "memory");
        }
    }
    __syncthreads();
}

__global__ void __launch_bounds__(512, 2) fwd_megakernel(KP p) {
    extern __shared__ __attribute__((aligned(16))) unsigned char shm[];
    LAS unsigned char* lds = (LAS unsigned char*)shm;
    cg::grid_group grid = cg::this_grid();
    { volatile LAS unsigned* st0 = (volatile LAS unsigned*)(lds + 143360); if (threadIdx.x < 4) st0[threadIdx.x] = 0u; }
    __syncthreads();
    const XcdBarrier xb = xcd_barrier_post((unsigned*)(p.ws + O_BAR), (volatile LAS unsigned*)(lds + 143360));
    if (p.out == nullptr) { asm volatile("s_waitcnt vmcnt(0) lgkmcnt(0)" ::: "memory"); grid.sync(); }
#define GSYNC() xcd_barrier(xb)
    unsigned char* ws = p.ws;
    bf16_t* BIG = (bf16_t*)(ws + O_BIG); bf16_t* XN = (bf16_t*)(ws + O_XN); bf16_t* XC = (bf16_t*)(ws + O_XC);
    bf16_t* Q = (bf16_t*)(ws + O_Q); bf16_t* KB = (bf16_t*)(ws + O_K); bf16_t* Z = (bf16_t*)(ws + O_Z); bf16_t* YS5 = (bf16_t*)(ws + O_YS5);
    float* MIXACC = (float*)(ws + O_CST); float* IFB = (float*)(ws + O_IF);
    float* xo = p.out;
    for (int l = 0; l < 4; ++l) {
        const float* xcur = (l == 0) ? p.in[0] : xo;
        for (int rep = 0; rep < REP_A; ++rep) { if (l == 0) convert_phase(p, 0, lds, 1, 0);
        rmsnorm_phase<false>(xcur, p.in[1] + l * 1024, XN, nullptr, nullptr, nullptr, lds); }
        GSYNC(); if (STOP_PHASE == 1) break;
        { pg8::Gemm g{XN, (const bf16_t*)(ws + W_GU1), MTOK, 2 * FF, 1024, 1024, 1024, 0}; pg8::EpiGated<0> e{BIG, FF}; pg8::gemm_phase(lds, g, e); }
        convert_phase(p, l, lds, l == 0 ? 2 : 4, 1);
        GSYNC(); if (STOP_PHASE == 2) break;
        { pg8::Gemm g{BIG, (const bf16_t*)(ws + W_D1), MTOK, 1024, FF, FF, FF, 0}; pg8::EpiResid e{xcur, xo, 0.5f}; pg8::gemm_phase(lds, g, e); }
        GSYNC(); if (STOP_PHASE == 3) break;
        for (int rep = 0; rep < REP_A; ++rep) { rmsnorm_phase<true>(xo, p.in[5] + l * 1024, XN, p.in[6] + (size_t)l * 1024 * INC, p.in[7] + l * 8, IFB, lds); __syncthreads(); }
        GSYNC(); if (STOP_PHASE == 4) break;
        { pg8::Gemm g{XN, (const bf16_t*)(ws + W_IN), MTOK, NPROJ, 1024, 1024, 1024, 0}; pg8::EpiBf16 e{BIG, BIG, NPROJ, 1000, 1.0f}; pg8::gemm_phase(lds, g, e); }
        if (l == 0) convert_phase(p, 0, lds, 4, 1);
        if (l < 3) convert_phase(p, l + 1, lds, 1, 1);
        GSYNC(); if (STOP_PHASE == 5) break;
        if (gridDim.x == 256) {
            s5_phase<false>(p, l, lds);
            conv_slice(p, l, (int)blockIdx.x >> 2, (int)blockIdx.x & 3);
            asm volatile("s_waitcnt vmcnt(0) lgkmcnt(0)" ::: "memory"); __syncthreads();
            { pg8::Gemm g{XC, (const bf16_t*)(ws + W_QK), MTOK, 2048, 256, 1024, 256, 256, nullptr, nullptr, 0, 1}; pg8::EpiBf16 e{Q, KB, 1024, 4, 0.0625f}; pg8::gemm_phase(lds, g, e); }
            asm volatile("s_waitcnt vmcnt(0) lgkmcnt(0)" ::: "memory"); __syncthreads();
            mlstm_s1_phase<true>(p, lds);
            GSYNC();
            s5_phase<true>(p, l, lds);
            mlstm_s2_phase(p);
            GSYNC();
            __syncthreads();
            { pg8::Gemm g{Z, (const bf16_t*)(ws + W_GLU), MTOK, 1024, 512, 512, 512, 0}; pg8::EpiGated<1> e{YS5, 1024}; pg8::gemm_phase(lds, g, e); }
            mlstm_s3_phase(p, l, lds);
            GSYNC();
        } else {
            conv_phase(p, l);
            s5_phase<false>(p, l, lds);
            GSYNC();
            { pg8::Gemm g{XC, (const bf16_t*)(ws + W_QK), MTOK, 2048, 256, 1024, 256, 256}; pg8::EpiBf16 e{Q, KB, 1024, 4, 0.0625f}; pg8::gemm_phase(lds, g, e); }
            GSYNC();
            mlstm_s1_phase<false>(p, lds);
            s5_phase<true>(p, l, lds);
            GSYNC();
            mlstm_s2_phase(p);
            { pg8::Gemm g{Z, (const bf16_t*)(ws + W_GLU), MTOK, 1024, 512, 512, 512, 0}; pg8::EpiGated<1> e{YS5, 1024}; pg8::gemm_phase(lds, g, e); }
            GSYNC();
            mlstm_s3_phase(p, l, lds);
            GSYNC();
        }
        { pg8::Gemm g{YS5, (const bf16_t*)(ws + W_BS5), MTOK, 1024, 512, 1024, 1024, 0, XN, (const bf16_t*)(ws + W_BML), 1024}; pg8::EpiMergeDual e{BIG + 3584, BIG + 4608, Q}; pg8::gemm_phase(lds, g, e); }
        GSYNC(); if (STOP_PHASE == 11) break;
        { pg8::Gemm g{Q, (const bf16_t*)(ws + W_OUT), MTOK, 1024, 1024, 1024, 1024, 0}; pg8::EpiResid e{xo, xo, 1.0f}; pg8::gemm_phase(lds, g, e); }
        GSYNC(); if (STOP_PHASE == 12) break;
        for (int rep = 0; rep < REP_A; ++rep) rmsnorm_phase<false>(xo, p.in[27] + l * 1024, XN, nullptr, nullptr, nullptr, lds);
        GSYNC(); if (STOP_PHASE == 13) break;
        { pg8::Gemm g{XN, (const bf16_t*)(ws + W_GU2), MTOK, 2 * FF, 1024, 1024, 1024, 0}; pg8::EpiGated<0> e{BIG, FF}; pg8::gemm_phase(lds, g, e); }
        if (l < 3) convert_phase(p, l + 1, lds, 2, 1);
        GSYNC(); if (STOP_PHASE == 14) break;
        { pg8::Gemm g{BIG, (const bf16_t*)(ws + W_D2), MTOK, 1024, FF, FF, FF, 0}; pg8::EpiResid e{xo, xo, 0.5f}; pg8::gemm_phase(lds, g, e); }
        GSYNC(); if (STOP_PHASE == 15) break;
    }
#ifdef DUMP_OFF
    { const int gt = blockIdx.x * 512 + opaque_tid(); const int nthr = gridDim.x * 512;
      for (int i = gt; i < MTOK * DM; i += nthr) { float v;
          if (DUMP_KIND == 5) { v = bflo((unsigned)((const bf16_t*)(ws + O_BIG))[(size_t)(i >> 10) * NPROJ + DUMP_COL + (i & 1023)]); }
          else if (DUMP_KIND == 4) { v = 0.f; if (i < 512) v = ((const float*)(ws + O_G))[i]; else if (i < 1024) v = ((const float*)(ws + O_MLOC))[i - 512]; else if (i < 1024 + 131072) v = ((const float*)(ws + O_NLOC))[i - 1024]; }
          else if (DUMP_KIND == 2 && i < 131072) v = ((const float*)(ws + O_IF))[i];
          else if (DUMP_KIND == 3) v = bflo((unsigned)((const bf16_t*)(ws + (i < 8388608 ? O_Q : O_K)))[i & 8388607]);
          else if (DUMP_KIND == 1) v = ((const float*)(ws + DUMP_OFF))[i]; else v = bflo((unsigned)((const bf16_t*)(ws + DUMP_OFF))[i]);
          xo[i] = (fabsf(v) < 1e30f) ? v : 12345.0f; } }
#else
    final_norm_phase(xo, p.in[31]);
#endif
}

extern "C" void kernel_launch(void* const* d_in, const int* in_sizes, int n_in, void* d_out, int out_size, void* d_ws, size_t ws_size, hipStream_t stream) {
    static int grid_blocks = 0;
    if (grid_blocks == 0) {
        if (n_in != 32 || ws_size < WS_END) { fprintf(stderr, "kernel_launch: unexpected n_in %d or ws_size %zu (< %zu)\n", n_in, ws_size, (size_t)WS_END); grid_blocks = -1; return; }
        int dev = 0, cus = 0, per_cu = 0;
        hipGetDevice(&dev);
        hipDeviceGetAttribute(&cus, hipDeviceAttributeMultiprocessorCount, dev);
        if (hipFuncSetAttribute((const void*)fwd_megakernel, hipFuncAttributeMaxDynamicSharedMemorySize, LDS_BYTES) != hipSuccess) { fprintf(stderr, "kernel_launch: hipFuncSetAttribute failed\n"); grid_blocks = -1; return; }
        hipOccupancyMaxActiveBlocksPerMultiprocessor(&per_cu, (const void*)fwd_megakernel, 512, LDS_BYTES);
        if (per_cu < 1) { fprintf(stderr, "kernel_launch: occupancy query says %d blocks/CU\n", per_cu); per_cu = 1; }
        (void)hipGetLastError();
        grid_blocks = cus;
    }
    if (grid_blocks < 0) return;
    if (hipMemsetAsync((unsigned char*)d_ws + O_BAR, 0, 16384, stream) != hipSuccess) { fprintf(stderr, "kernel_launch: memset of barrier words failed\n"); return; }
    KP p{};
    for (int i = 0; i < 32; ++i) p.in[i] = (const float*)d_in[i];
    p.out = (float*)d_out; p.ws = (unsigned char*)d_ws;
    void* args[] = {&p};
    hipError_t e = hipLaunchCooperativeKernel((const void*)fwd_megakernel, dim3(grid_blocks), dim3(512), args, LDS_BYTES, stream);
    if (e != hipSuccess) fprintf(stderr, "cooperative launch failed: %s (grid %d)\n", hipGetErrorString(e), grid_blocks);
}
```

```cpp
#include <hip/hip_runtime.h>
#include <hip/hip_cooperative_groups.h>
#include <cstdio>
namespace cg = cooperative_groups;

#define LAS __attribute__((address_space(3)))
typedef unsigned short bf16_t;
typedef short bf16x8 __attribute__((ext_vector_type(8)));
typedef short s16x4 __attribute__((ext_vector_type(4)));
typedef float f32x4 __attribute__((ext_vector_type(4)));
typedef float f32x2 __attribute__((ext_vector_type(2)));
typedef unsigned u32x4 __attribute__((ext_vector_type(4)));
typedef unsigned u32x2 __attribute__((ext_vector_type(2)));

constexpr int MTOK = 16384, DM = 1024, FF = 2816, NPROJ = 5632, SEQ = 8192, INC = 5640;
constexpr float EPS = 1e-6f;
constexpr int LDS_BYTES = 147456;
#ifndef STOP_PHASE
#define STOP_PHASE 99
#define REP_A 1
#define REP_G 1
#define REP_B 1
#define REP_C 1
#define REP_D 1
#endif
constexpr int VEC_OFF = 131072;

constexpr size_t W_GU1 = 0;
constexpr size_t W_D1 = W_GU1 + (size_t)5632 * 1024 * 2;
constexpr size_t W_IN = W_D1 + (size_t)1024 * 2816 * 2;
constexpr size_t W_GLU = W_IN + (size_t)5632 * 1024 * 2;
constexpr size_t W_QK = W_GLU + (size_t)1024 * 512 * 2;
constexpr size_t W_BS5 = W_QK + (size_t)2048 * 256 * 2;
constexpr size_t W_BML = W_BS5 + (size_t)1024 * 1024 * 2;
constexpr size_t W_OUT = W_BML + (size_t)1024 * 1024 * 2;
constexpr size_t W_GU2 = W_OUT + (size_t)1024 * 1024 * 2;
constexpr size_t W_D2 = W_GU2 + (size_t)5632 * 1024 * 2;
constexpr size_t W_END = W_D2 + (size_t)1024 * 2816 * 2;
constexpr size_t O_BIG = W_END;
constexpr size_t O_XN = O_BIG + (size_t)MTOK * NPROJ * 2;
constexpr size_t O_XC = O_XN + (size_t)MTOK * 1024 * 2;
constexpr size_t O_Q = O_XC + (size_t)MTOK * 1024 * 2;
constexpr size_t O_K = O_Q + (size_t)MTOK * 1024 * 2;
constexpr size_t O_Z = O_K + (size_t)MTOK * 1024 * 2;
constexpr size_t O_YS5 = O_Z + (size_t)MTOK * 512 * 2;
constexpr size_t O_CST = O_YS5 + (size_t)MTOK * 1024 * 2;
constexpr size_t O_IF = O_CST + (size_t)512 * 65536 * 2;
constexpr size_t O_S5END = O_IF + (size_t)MTOK * 8 * 4;
constexpr size_t O_G = O_S5END + (size_t)64 * 64 * 64 * 8;
constexpr size_t O_MLOC = O_G + 2048;
constexpr size_t O_MST = O_MLOC + 2048;
constexpr size_t O_NLOC = O_MST + 2048;
constexpr size_t O_NST = O_NLOC + (size_t)512 * 256 * 4;
constexpr size_t O_BAR = O_NST + (size_t)512 * 256 * 4;
constexpr size_t WS_END = O_BAR + 16384;

struct KP { const float* in[32]; float* out; unsigned char* ws; };

typedef __bf16 bf16v2_t __attribute__((ext_vector_type(2)));
__device__ __forceinline__ unsigned cvt_pk_bf16(float lo, float hi) { const f32x2 v = {lo, hi}; const bf16v2_t b = __builtin_convertvector(v, bf16v2_t); return __builtin_bit_cast(unsigned, b); }
__device__ __forceinline__ float bflo(unsigned u) { return __uint_as_float(u << 16); }
__device__ __forceinline__ float bfhi(unsigned u) { return __uint_as_float(u & 0xffff0000u); }
__device__ __forceinline__ float sigmoidf_(float x) { return __builtin_amdgcn_rcpf(1.0f + __expf(-x)); }
__device__ __forceinline__ float siluf_(float x) { return x * __builtin_amdgcn_rcpf(1.0f + __expf(-x)); }
__device__ __forceinline__ float gelu_tanh(float y) { const float v = 0.7978845608028654f * (y + 0.044715f * y * y * y); const float th = 1.0f - 2.0f * __builtin_amdgcn_rcpf(1.0f + __expf(2.0f * v)); return 0.5f * y * (1.0f + th); }
__device__ __forceinline__ float logsigmoidf_(float x) { return fminf(x, 0.f) - log1pf(__expf(-fabsf(x))); }
__device__ __forceinline__ float wave_sum(float v) {
#pragma unroll
    for (int o = 1; o < 64; o <<= 1) v += __shfl_xor(v, o);
    return v;
}
__device__ __forceinline__ int opaque_tid() { int t = threadIdx.x; asm volatile("" : "+v"(t)); return t; }
#define WAVE_LDS_SYNC() asm volatile("s_waitcnt lgkmcnt(0)" ::: "memory")
__device__ __forceinline__ void sincos_acc(float x, float& s, float& c) {
    const float k = rintf(x * 0.63661977236758134f);
    float r = fmaf(-k, 1.5703125f, x); r = fmaf(-k, 4.837512969970703125e-4f, r); r = fmaf(-k, 7.54978995489188216e-8f, r);
    const float r2 = r * r;
    const float sp = r + r * r2 * (-1.6666654611e-1f + r2 * (8.3321608736e-3f + r2 * (-1.9515295891e-4f)));
    const float cp = 1.0f - 0.5f * r2 + r2 * r2 * (4.166664568298827e-2f + r2 * (-1.388731625493765e-3f + r2 * 2.443315711809948e-5f));
    const int q = ((int)k) & 3;
    s = (q == 0) ? sp : (q == 1) ? cp : (q == 2) ? -sp : -cp;
    c = (q == 0) ? cp : (q == 1) ? -sp : (q == 2) ? -cp : sp;
}

namespace pg8 {
constexpr int BM = 256, BK = 64, HALF = 128, HTB = HALF * BK * 2, STAGE_BYTES = 8 * HTB, NXCD = 8, WGM = 8;
__host__ __device__ __forceinline__ int lds_byte(int r, int c) { const int st = (r >> 4) * 2 + (c >> 5), rr = r & 15, cc = c & 31, ob = rr * 64 + cc * 2; return st * 1024 + (ob ^ (((ob >> 9) & 1) << 5)); }
__host__ __device__ __forceinline__ void stage_rc(int b, int& R, int& C) { const int st = b / 1024, sb = b % 1024, swz = sb ^ (((sb >> 9) & 1) << 5); R = (st >> 1) * 16 + swz / 64; C = (st & 1) * 32 + (swz % 64) / 2; }
__host__ __device__ __forceinline__ int perm32(int rho) { const int n = rho >> 4, i = rho & 15; return 8 * (i >> 2) + 4 * n + (i & 3); }
struct Unit { int pm, pn; };
struct Gemm { const bf16_t* A; const bf16_t* Bt; int M, N, K, lda, ldb, ahead; const bf16_t* A2; const bf16_t* Bt2; int K2; int pairmode; };
struct StaticOrder {
    int nM, nN, nwg, G, c;
    __device__ void init(int M, int N, int G_, int c_) { nM = M / BM; nN = N / BM; nwg = nM * nN; G = G_; c = c_; }
    __device__ bool next(int i, Unit& u) const {
        const long L = (long)i * G + c; if (L >= nwg) return false;
        int wgid = (int)L; { const int q = nwg / NXCD, r = nwg % NXCD, xcd = wgid % NXCD, off = wgid / NXCD; wgid = (xcd < r ? xcd * (q + 1) : r * (q + 1) + (xcd - r) * q) + off; }
        const int nig = WGM * nN, gid = wgid / nig, fm = gid * WGM, gsz = (nM - fm) < WGM ? (nM - fm) : WGM;
        u.pm = fm + ((wgid % nig) % gsz); u.pn = (wgid % nig) / gsz; return true;
    }
};

template <class Epi>
__device__ __forceinline__ void gemm_phase(LAS unsigned char* lds, const Gemm g, const Epi& E) {
    StaticOrder S; S.init(g.M, g.N, (int)gridDim.x, (int)blockIdx.x);
    const int tid = opaque_tid(), wid = __builtin_amdgcn_readfirstlane(tid >> 6), lane = tid & 63, wr = wid >> 2, wc = wid & 3, fr = lane & 15, fq = lane >> 4;
    const int K = g.K; int nt = K / BK; int seg = 0;
    unsigned voffA[2], voffB[2];
#pragma unroll
    for (int i = 0; i < 2; ++i) { int R, C; stage_rc(tid * 16 + i * 8192, R, C); const int Rb = Epi::PERM ? ((R & ~31) + perm32(R & 31)) : R;
        voffA[i] = (unsigned)(R * g.lda + C) * 2u; voffB[i] = (unsigned)(Rb * g.ldb + C) * 2u; }
    const size_t kstep = (size_t)(BK * 2);
    const size_t hstepA = (size_t)HALF * g.lda * 2, hstepB = (size_t)HALF * g.ldb * 2;
    const size_t tstepA = 2 * hstepA, tstepB = 2 * hstepB;
    const unsigned ldsw = (unsigned)wid * 1024u;
    const int aoff = lds_byte(wr * 64 + fr, fq * 8), boff = lds_byte(wc * 32 + fr, fq * 8);
#define PG8_SA(b, h) (((b) * 2 + (h)) * HTB)
#define PG8_SB(b, h) ((4 + (b) * 2 + (h)) * HTB)
#define PG8_STAGE(bufoff, gbase, voff) do { _Pragma("unroll") for (int _i = 0; _i < 2; ++_i) \
        __builtin_amdgcn_global_load_lds((const unsigned*)((const char*)(gbase) + (voff)[_i]), (LAS unsigned*)(lds + (bufoff) + ldsw + _i * 8192), 16, 0, 0); } while (0)
#define PG8_LDA(dst, b, h) do { _Pragma("unroll") for (int m = 0; m < 4; ++m) _Pragma("unroll") for (int k = 0; k < 2; ++k) dst[m][k] = *(const LAS bf16x8*)(lds + PG8_SA(b, h) + aoff + m * 2048 + k * 1024); } while (0)
#define PG8_LDB(dst, b, h) do { _Pragma("unroll") for (int n = 0; n < 2; ++n) _Pragma("unroll") for (int k = 0; k < 2; ++k) dst[n][k] = *(const LAS bf16x8*)(lds + PG8_SB(b, h) + boff + n * 2048 + k * 1024); } while (0)
#define PG8_MMA(ai, bj, At, Bt) do { __builtin_amdgcn_s_setprio(1); _Pragma("unroll") for (int m = 0; m < 4; ++m) _Pragma("unroll") for (int n = 0; n < 2; ++n) _Pragma("unroll") for (int k = 0; k < 2; ++k) \
        acc[ai][bj][m][n] = __builtin_amdgcn_mfma_f32_16x16x32_bf16(Bt[n][k], At[m][k], acc[ai][bj][m][n], 0, 0, 0); __builtin_amdgcn_s_setprio(0); } while (0)
#define PG8_WAIT_V(n) asm volatile("s_waitcnt vmcnt(" #n ")" ::: "memory")
#define PG8_WAIT_L(n) asm volatile("s_waitcnt lgkmcnt(" #n ")" ::: "memory")
#define PG8_BAR __builtin_amdgcn_s_barrier()
#define PG8_SCHED __builtin_amdgcn_sched_barrier(0)
    auto nextu = [&](int i, Unit& u) -> bool { if (g.pairmode) { if (i >= 2) return false; u.pm = (int)blockIdx.x >> 2; u.pn = ((int)blockIdx.x & 3) + 4 * i; return true; } return S.next(i, u); };
    Unit cur, nxt; int ui = 0;
    if (!nextu(0, cur)) return;
    f32x4 acc[2][2][4][2];
#pragma unroll
    for (int a = 0; a < 2; ++a)
#pragma unroll
        for (int b = 0; b < 2; ++b)
#pragma unroll
            for (int m = 0; m < 4; ++m)
#pragma unroll
                for (int n = 0; n < 2; ++n) acc[a][b][m][n] = (f32x4){0.f, 0.f, 0.f, 0.f};
    bf16x8 At[4][2], B0[2][2], B1[2][2];
    const char* cA = (const char*)g.A + (size_t)cur.pm * tstepA + (size_t)((cur.pn & 3) * g.ahead) * 2; const char* cB = (const char*)g.Bt + (size_t)cur.pn * tstepB;
    PG8_STAGE(PG8_SB(0, 0), cB, voffB); PG8_STAGE(PG8_SA(0, 0), cA, voffA); PG8_STAGE(PG8_SB(0, 1), cB + hstepB, voffB); PG8_STAGE(PG8_SA(0, 1), cA + hstepA, voffA);
    if (wr == 1) PG8_BAR;
    PG8_WAIT_V(4); PG8_BAR;
    PG8_STAGE(PG8_SB(1, 0), cB + kstep, voffB); PG8_STAGE(PG8_SA(1, 0), cA + kstep, voffA); PG8_STAGE(PG8_SB(1, 1), cB + hstepB + kstep, voffB);
    PG8_WAIT_V(6); PG8_BAR;
    for (;;) {
        bool has_next; const char* nA; const char* nB;
        if (Epi::DUAL && seg == 0) { has_next = true; nxt = cur; nA = (const char*)g.A2 + (size_t)cur.pm * tstepA; nB = (const char*)g.Bt2 + (size_t)cur.pn * tstepB; }
        else { has_next = nextu(ui + 1, nxt);
            nA = has_next ? (const char*)g.A + (size_t)nxt.pm * tstepA + (size_t)((nxt.pn & 3) * g.ahead) * 2 : cA; nB = has_next ? (const char*)g.Bt + (size_t)nxt.pn * tstepB : cB; }
        for (int t = 0; t < nt; t += 2) {
            const bool last = (t == nt - 2);
            const char* a1 = cA + (size_t)(t + 1) * kstep;
            const char* a2 = last ? nA : cA + (size_t)(t + 2) * kstep; const char* b2 = last ? nB : cB + (size_t)(t + 2) * kstep;
            const char* a3 = a2 + kstep; const char* b3 = b2 + kstep;
            PG8_LDB(B0, 0, 0); PG8_SCHED; PG8_LDA(At, 0, 0); PG8_STAGE(PG8_SA(1, 1), a1 + hstepA, voffA);
            PG8_WAIT_L(8); PG8_BAR; PG8_WAIT_L(0); PG8_MMA(0, 0, At, B0); PG8_BAR; PG8_SCHED;
            PG8_LDB(B1, 0, 1); PG8_STAGE(PG8_SB(0, 0), b2, voffB);
            PG8_BAR; PG8_WAIT_L(0); PG8_MMA(0, 1, At, B1); PG8_BAR;
            PG8_LDA(At, 0, 1); PG8_STAGE(PG8_SA(0, 0), a2, voffA);
            PG8_BAR; PG8_WAIT_L(0); PG8_MMA(1, 0, At, B0); PG8_BAR; PG8_SCHED;
            PG8_STAGE(PG8_SB(0, 1), b2 + hstepB, voffB);
            PG8_WAIT_V(6); PG8_BAR; PG8_MMA(1, 1, At, B1); PG8_BAR;
            PG8_LDB(B0, 1, 0); PG8_SCHED; PG8_LDA(At, 1, 0); PG8_STAGE(PG8_SA(0, 1), a2 + hstepA, voffA);
            PG8_WAIT_L(8); PG8_BAR; PG8_WAIT_L(0); PG8_MMA(0, 0, At, B0); PG8_BAR; PG8_SCHED;
            PG8_LDB(B1, 1, 1); PG8_STAGE(PG8_SB(1, 0), b3, voffB);
            PG8_BAR; PG8_WAIT_L(0); PG8_MMA(0, 1, At, B1); PG8_BAR;
            PG8_LDA(At, 1, 1); PG8_STAGE(PG8_SA(1, 0), a3, voffA);
            PG8_BAR; PG8_WAIT_L(0); PG8_MMA(1, 0, At, B0); PG8_BAR; PG8_SCHED;
            PG8_STAGE(PG8_SB(1, 1), b3 + hstepB, voffB);
            PG8_WAIT_V(6); PG8_BAR; PG8_MMA(1, 1, At, B1); PG8_BAR;
        }
        if constexpr (Epi::DUAL) { if (seg == 0) { E.mid(acc, cur, wr, wc, fr, fq); seg = 1; cA = nA; cB = nB; nt = g.K2 / BK; continue; } }
        E(acc, cur, wr, wc, fr, fq);
        if (Epi::DUAL) { seg = 0; nt = K / BK; }
        if (!has_next) break;
#pragma unroll
        for (int a = 0; a < 2; ++a)
#pragma unroll
            for (int b = 0; b < 2; ++b)
#pragma unroll
                for (int m = 0; m < 4; ++m)
#pragma unroll
                    for (int n = 0; n < 2; ++n) acc[a][b][m][n] = (f32x4){0.f, 0.f, 0.f, 0.f};
        cur = nxt; cA = nA; cB = nB; ++ui;
    }
    PG8_WAIT_V(0);
    if (wr == 0) PG8_BAR;
    PG8_BAR;
#undef PG8_SA
#undef PG8_SB
#undef PG8_STAGE
#undef PG8_LDA
#undef PG8_LDB
#undef PG8_MMA
#undef PG8_WAIT_V
#undef PG8_WAIT_L
#undef PG8_BAR
#undef PG8_SCHED
}

template <int ACT> struct EpiGated {
    static constexpr bool DUAL = false;
    static constexpr bool PERM = true;
    bf16_t* O; int ldo;
    __device__ __forceinline__ void operator()(const f32x4 (&acc)[2][2][4][2], const Unit& u, int wr, int wc, int fr, int fq) const {
        const int row0 = u.pm * BM + wr * 64 + fr, col0 = u.pn * 128 + wc * 32 + 8 * fq;
#pragma unroll
        for (int ai = 0; ai < 2; ++ai)
#pragma unroll
            for (int m = 0; m < 4; ++m) {
                bf16_t* rowp = O + (size_t)(row0 + ai * HALF + m * 16) * ldo + col0;
                float r[8];
#pragma unroll
                for (int n = 0; n < 2; ++n)
#pragma unroll
                    for (int j = 0; j < 4; ++j) { const float a0 = acc[ai][0][m][n][j], a1 = acc[ai][1][m][n][j]; r[n * 4 + j] = ACT == 0 ? siluf_(a0) * a1 : a0 * sigmoidf_(a1); }
                u32x4 o; o.x = cvt_pk_bf16(r[0], r[1]); o.y = cvt_pk_bf16(r[2], r[3]); o.z = cvt_pk_bf16(r[4], r[5]); o.w = cvt_pk_bf16(r[6], r[7]);
                *(u32x4*)rowp = o;
            }
    }
};
struct EpiResid {
    static constexpr bool DUAL = false;
    static constexpr bool PERM = false;
    const float* xin; float* xout; float scale;
    __device__ __forceinline__ void operator()(const f32x4 (&acc)[2][2][4][2], const Unit& u, int wr, int wc, int fr, int fq) const {
        const int row0 = u.pm * BM + wr * 64 + fr, col0 = u.pn * BM + wc * 32 + 4 * fq;
#pragma unroll
        for (int ai = 0; ai < 2; ++ai) {
            f32x4 xv[4][2][2];
#pragma unroll
            for (int m = 0; m < 4; ++m) { const size_t ro = (size_t)(row0 + ai * HALF + m * 16) * DM + col0;
#pragma unroll
                for (int bj = 0; bj < 2; ++bj)
#pragma unroll
                    for (int n = 0; n < 2; ++n) xv[m][bj][n] = *(const f32x4*)(xin + ro + bj * HALF + n * 16); }
            asm volatile("" ::: "memory");
#pragma unroll
            for (int m = 0; m < 4; ++m) { const size_t ro = (size_t)(row0 + ai * HALF + m * 16) * DM + col0;
#pragma unroll
                for (int bj = 0; bj < 2; ++bj)
#pragma unroll
                    for (int n = 0; n < 2; ++n) *(f32x4*)(xout + ro + bj * HALF + n * 16) = xv[m][bj][n] + scale * acc[ai][bj][m][n]; }
            asm volatile("" ::: "memory");
        }
    }
};
struct EpiBf16 {
    static constexpr bool DUAL = false;
    static constexpr bool PERM = true;
    bf16_t* O; bf16_t* O2; int ldo, split; float scale1;
    __device__ __forceinline__ void operator()(const f32x4 (&acc)[2][2][4][2], const Unit& u, int wr, int wc, int fr, int fq) const {
        const int row0 = u.pm * BM + wr * 64 + fr; int pn = u.pn; bf16_t* base = O; float sc = scale1;
        if (pn >= split) { pn -= split; base = O2; sc = 1.0f; }
        const int col0 = pn * BM + wc * 32 + 8 * fq;
#pragma unroll
        for (int ai = 0; ai < 2; ++ai)
#pragma unroll
            for (int m = 0; m < 4; ++m) { bf16_t* rowp = base + (size_t)(row0 + ai * HALF + m * 16) * ldo + col0;
#pragma unroll
                for (int bj = 0; bj < 2; ++bj) { const f32x4 v0 = acc[ai][bj][m][0] * sc, v1 = acc[ai][bj][m][1] * sc;
                    u32x4 o; o.x = cvt_pk_bf16(v0[0], v0[1]); o.y = cvt_pk_bf16(v0[2], v0[3]); o.z = cvt_pk_bf16(v1[0], v1[1]); o.w = cvt_pk_bf16(v1[2], v1[3]);
                    *(u32x4*)(rowp + bj * HALF) = o; } }
    }
};
template <int SECOND> struct EpiMerge {
    static constexpr bool DUAL = false;
    static constexpr bool PERM = true;
    const bf16_t* gate; float* mixacc; bf16_t* mix;
    __device__ __forceinline__ void operator()(const f32x4 (&acc)[2][2][4][2], const Unit& u, int wr, int wc, int fr, int fq) const {
        const int row0 = u.pm * BM + wr * 64 + fr, col0 = u.pn * BM + wc * 32 + 8 * fq;
#pragma unroll
        for (int ai = 0; ai < 2; ++ai)
#pragma unroll
            for (int mp = 0; mp < 2; ++mp) {
                u32x4 gv[2][2]; f32x4 pv[2][2][2];
#pragma unroll
                for (int mi = 0; mi < 2; ++mi)
#pragma unroll
                    for (int bj = 0; bj < 2; ++bj) { const size_t row = (size_t)(row0 + ai * HALF + (mp * 2 + mi) * 16); const int col = col0 + bj * HALF;
                        gv[mi][bj] = *(const u32x4*)(gate + row * NPROJ + col);
                        if (SECOND == 1) { pv[mi][bj][0] = *(const f32x4*)(mixacc + row * DM + col); pv[mi][bj][1] = *(const f32x4*)(mixacc + row * DM + col + 4); } }
                asm volatile("" ::: "memory");
#pragma unroll
                for (int mi = 0; mi < 2; ++mi)
#pragma unroll
                    for (int bj = 0; bj < 2; ++bj) { const int m = mp * 2 + mi; const size_t row = (size_t)(row0 + ai * HALF + m * 16); const int col = col0 + bj * HALF; const u32x4 g4 = gv[mi][bj];
                        float r[8];
                        r[0] = sigmoidf_(bflo(g4.x)) * acc[ai][bj][m][0][0]; r[1] = sigmoidf_(bfhi(g4.x)) * acc[ai][bj][m][0][1];
                        r[2] = sigmoidf_(bflo(g4.y)) * acc[ai][bj][m][0][2]; r[3] = sigmoidf_(bfhi(g4.y)) * acc[ai][bj][m][0][3];
                        r[4] = sigmoidf_(bflo(g4.z)) * acc[ai][bj][m][1][0]; r[5] = sigmoidf_(bfhi(g4.z)) * acc[ai][bj][m][1][1];
                        r[6] = sigmoidf_(bflo(g4.w)) * acc[ai][bj][m][1][2]; r[7] = sigmoidf_(bfhi(g4.w)) * acc[ai][bj][m][1][3];
                        if (SECOND == 0) { float* mp_ = mixacc + row * DM + col; *(f32x4*)mp_ = (f32x4){r[0], r[1], r[2], r[3]}; *(f32x4*)(mp_ + 4) = (f32x4){r[4], r[5], r[6], r[7]}; }
                        else { const f32x4 p0 = pv[mi][bj][0], p1 = pv[mi][bj][1];
                            u32x4 o; o.x = cvt_pk_bf16(r[0] + p0[0], r[1] + p0[1]); o.y = cvt_pk_bf16(r[2] + p0[2], r[3] + p0[3]); o.z = cvt_pk_bf16(r[4] + p1[0], r[5] + p1[1]); o.w = cvt_pk_bf16(r[6] + p1[2], r[7] + p1[3]);
                            *(u32x4*)(mix + row * DM + col) = o; } }
                asm volatile("" ::: "memory");
            }
    }
};
struct EpiMergeDual {
    static constexpr bool PERM = true, DUAL = true;
    const bf16_t* gate1; const bf16_t* gate2; bf16_t* mix;
    static __device__ __forceinline__ float em(float g) { return fminf(__expf(-g), 1e30f); }
    __device__ __forceinline__ void mid(f32x4 (&acc)[2][2][4][2], const Unit& u, int wr, int wc, int fr, int fq) const {
        const int row0 = u.pm * BM + wr * 64 + fr, col0 = u.pn * BM + wc * 32 + 8 * fq;
#pragma unroll
        for (int ai = 0; ai < 2; ++ai)
#pragma unroll
            for (int mp = 0; mp < 2; ++mp) {
                u32x4 g1v[2][2], g2v[2][2];
#pragma unroll
                for (int mi = 0; mi < 2; ++mi)
#pragma unroll
                    for (int bj = 0; bj < 2; ++bj) { const size_t row = (size_t)(row0 + ai * HALF + (mp * 2 + mi) * 16); const int col = col0 + bj * HALF;
                        g1v[mi][bj] = *(const u32x4*)(gate1 + row * NPROJ + col); g2v[mi][bj] = *(const u32x4*)(gate2 + row * NPROJ + col); }
#pragma unroll
                for (int mi = 0; mi < 2; ++mi)
#pragma unroll
                    for (int bj = 0; bj < 2; ++bj) { const int m = mp * 2 + mi; const u32x4 a = g1v[mi][bj], b = g2v[mi][bj];
                        const float ga[8] = {bflo(a.x), bfhi(a.x), bflo(a.y), bfhi(a.y), bflo(a.z), bfhi(a.z), bflo(a.w), bfhi(a.w)};
                        const float gb[8] = {bflo(b.x), bfhi(b.x), bflo(b.y), bfhi(b.y), bflo(b.z), bfhi(b.z), bflo(b.w), bfhi(b.w)};
#pragma unroll
                        for (int j = 0; j < 8; ++j) acc[ai][bj][m][j >> 2][j & 3] *= (1.0f + em(gb[j])) * __builtin_amdgcn_rcpf(1.0f + em(ga[j])); }
            }
    }
    __device__ __forceinline__ void operator()(const f32x4 (&acc)[2][2][4][2], const Unit& u, int wr, int wc, int fr, int fq) const {
        const int row0 = u.pm * BM + wr * 64 + fr, col0 = u.pn * BM + wc * 32 + 8 * fq;
#pragma unroll
        for (int ai = 0; ai < 2; ++ai)
#pragma unroll
            for (int mp = 0; mp < 2; ++mp) {
                u32x4 g2v[2][2];
#pragma unroll
                for (int mi = 0; mi < 2; ++mi)
#pragma unroll
                    for (int bj = 0; bj < 2; ++bj) { const size_t row = (size_t)(row0 + ai * HALF + (mp * 2 + mi) * 16); const int col = col0 + bj * HALF;
                        g2v[mi][bj] = *(const u32x4*)(gate2 + row * NPROJ + col); }
#pragma unroll
                for (int mi = 0; mi < 2; ++mi)
#pragma unroll
                    for (int bj = 0; bj < 2; ++bj) { const int m = mp * 2 + mi; const size_t row = (size_t)(row0 + ai * HALF + m * 16); const int col = col0 + bj * HALF; const u32x4 b = g2v[mi][bj];
                        const float gb[8] = {bflo(b.x), bfhi(b.x), bflo(b.y), bfhi(b.y), bflo(b.z), bfhi(b.z), bflo(b.w), bfhi(b.w)};
                        float r[8];
#pragma unroll
                        for (int j = 0; j < 8; ++j) r[j] = acc[ai][bj][m][j >> 2][j & 3] * __builtin_amdgcn_rcpf(1.0f + em(gb[j]));
                        u32x4 o; o.x = cvt_pk_bf16(r[0], r[1]); o.y = cvt_pk_bf16(r[2], r[3]); o.z = cvt_pk_bf16(r[4], r[5]); o.w = cvt_pk_bf16(r[6], r[7]);
                        *(u32x4*)(mix + row * DM + col) = o; }
            }
    }
};
}

__device__ __forceinline__ void tr_job(const float* W, int K, int ld, int c0, int NC, bf16_t* WT, int rowbase, int rs, LAS float* scr, int gw, int nw, int lane, int ldw = 0) {
    if (ldw == 0) ldw = K;
    const int nblk = NC / 32, nitems = (K / 64) * nblk;
    for (int item = gw; item < nitems; item += nw) {
        const int kb = item / nblk, nb = item % nblk, k0 = 64 * kb, n0 = 32 * nb;
        float wv[32];
#pragma unroll
        for (int i = 0; i < 32; ++i) { const int kk = 2 * i + (lane >> 5); wv[i] = W[(size_t)(k0 + kk) * ld + c0 + n0 + (lane & 31)]; }
#pragma unroll
        for (int i = 0; i < 32; ++i) { const int kk = 2 * i + (lane >> 5); scr[kk * 33 + (lane & 31)] = wv[i]; }
        WAVE_LDS_SYNC();
        const int c = lane & 7;
#pragma unroll
        for (int j = 0; j < 4; ++j) { const int n = (lane >> 3) + 8 * j; const LAS float* s = scr + (8 * c) * 33 + n;
            u32x4 o; o.x = cvt_pk_bf16(s[0 * 33], s[1 * 33]); o.y = cvt_pk_bf16(s[2 * 33], s[3 * 33]); o.z = cvt_pk_bf16(s[4 * 33], s[5 * 33]); o.w = cvt_pk_bf16(s[6 * 33], s[7 * 33]);
            const int nn = n0 + n, drow = rowbase + (nn >> 7) * rs + (nn & 127);
            *(u32x4*)(WT + (size_t)drow * ldw + k0 + 8 * c) = o; }
        WAVE_LDS_SYNC();
    }
}
__device__ __forceinline__ void convert_phase(const KP& p, int l, LAS unsigned char* lds, int mask, int part) {
    const int tid = opaque_tid(); const int wid = tid >> 6, lane = tid & 63;
    if (part && (int)blockIdx.x < 128) return;
    const int nw = part ? ((int)gridDim.x - 128) * 8 : (int)gridDim.x * 8;
    int gw = (part ? (int)blockIdx.x - 128 : (int)blockIdx.x) * 8 + wid;
    if (nw <= 0) return;
    LAS float* scr = (LAS float*)(lds + wid * 8448);
    unsigned char* ws = p.ws;
    const size_t ffw = (size_t)l * 1024 * 2816;
    bf16_t* gu1 = (bf16_t*)(ws + W_GU1); bf16_t* d1 = (bf16_t*)(ws + W_D1);
#define ROT(n) gw = (gw + (n)) % nw
    if (mask & 1) {
        tr_job(p.in[2] + ffw, 1024, 2816, 0, 2816, gu1, 0, 256, scr, gw, nw, lane);
        tr_job(p.in[3] + ffw, 1024, 2816, 0, 2816, gu1, 128, 256, scr, gw, nw, lane);
        tr_job(p.in[4] + ffw, 2816, 1024, 0, 1024, d1, 0, 128, scr, gw, nw, lane);
    }
    if (mask & 4) {
        tr_job(p.in[28] + ffw, 1024, 2816, 0, 2816, (bf16_t*)(ws + W_GU2), 0, 256, scr, gw, nw, lane);
        tr_job(p.in[29] + ffw, 1024, 2816, 0, 2816, (bf16_t*)(ws + W_GU2), 128, 256, scr, gw, nw, lane);
        tr_job(p.in[30] + ffw, 2816, 1024, 0, 1024, (bf16_t*)(ws + W_D2), 0, 128, scr, gw, nw, lane);
    }
    if (mask & 2) {
        tr_job(p.in[6] + (size_t)l * 1024 * INC, 1024, INC, 0, 3584, (bf16_t*)(ws + W_IN), 0, 128, scr, gw, nw, lane);
        tr_job(p.in[6] + (size_t)l * 1024 * INC, 1024, INC, 3592, 2048, (bf16_t*)(ws + W_IN), 3584, 128, scr, gw, nw, lane);
        ROT(768);
        tr_job(p.in[16] + (size_t)l * 512 * 512, 512, 512, 0, 512, (bf16_t*)(ws + W_GLU), 0, 256, scr, gw, nw, lane);
        ROT(128);
        tr_job(p.in[17] + (size_t)l * 512 * 512, 512, 512, 0, 512, (bf16_t*)(ws + W_GLU), 128, 256, scr, gw, nw, lane);
        ROT(128);
        tr_job(p.in[24] + (size_t)l * 512 * 1024, 512, 1024, 0, 1024, (bf16_t*)(ws + W_BS5), 0, 128, scr, gw, nw, lane, 1024);
        ROT(256);
        tr_job(p.in[25] + (size_t)l * 1024 * 1024, 1024, 1024, 0, 1024, (bf16_t*)(ws + W_BML), 0, 128, scr, gw, nw, lane);
        ROT(512);
        tr_job(p.in[26] + (size_t)l * 1024 * 1024, 1024, 1024, 0, 1024, (bf16_t*)(ws + W_OUT), 0, 128, scr, gw, nw, lane);
        ROT(512);
        for (int h = 0; h < 4; ++h) {
            tr_job(p.in[20] + ((size_t)l * 4 + h) * 65536, 256, 256, 0, 256, (bf16_t*)(ws + W_QK), h * 256, 128, scr, gw, nw, lane);
            ROT(32);
            tr_job(p.in[21] + ((size_t)l * 4 + h) * 65536, 256, 256, 0, 256, (bf16_t*)(ws + W_QK), 1024 + h * 256, 128, scr, gw, nw, lane);
            ROT(32);
        }
    }
#undef ROT
}

template <bool WITH_IF>
__device__ __forceinline__ void rmsnorm_phase(const float* x, const float* gain, bf16_t* xn, const float* win_l, const float* bif, float* ifbuf, LAS unsigned char* lds) {
    const int tid = opaque_tid(); const int wid = tid >> 6, lane = tid & 63;
    LAS float* ifw = (LAS float*)lds;
    if (WITH_IF) {
        for (int k = tid; k < 1024; k += 512) { const f32x4 a = *(const f32x4*)(win_l + (size_t)k * INC + 3584), b = *(const f32x4*)(win_l + (size_t)k * INC + 3588);
            *(LAS f32x4*)(ifw + k * 8) = a; *(LAS f32x4*)(ifw + k * 8 + 4) = b; }
        __syncthreads();
    }
    f32x4 gv[4];
#pragma unroll
    for (int i = 0; i < 4; ++i) gv[i] = *(const f32x4*)(gain + 4 * (lane + 64 * i));
    const int nw = gridDim.x * 8;
    constexpr int RPT = WITH_IF ? 4 : 8;
    for (int row0 = blockIdx.x * 8 + wid; row0 < MTOK; row0 += RPT * nw) {
        f32x4 v[RPT][4];
#pragma unroll
        for (int q = 0; q < RPT; ++q) { const int row = (row0 + q * nw < MTOK) ? row0 + q * nw : row0;
#pragma unroll
            for (int i = 0; i < 4; ++i) v[q][i] = *(const f32x4*)(x + (size_t)row * DM + 4 * (lane + 64 * i)); }
        asm volatile("" ::: "memory");
#pragma unroll
        for (int q = 0; q < RPT; ++q) { const int row = row0 + q * nw;
            float ss = 0.f;
#pragma unroll
            for (int i = 0; i < 4; ++i) ss += (v[q][i].x * v[q][i].x + v[q][i].y * v[q][i].y) + (v[q][i].z * v[q][i].z + v[q][i].w * v[q][i].w);
            ss = wave_sum(ss);
            const float r = rsqrtf(ss * (1.0f / DM) + EPS);
            float ga[8];
            if (WITH_IF) {
#pragma unroll
                for (int j = 0; j < 8; ++j) ga[j] = 0.f;
            }
            if (row < MTOK) {
#pragma unroll
                for (int i = 0; i < 4; ++i) { const f32x4 y = v[q][i] * r * gv[i];
                    u32x2 o; o.x = cvt_pk_bf16(y.x, y.y); o.y = cvt_pk_bf16(y.z, y.w);
                    *(u32x2*)(xn + (size_t)row * DM + 4 * (lane + 64 * i)) = o;
                    if (WITH_IF) {
#pragma unroll
                        for (int e = 0; e < 4; ++e) { const int k = 4 * (lane + 64 * i) + e; const f32x4 a = *(LAS f32x4*)(ifw + k * 8), b = *(LAS f32x4*)(ifw + k * 8 + 4); const float xv = y[e];
                            ga[0] += xv * a.x; ga[1] += xv * a.y; ga[2] += xv * a.z; ga[3] += xv * a.w; ga[4] += xv * b.x; ga[5] += xv * b.y; ga[6] += xv * b.z; ga[7] += xv * b.w; }
                        asm volatile("" ::: "memory");
                    }
                }
                if (WITH_IF) {
#pragma unroll
                    for (int j = 0; j < 8; ++j) ga[j] = wave_sum(ga[j]);
                    if (lane == 0) { *(f32x4*)(ifbuf + (size_t)row * 8) = (f32x4){ga[0] + bif[0], ga[1] + bif[1], ga[2] + bif[2], ga[3] + bif[3]};
                        *(f32x4*)(ifbuf + (size_t)row * 8 + 4) = (f32x4){ga[4] + bif[4], ga[5] + bif[5], ga[6] + bif[6], ga[7] + bif[7]}; }
                }
            }
        }
    }
}
__device__ __forceinline__ void final_norm_phase(float* x, const float* gain) {
    const int tid = opaque_tid(); const int wid = tid >> 6, lane = tid & 63;
    f32x4 gv[4];
#pragma unroll
    for (int i = 0; i < 4; ++i) gv[i] = *(const f32x4*)(gain + 4 * (lane + 64 * i));
    for (int row = blockIdx.x * 8 + wid; row < MTOK; row += gridDim.x * 8) {
        float* xr = x + (size_t)row * DM;
        f32x4 v[4]; float ss = 0.f;
#pragma unroll
        for (int i = 0; i < 4; ++i) { v[i] = *(const f32x4*)(xr + 4 * (lane + 64 * i)); ss += (v[i].x * v[i].x + v[i].y * v[i].y) + (v[i].z * v[i].z + v[i].w * v[i].w); }
        ss = wave_sum(ss);
        const float r = rsqrtf(ss * (1.0f / DM) + EPS);
#pragma unroll
        for (int i = 0; i < 4; ++i) *(f32x4*)(xr + 4 * (lane + 64 * i)) = v[i] * r * gv[i];
    }
}

__device__ __forceinline__ void conv_phase(const KP& p, int l) {
    const bf16_t* proj = (const bf16_t*)(p.ws + O_BIG); bf16_t* xc = (bf16_t*)(p.ws + O_XC);
    const int gt = blockIdx.x * 512 + opaque_tid(), c8 = gt & 127;
    const float* cw = p.in[18] + (size_t)l * 4 * 1024 + c8 * 8; const float* cb = p.in[19] + (size_t)l * 1024 + c8 * 8;
    float w[4][8], bias[8];
#pragma unroll
    for (int j = 0; j < 4; ++j) { const f32x4 a = *(const f32x4*)(cw + j * 1024), b = *(const f32x4*)(cw + j * 1024 + 4); w[j][0] = a.x; w[j][1] = a.y; w[j][2] = a.z; w[j][3] = a.w; w[j][4] = b.x; w[j][5] = b.y; w[j][6] = b.z; w[j][7] = b.w; }
    { const f32x4 a = *(const f32x4*)cb, b = *(const f32x4*)(cb + 4); bias[0] = a.x; bias[1] = a.y; bias[2] = a.z; bias[3] = a.w; bias[4] = b.x; bias[5] = b.y; bias[6] = b.z; bias[7] = b.w; }
    const int nthr = gridDim.x * 512;
    for (int idx0 = gt; idx0 < MTOK * 128; idx0 += 4 * nthr) {
        u32x4 v[4][4];
#pragma unroll
        for (int q = 0; q < 4; ++q) { const int idx = idx0 + q * nthr; const int t = idx >> 7, pos = t & (SEQ - 1);
#pragma unroll
            for (int j = 0; j < 4; ++j) { v[q][j] = (u32x4){0u, 0u, 0u, 0u}; if (idx < MTOK * 128 && pos - 3 + j >= 0) v[q][j] = *(const u32x4*)(proj + (size_t)(t - 3 + j) * NPROJ + 512 + c8 * 8); } }
        asm volatile("" ::: "memory");
#pragma unroll
        for (int q = 0; q < 4; ++q) { const int idx = idx0 + q * nthr; const int t = idx >> 7;
            float y[8];
#pragma unroll
            for (int e = 0; e < 8; ++e) y[e] = bias[e];
#pragma unroll
            for (int j = 0; j < 4; ++j) { const u32x4 vv = v[q][j];
                y[0] += w[j][0] * bflo(vv.x); y[1] += w[j][1] * bfhi(vv.x); y[2] += w[j][2] * bflo(vv.y); y[3] += w[j][3] * bfhi(vv.y);
                y[4] += w[j][4] * bflo(vv.z); y[5] += w[j][5] * bfhi(vv.z); y[6] += w[j][6] * bflo(vv.w); y[7] += w[j][7] * bfhi(vv.w); }
            u32x4 o; o.x = cvt_pk_bf16(siluf_(y[0]), siluf_(y[1])); o.y = cvt_pk_bf16(siluf_(y[2]), siluf_(y[3])); o.z = cvt_pk_bf16(siluf_(y[4]), siluf_(y[5])); o.w = cvt_pk_bf16(siluf_(y[6]), siluf_(y[7]));
            if (idx < MTOK * 128) *(u32x4*)(xc + (size_t)t * DM + c8 * 8) = o; }
    }
}

__device__ __forceinline__ void conv_slice(const KP& p, int l, int pm, int head) {
    const bf16_t* proj = (const bf16_t*)(p.ws + O_BIG); bf16_t* xc = (bf16_t*)(p.ws + O_XC);
    const int tid = opaque_tid(); const int c8 = head * 32 + (tid & 31), rsub = tid >> 5;
    const float* cw = p.in[18] + (size_t)l * 4 * 1024 + c8 * 8; const float* cb = p.in[19] + (size_t)l * 1024 + c8 * 8;
    float w[4][8], bias[8];
#pragma unroll
    for (int j = 0; j < 4; ++j) { const f32x4 a = *(const f32x4*)(cw + j * 1024), b = *(const f32x4*)(cw + j * 1024 + 4); w[j][0] = a.x; w[j][1] = a.y; w[j][2] = a.z; w[j][3] = a.w; w[j][4] = b.x; w[j][5] = b.y; w[j][6] = b.z; w[j][7] = b.w; }
    { const f32x4 a = *(const f32x4*)cb, b = *(const f32x4*)(cb + 4); bias[0] = a.x; bias[1] = a.y; bias[2] = a.z; bias[3] = a.w; bias[4] = b.x; bias[5] = b.y; bias[6] = b.z; bias[7] = b.w; }
    for (int j0 = 0; j0 < 16; j0 += 4) {
        u32x4 v[4][4];
#pragma unroll
        for (int q = 0; q < 4; ++q) { const int t = pm * 256 + rsub + 16 * (j0 + q), pos = t & (SEQ - 1);
#pragma unroll
            for (int j = 0; j < 4; ++j) { v[q][j] = (u32x4){0u, 0u, 0u, 0u}; if (pos - 3 + j >= 0) v[q][j] = *(const u32x4*)(proj + (size_t)(t - 3 + j) * NPROJ + 512 + c8 * 8); } }
        asm volatile("" ::: "memory");
#pragma unroll
        for (int q = 0; q < 4; ++q) { const int t = pm * 256 + rsub + 16 * (j0 + q);
            float y[8];
#pragma unroll
            for (int e = 0; e < 8; ++e) y[e] = bias[e];
#pragma unroll
            for (int j = 0; j < 4; ++j) { const u32x4 vv = v[q][j];
                y[0] += w[j][0] * bflo(vv.x); y[1] += w[j][1] * bfhi(vv.x); y[2] += w[j][2] * bflo(vv.y); y[3] += w[j][3] * bfhi(vv.y);
                y[4] += w[j][4] * bflo(vv.z); y[5] += w[j][5] * bfhi(vv.z); y[6] += w[j][6] * bflo(vv.w); y[7] += w[j][7] * bfhi(vv.w); }
            u32x4 o; o.x = cvt_pk_bf16(siluf_(y[0]), siluf_(y[1])); o.y = cvt_pk_bf16(siluf_(y[2]), siluf_(y[3])); o.z = cvt_pk_bf16(siluf_(y[4]), siluf_(y[5])); o.w = cvt_pk_bf16(siluf_(y[6]), siluf_(y[7]));
            *(u32x4*)(xc + (size_t)t * DM + c8 * 8) = o; }
    }
}

template <bool PASSC>
__device__ __forceinline__ void s5_phase(const KP& p, int l, LAS unsigned char* lds) {
    const int tid = opaque_tid(); const int wid = tid >> 6, lane = tid & 63, fr = lane & 15, fq = lane >> 4;
    LAS float* buS = (LAS float*)(lds + wid * 12800);
    LAS unsigned char* sS = lds + wid * 12800 + 8448;
    const bf16_t* proj = (const bf16_t*)(p.ws + O_BIG); bf16_t* z = (bf16_t*)(p.ws + O_Z);
    f32x2* s5end = (f32x2*)(p.ws + O_S5END);
    for (int task = blockIdx.x * 8 + wid; task < 2048; task += gridDim.x * 8) {
        const int seq = task >> 5, c = task & 31, b = seq >> 5, g = seq & 31, n = lane, lg = l * 32 + g;
        const float dt = expf(p.in[10][lg]);
        float ar, ai;
        { const float lr = fminf(p.in[8][lg * 64 + n], -1e-4f), li = p.in[9][lg * 64 + n];
          const float mag = expf(lr * dt); float sn, cs; sincos_acc(li * dt, sn, cs); ar = mag * cs; ai = mag * sn; }
        bf16x8 bx[8];
#pragma unroll
        for (int q4 = 0; q4 < 4; ++q4) { const int n2 = q4 * 16 + fr;
            const float lr = fminf(p.in[8][lg * 64 + n2], -1e-4f), li = p.in[9][lg * 64 + n2];
            const float mag = expf(lr * dt); float sn, cs; sincos_acc(li * dt, sn, cs);
            const float a_r = mag * cs, a_i = mag * sn, den = lr * lr + li * li;
            float qr = ((a_r - 1.0f) * lr + a_i * li) / den, qi = (a_i * lr - (a_r - 1.0f) * li) / den;
            if (fq >= 2) { qr = 0.f; qi = 0.f; }
            const float* brp = p.in[11] + (size_t)(lg * 64 + n2) * 16 + (fq & 1) * 8; const float* bip = p.in[12] + (size_t)(lg * 64 + n2) * 16 + (fq & 1) * 8;
            const f32x4 br0 = *(const f32x4*)brp, br1 = *(const f32x4*)(brp + 4), bi0 = *(const f32x4*)bip, bi1 = *(const f32x4*)(bip + 4);
            const f32x4 re0 = qr * br0 - qi * bi0, re1 = qr * br1 - qi * bi1, im0 = qr * bi0 + qi * br0, im1 = qr * bi1 + qi * br1;
            u32x4 o; o.x = cvt_pk_bf16(re0.x, re0.y); o.y = cvt_pk_bf16(re0.z, re0.w); o.z = cvt_pk_bf16(re1.x, re1.y); o.w = cvt_pk_bf16(re1.z, re1.w);
            bx[q4] = __builtin_bit_cast(bf16x8, o);
            o.x = cvt_pk_bf16(im0.x, im0.y); o.y = cvt_pk_bf16(im0.z, im0.w); o.z = cvt_pk_bf16(im1.x, im1.y); o.w = cvt_pk_bf16(im1.z, im1.w);
            bx[4 + q4] = __builtin_bit_cast(bf16x8, o); }
        float sr = 0.f, si = 0.f;
        bf16x8 cm[4]; f32x4 d4 = (f32x4){0.f, 0.f, 0.f, 0.f};
        if (PASSC) {
            float xr = ar, xi = ai;
#pragma unroll
            for (int q = 0; q < 8; ++q) { const float t0 = xr * xr - xi * xi, t1 = 2.0f * xr * xi; xr = t0; xi = t1; }
            for (int c0 = 0; c0 < c; c0 += 16) {
                f32x2 ev[16];
#pragma unroll
                for (int j = 0; j < 16; ++j) { const int cc = (c0 + j < c) ? c0 + j : c - 1; ev[j] = s5end[(size_t)(seq * 32 + cc) * 64 + n]; }
#pragma unroll
                for (int j = 0; j < 16; ++j) { const bool on = c0 + j < c; const float t0 = sr * xr - si * xi + ev[j].x, t1 = sr * xi + si * xr + ev[j].y; sr = on ? t0 : sr; si = on ? t1 : si; }
            }
#pragma unroll
            for (int kb = 0; kb < 4; ++kb) { const float* src = (kb < 2 ? p.in[13] : p.in[14]) + (size_t)(lg * 16 + fr) * 64 + (kb & 1) * 32 + fq * 8;
                const f32x4 a = *(const f32x4*)src, bq = *(const f32x4*)(src + 4); const float sg = kb < 2 ? 1.0f : -1.0f;
                u32x4 o; o.x = cvt_pk_bf16(sg * a.x, sg * a.y); o.y = cvt_pk_bf16(sg * a.z, sg * a.w); o.z = cvt_pk_bf16(sg * bq.x, sg * bq.y); o.w = cvt_pk_bf16(sg * bq.z, sg * bq.w);
                cm[kb] = __builtin_bit_cast(bf16x8, o); }
            d4 = *(const f32x4*)(p.in[15] + (size_t)l * 512 + g * 16 + fq * 4);
        }
        const int tok0 = b * SEQ + c * 256;
        const bf16_t* urow0 = proj + (size_t)(tok0 + fr) * NPROJ + g * 16;
        u32x4 unext = *(const u32x4*)(urow0 + (fq & 1) * 8); u32x2 u4next = *(const u32x2*)(urow0 + fq * 4);
        for (int sub = 0; sub < 16; ++sub) {
            u32x4 uraw = unext; const u32x2 u4 = u4next;
            if (sub < 15) { const bf16_t* urow = urow0 + (size_t)(sub + 1) * 16 * NPROJ; unext = *(const u32x4*)(urow + (fq & 1) * 8); u4next = *(const u32x2*)(urow + fq * 4); }
            if (fq >= 2) uraw = (u32x4){0u, 0u, 0u, 0u};
            const bf16x8 yu = __builtin_bit_cast(bf16x8, uraw);
#pragma unroll
            for (int kb = 0; kb < 8; ++kb) { const f32x4 acc = __builtin_amdgcn_mfma_f32_16x16x32_bf16(bx[kb], yu, (f32x4){0.f, 0.f, 0.f, 0.f}, 0, 0, 0);
                *(LAS f32x4*)(buS + fr * 132 + kb * 16 + fq * 4) = acc; }
            WAVE_LDS_SYNC();
            float burv[16], buiv[16];
#pragma unroll
            for (int tt = 0; tt < 16; ++tt) { burv[tt] = buS[tt * 132 + n]; buiv[tt] = buS[tt * 132 + 64 + n]; }
#pragma unroll
            for (int tt = 0; tt < 16; ++tt) {
                const float bur = burv[tt], bui = buiv[tt];
                const float t0 = ar * sr - ai * si + bur, t1 = ar * si + ai * sr + bui; sr = t0; si = t1;
                if (PASSC) { const unsigned pk = cvt_pk_bf16(sr, si); *(LAS unsigned short*)(sS + tt * 272 + n * 2) = (unsigned short)(pk & 0xffffu); *(LAS unsigned short*)(sS + tt * 272 + 128 + n * 2) = (unsigned short)(pk >> 16); }
            }
            if (PASSC) {
                WAVE_LDS_SYNC();
                f32x4 acc = (f32x4){0.f, 0.f, 0.f, 0.f};
#pragma unroll
                for (int kb = 0; kb < 4; ++kb) { const bf16x8 yf = *(LAS bf16x8*)(sS + fr * 272 + (kb * 32 + fq * 8) * 2); acc = __builtin_amdgcn_mfma_f32_16x16x32_bf16(cm[kb], yf, acc, 0, 0, 0); }
                const f32x4 uv = (f32x4){bflo(u4.x), bfhi(u4.x), bflo(u4.y), bfhi(u4.y)};
                const f32x4 y = acc + d4 * uv;
                u32x2 o; o.x = cvt_pk_bf16(gelu_tanh(y.x), gelu_tanh(y.y)); o.y = cvt_pk_bf16(gelu_tanh(y.z), gelu_tanh(y.w));
                *(u32x2*)(z + (size_t)(tok0 + sub * 16 + fr) * 512 + g * 16 + fq * 4) = o;
            }
            WAVE_LDS_SYNC();
        }
        if (!PASSC) s5end[(size_t)(seq * 32 + c) * 64 + n] = (f32x2){sr, si};
    }
}

__device__ __forceinline__ float scan_sum128(float v, int tid, LAS float* tmp) {
    const int lane = tid & 63; float x = v;
#pragma unroll
    for (int o = 1; o < 64; o <<= 1) { const float y = __shfl_up(x, o); if (lane >= o) x += y; }
    if (tid == 63) tmp[0] = x;
    __syncthreads();
    if (tid >= 64 && tid < 128) x += tmp[0];
    return x;
}
__device__ __forceinline__ float scan_max128(float v, int tid, LAS float* tmp) {
    const int lane = tid & 63; float x = v;
#pragma unroll
    for (int o = 1; o < 64; o <<= 1) { const float y = __shfl_up(x, o); if (lane >= o) x = fmaxf(x, y); }
    if (tid == 63) tmp[1] = x;
    __syncthreads();
    if (tid >= 64 && tid < 128) x = fmaxf(x, tmp[1]);
    return x;
}
__device__ __forceinline__ bf16x8 tr_frag(LAS unsigned char* a0, int second_off) {
    const s16x4 lo = __builtin_amdgcn_ds_read_tr16_b64_v4i16((LAS s16x4*)a0);
    const s16x4 hi = __builtin_amdgcn_ds_read_tr16_b64_v4i16((LAS s16x4*)(a0 + second_off));
    return __builtin_shufflevector(lo, hi, 0, 1, 2, 3, 4, 5, 6, 7);
}
template <bool OWN> __device__ __forceinline__ void mlstm_s1_phase(const KP& p, LAS unsigned char* lds) {
    const int tid = opaque_tid(), wid = tid >> 6, lane = tid & 63, fr = lane & 15, fq = lane >> 4;
    const bf16_t* proj = (const bf16_t*)(p.ws + O_BIG); const bf16_t* kbuf = (const bf16_t*)(p.ws + O_K);
    const float* ifb = (const float*)(p.ws + O_IF); bf16_t* cst = (bf16_t*)(p.ws + O_CST);
    float* gout = (float*)(p.ws + O_G); float* mlout = (float*)(p.ws + O_MLOC); float* nloc = (float*)(p.ws + O_NLOC);
    LAS unsigned char* Ks = lds; LAS unsigned char* Vs = lds + 69632;
    LAS float* vlf = (LAS float*)(lds + VEC_OFF); LAS float* vi = vlf + 128; LAS float* vb = vlf + 256; LAS float* vdec = vlf + 384;
    const int own_pm = (int)blockIdx.x >> 2, own_bhc0 = (((own_pm >> 5) * 4 + ((int)blockIdx.x & 3)) * 64) + (own_pm & 31) * 2;
    for (int tk = OWN ? 0 : (int)blockIdx.x; tk < (OWN ? 4 : 1024); tk += OWN ? 1 : (int)gridDim.x) {
        const int task = OWN ? (((own_bhc0 + (tk >> 1)) << 1) | (tk & 1)) : tk;
        const int eh = task & 1, bhc = task >> 1, c = bhc & 63, bh = bhc >> 6, h = bh & 3, b = bh >> 2;
        const int tok0 = b * SEQ + c * 128;
        const bool newk = !OWN || eh == 0;
        u32x4 kv[8], vv[4];
        if (newk) {
#pragma unroll
            for (int it = 0; it < 8; ++it) { const int id = it * 512 + tid, s = id >> 5, ch = id & 31; kv[it] = *(const u32x4*)(kbuf + (unsigned)(tok0 + s) * DM + h * 256 + ch * 8); }
        }
#pragma unroll
        for (int it = 0; it < 4; ++it) { const int id = it * 512 + tid, s = id >> 4, ch = id & 15; vv[it] = *(const u32x4*)(proj + (unsigned)(tok0 + s) * NPROJ + 1536 + h * 256 + eh * 128 + ch * 8); }
        LAS float* tmp = vlf;
        float gg = 0.f, mloc = 0.f;
        if (newk) {
        float gi = 0.f, glf = 0.f;
        if (tid < 128) { gi = ifb[(size_t)(tok0 + tid) * 8 + h]; glf = logsigmoidf_(ifb[(size_t)(tok0 + tid) * 8 + 4 + h]); }
        const float bsum = scan_sum128(glf, tid, tmp);
        if (tid == 127) tmp[2] = bsum;
        __syncthreads();
        gg = tmp[2];
        float dec = -INFINITY;
        if (tid < 128) { dec = gg - bsum + gi; vdec[tid] = dec; }
        { float x = dec;
#pragma unroll
          for (int o = 1; o < 64; o <<= 1) x = fmaxf(x, __shfl_xor(x, o));
          if (lane == 0 && wid < 2) tmp[4 + wid] = x; }
        __syncthreads();
        mloc = fmaxf(tmp[4], tmp[5]);
        asm volatile("" ::: "memory");
#pragma unroll
        for (int it = 0; it < 8; ++it) { const int id = it * 512 + tid, s = id >> 5, ch = id & 31;
            const u32x4 v = kv[it]; const float w = __expf(vdec[s] - mloc);
            u32x4 o; o.x = cvt_pk_bf16(bflo(v.x) * w, bfhi(v.x) * w); o.y = cvt_pk_bf16(bflo(v.y) * w, bfhi(v.y) * w); o.z = cvt_pk_bf16(bflo(v.z) * w, bfhi(v.z) * w); o.w = cvt_pk_bf16(bflo(v.w) * w, bfhi(v.w) * w);
            *(LAS u32x4*)(Ks + s * 544 + ch * 16) = o; }
        }
#pragma unroll
        for (int it = 0; it < 4; ++it) { const int id = it * 512 + tid, s = id >> 4, ch = id & 15;
            *(LAS u32x4*)(Vs + s * 288 + ch * 16) = vv[it]; }
        __syncthreads();
        f32x4 acc[2][8];
#pragma unroll
        for (int a = 0; a < 2; ++a)
#pragma unroll
            for (int e = 0; e < 8; ++e) acc[a][e] = (f32x4){0.f, 0.f, 0.f, 0.f};
#pragma unroll
        for (int kb = 0; kb < 4; ++kb) {
            bf16x8 X[2];
#pragma unroll
            for (int db = 0; db < 2; ++db) X[db] = tr_frag(Ks + (kb * 32 + fq * 4 + (fr >> 2)) * 544 + (32 * wid + db * 16 + (fr & 3) * 4) * 2, 16 * 544);
#pragma unroll
            for (int eb = 0; eb < 8; ++eb) { const bf16x8 Y = tr_frag(Vs + (kb * 32 + fq * 4 + (fr >> 2)) * 288 + (eb * 16 + (fr & 3) * 4) * 2, 16 * 288);
#pragma unroll
                for (int db = 0; db < 2; ++db) acc[db][eb] = __builtin_amdgcn_mfma_f32_16x16x32_bf16(X[db], Y, acc[db][eb], 0, 0, 0); }
        }
#pragma unroll
        for (int db = 0; db < 2; ++db)
#pragma unroll
            for (int eb = 0; eb < 8; ++eb) { u32x2 o; o.x = cvt_pk_bf16(acc[db][eb][0], acc[db][eb][1]); o.y = cvt_pk_bf16(acc[db][eb][2], acc[db][eb][3]);
                *(u32x2*)(cst + (size_t)bhc * 65536 + (size_t)(eh * 128 + eb * 16 + fr) * 256 + 32 * wid + db * 16 + fq * 4) = o; }
        if (eh == 0) {
            if (tid < 256) { float sn = 0.f;
                for (int s0 = 0; s0 < 128; s0 += 16) { unsigned short tv[16];
#pragma unroll
                    for (int j = 0; j < 16; ++j) tv[j] = *(LAS unsigned short*)(Ks + (s0 + j) * 544 + tid * 2);
#pragma unroll
                    for (int j = 0; j < 16; ++j) sn += bflo((unsigned)tv[j]); }
                nloc[(size_t)bhc * 256 + tid] = sn; }
            if (tid == 0) { gout[bhc] = gg; mlout[bhc] = mloc; }
        }
        __syncthreads();
    }
}
__device__ __forceinline__ void mlstm_s2_phase(const KP& p) {
    const int tid = opaque_tid();
    bf16_t* cst = (bf16_t*)(p.ws + O_CST);
    const float* gin = (const float*)(p.ws + O_G); const float* mlin = (const float*)(p.ws + O_MLOC); float* mst = (float*)(p.ws + O_MST);
    const float* nloc = (const float*)(p.ws + O_NLOC); float* nst = (float*)(p.ws + O_NST);
    for (int slot = blockIdx.x; slot < 256; slot += gridDim.x) {
        const int bh = slot >> 5, part = slot & 31; const size_t e0 = (size_t)(part * 512 + tid) * 4;
        float m = 0.f, C0 = 0.f, C1 = 0.f, C2 = 0.f, C3 = 0.f, nv = 0.f;
        const bool do_n = (part == 0) && (tid < 256);
        for (int c8 = 0; c8 < 64; c8 += 8) {
            u32x2 loc[8]; float nl[8];
#pragma unroll
            for (int j = 0; j < 8; ++j) { loc[j] = *(const u32x2*)(cst + (size_t)(bh * 64 + c8 + j) * 65536 + e0); nl[j] = do_n ? nloc[(size_t)(bh * 64 + c8 + j) * 256 + tid] : 0.f; }
#pragma unroll
            for (int j = 0; j < 8; ++j) { const int idx = bh * 64 + c8 + j;
                const float g = gin[idx], ml = mlin[idx]; const float mnew = fmaxf(g + m, ml); const float wo = __expf(g + m - mnew), wl = __expf(ml - mnew);
                u32x2 o; o.x = cvt_pk_bf16(C0, C1); o.y = cvt_pk_bf16(C2, C3);
                *(u32x2*)(cst + (size_t)idx * 65536 + e0) = o;
                C0 = wo * C0 + wl * bflo(loc[j].x); C1 = wo * C1 + wl * bfhi(loc[j].x); C2 = wo * C2 + wl * bflo(loc[j].y); C3 = wo * C3 + wl * bfhi(loc[j].y);
                if (do_n) { nst[(size_t)idx * 256 + tid] = nv; nv = wo * nv + wl * nl[j]; if (tid == 0) mst[idx] = m; }
                m = mnew; }
        }
    }
}
__device__ __forceinline__ void mlstm_s3_phase(const KP& p, int l, LAS unsigned char* lds) {
    const int tid = opaque_tid(), wid = tid >> 6, lane = tid & 63, fr = lane & 15, fq = lane >> 4;
    const bf16_t* proj = (const bf16_t*)(p.ws + O_BIG); const bf16_t* qbuf = (const bf16_t*)(p.ws + O_Q); const bf16_t* kbuf = (const bf16_t*)(p.ws + O_K);
    const bf16_t* xc = (const bf16_t*)(p.ws + O_XC); const float* ifb = (const float*)(p.ws + O_IF); const bf16_t* cst = (const bf16_t*)(p.ws + O_CST);
    const float* mst = (const float*)(p.ws + O_MST); const float* nst = (const float*)(p.ws + O_NST); bf16_t* yml = (bf16_t*)(p.ws + O_XN);
    const float* normg = p.in[22] + (unsigned)l * 1024; const float* skipg = p.in[23] + (unsigned)l * 1024;
    LAS unsigned char* Vh = lds;
    LAS unsigned char* Qs = lds + 36864;
    LAS unsigned char* Kt = lds + 55296;
    LAS unsigned char* CTs = lds + 73728;
    LAS unsigned char* Ss = lds + 92160;
    LAS float* vlf = (LAS float*)(lds + VEC_OFF); LAS float* va = vlf + 128; LAS float* vb = vlf + 256; LAS float* vM = vlf + 384; LAS float* nvec = vlf + 512; LAS float* ngs = vlf + 768; LAS float* sks = vlf + 1024;
    for (int task = blockIdx.x; task < 512; task += gridDim.x) {
        const int bhc = task, c = bhc & 63, bh = bhc >> 6, h = bh & 3, b = bh >> 2;
        const int tok0 = b * SEQ + c * 128;
        u32x4 pq[2], pk[2], pc[2];
#define S3_LOAD(EH, DB) do { _Pragma("unroll") for (int it = 0; it < 2; ++it) { const int id = it * 512 + tid, row = id >> 3, ch = id & 7; \
                    pq[it] = *(const u32x4*)(qbuf + (unsigned)(tok0 + row) * DM + h * 256 + (DB) * 64 + ch * 8); \
                    if ((EH) == 0) pk[it] = *(const u32x4*)(kbuf + (unsigned)(tok0 + row) * DM + h * 256 + (DB) * 64 + ch * 8); \
                    pc[it] = *(const u32x4*)(cst + (unsigned)bhc * 65536 + (unsigned)((EH) * 128 + row) * 256 + (DB) * 64 + ch * 8); } } while (0)
        S3_LOAD(0, 0);
        const float m0 = mst[bhc];
        float gi = 0.f, glf = 0.f;
        if (tid < 128) { gi = ifb[(unsigned)(tok0 + tid) * 8 + h]; glf = logsigmoidf_(ifb[(unsigned)(tok0 + tid) * 8 + 4 + h]); }
        if (tid < 256) { nvec[tid] = nst[(unsigned)bhc * 256 + tid]; ngs[tid] = normg[h * 256 + tid]; sks[tid] = skipg[h * 256 + tid]; }
        const float bs = scan_sum128(glf, tid, vlf);
        const float av = (tid < 128) ? gi - bs : -INFINITY;
        const float mm = scan_max128(av, tid, vlf);
        if (tid < 128) { vb[tid] = bs; va[tid] = av; vM[tid] = fmaxf(m0, mm); }
        const int t = 16 * wid + fr;
        const unsigned tok = (unsigned)(tok0 + t);
        u32x2 hc0[8];
        float qn = 0.f, ss = 0.f, inv = 0.f, winter = 0.f;
#pragma unroll
        for (int eh = 0; eh < 2; ++eh) {
            f32x4 accS[8], accO[8];
#pragma unroll
            for (int i = 0; i < 8; ++i) { accS[i] = (f32x4){0.f, 0.f, 0.f, 0.f}; accO[i] = (f32x4){0.f, 0.f, 0.f, 0.f}; }
            if (eh == 1) S3_LOAD(1, 0);
            for (int db4 = 0; db4 < 4; ++db4) {
                __syncthreads();
#pragma unroll
                for (int it = 0; it < 2; ++it) { const int id = it * 512 + tid, row = id >> 3, ch = id & 7;
                    *(LAS u32x4*)(Qs + row * 144 + ch * 16) = pq[it];
                    if (eh == 0) *(LAS u32x4*)(Kt + row * 144 + ch * 16) = pk[it];
                    *(LAS u32x4*)(CTs + row * 144 + ch * 16) = pc[it]; }
                if (db4 < 3) S3_LOAD(eh, db4 + 1);
                __syncthreads();
#pragma unroll
                for (int kk = 0; kk < 2; ++kk) {
                    const bf16x8 Qf = *(LAS bf16x8*)(Qs + (16 * wid + fr) * 144 + (kk * 32 + fq * 8) * 2);
                    if (eh == 0) {
                        const u32x4 qu = __builtin_bit_cast(u32x4, Qf); const LAS float* nvp = nvec + db4 * 64 + kk * 32 + fq * 8; const f32x4 n0 = *(LAS f32x4*)nvp, n1 = *(LAS f32x4*)(nvp + 4);
                        qn += bflo(qu.x) * n0.x + bfhi(qu.x) * n0.y + bflo(qu.y) * n0.z + bfhi(qu.y) * n0.w + bflo(qu.z) * n1.x + bfhi(qu.z) * n1.y + bflo(qu.w) * n1.z + bfhi(qu.w) * n1.w;
#pragma unroll
                        for (int sb = 0; sb < 8; ++sb) { if (sb <= wid) { const bf16x8 Kf = *(LAS bf16x8*)(Kt + (sb * 16 + fr) * 144 + (kk * 32 + fq * 8) * 2); accS[sb] = __builtin_amdgcn_mfma_f32_16x16x32_bf16(Kf, Qf, accS[sb], 0, 0, 0); } if ((sb & 3) == 3) { asm volatile("" ::: "memory"); __builtin_amdgcn_sched_barrier(0); } }
                    }
#pragma unroll
                    for (int eb = 0; eb < 8; ++eb) { const bf16x8 Cf = *(LAS bf16x8*)(CTs + (eb * 16 + fr) * 144 + (kk * 32 + fq * 8) * 2); accO[eb] = __builtin_amdgcn_mfma_f32_16x16x32_bf16(Cf, Qf, accO[eb], 0, 0, 0); if ((eb & 3) == 3) { asm volatile("" ::: "memory"); __builtin_amdgcn_sched_barrier(0); } }
                }
            }
            u32x4 vt[4];
#pragma unroll
            for (int it = 0; it < 4; ++it) { const int id = it * 512 + tid, s = id >> 4, ch = id & 15; vt[it] = *(const u32x4*)(proj + (unsigned)(tok0 + s) * NPROJ + 1536 + h * 256 + eh * 128 + ch * 8); }
            asm volatile("" ::: "memory");
#pragma unroll
            for (int it = 0; it < 4; ++it) { const int id = it * 512 + tid, s = id >> 4, ch = id & 15; *(LAS u32x4*)(Vh + s * 288 + ch * 16) = vt[it]; }
            if (eh == 0) {
                const float Mt = vM[t]; winter = __expf(m0 - Mt);
                float rowsum = 0.f;
#pragma unroll
                for (int sb = 0; sb < 8; ++sb) if (sb <= (wid | 1)) {
                    const f32x4 a4 = *(LAS f32x4*)(va + sb * 16 + fq * 4);
                    float sv[4];
#pragma unroll
                    for (int j = 0; j < 4; ++j) { const int s = sb * 16 + fq * 4 + j; const float v0 = accS[sb][j] * __expf(fminf(a4[j] - Mt, 0.f)); const float v = (s <= t) ? v0 : 0.f; sv[j] = v; rowsum += v; }
                    u32x2 o; o.x = cvt_pk_bf16(sv[0], sv[1]); o.y = cvt_pk_bf16(sv[2], sv[3]);
                    *(LAS u32x2*)(Ss + t * 272 + (sb * 16 + fq * 4) * 2) = o;
                }
                rowsum += __shfl_xor(rowsum, 16); rowsum += __shfl_xor(rowsum, 32);
                qn += __shfl_xor(qn, 16); qn += __shfl_xor(qn, 32);
                const float den = winter * qn + rowsum, mt = vb[t] + Mt;
                inv = 1.0f / fmaxf(fabsf(den), __expf(-mt));
            }
#pragma unroll
            for (int eb = 0; eb < 8; ++eb) accO[eb] = accO[eb] * winter;
            __syncthreads();
            for (int kb = 0; kb <= (wid >> 1); ++kb) {
                const s16x4 s0 = *(LAS s16x4*)(Ss + t * 272 + (kb * 32 + fq * 4) * 2), s1 = *(LAS s16x4*)(Ss + t * 272 + (kb * 32 + 16 + fq * 4) * 2);
                const bf16x8 Sf = __builtin_shufflevector(s0, s1, 0, 1, 2, 3, 4, 5, 6, 7);
#pragma unroll
                for (int eb = 0; eb < 8; ++eb) { const bf16x8 Vf = tr_frag(Vh + (kb * 32 + fq * 4 + (fr >> 2)) * 288 + (eb * 16 + (fr & 3) * 4) * 2, 16 * 288);
                    accO[eb] = __builtin_amdgcn_mfma_f32_16x16x32_bf16(Vf, Sf, accO[eb], 0, 0, 0); if ((eb & 3) == 3) { asm volatile("" ::: "memory"); __builtin_amdgcn_sched_barrier(0); } }
            }
            u32x2 ovv[8];
#pragma unroll
            for (int eb = 0; eb < 8; ++eb) ovv[eb] = *(const u32x2*)(proj + tok * NPROJ + 2560 + h * 256 + eh * 128 + eb * 16 + fq * 4);
            asm volatile("" ::: "memory");
#pragma unroll
            for (int eb = 0; eb < 8; ++eb) { const u32x2 ov = ovv[eb];
                f32x4 hc; hc.x = sigmoidf_(bflo(ov.x)) * accO[eb].x * inv; hc.y = sigmoidf_(bfhi(ov.x)) * accO[eb].y * inv; hc.z = sigmoidf_(bflo(ov.y)) * accO[eb].z * inv; hc.w = sigmoidf_(bfhi(ov.y)) * accO[eb].w * inv;
                ss += (hc.x * hc.x + hc.y * hc.y) + (hc.z * hc.z + hc.w * hc.w);
                if (eh == 0) { hc0[eb].x = cvt_pk_bf16(hc.x, hc.y); hc0[eb].y = cvt_pk_bf16(hc.z, hc.w); } else accO[eb] = hc;
                if ((eb & 3) == 3) { asm volatile("" ::: "memory"); __builtin_amdgcn_sched_barrier(0); } }
            if (eh == 1) {
                ss += __shfl_xor(ss, 16); ss += __shfl_xor(ss, 32);
                const float rs = rsqrtf(ss * (1.0f / 256.0f) + EPS);
#pragma unroll
                for (int e4 = 0; e4 < 4; ++e4) {
                    u32x2 xvv[4];
#pragma unroll
                    for (int q = 0; q < 4; ++q) { const int col = h * 256 + (e4 * 4 + q) * 16 + fq * 4; xvv[q] = *(const u32x2*)(xc + tok * DM + col); }
                    asm volatile("" ::: "memory");
#pragma unroll
                    for (int q = 0; q < 4; ++q) { const int e2 = e4 * 4 + q, col = h * 256 + e2 * 16 + fq * 4;
                        const f32x4 ng = *(LAS f32x4*)(ngs + e2 * 16 + fq * 4), sk = *(LAS f32x4*)(sks + e2 * 16 + fq * 4); const u32x2 xv = xvv[q];
                        f32x4 hc; if (e2 < 8) { const u32x2 hp = hc0[e2 & 7]; hc = (f32x4){bflo(hp.x), bfhi(hp.x), bflo(hp.y), bfhi(hp.y)}; } else hc = accO[e2 & 7];
                        u32x2 o; o.x = cvt_pk_bf16(hc.x * rs * ng.x + sk.x * bflo(xv.x), hc.y * rs * ng.y + sk.y * bfhi(xv.x)); o.y = cvt_pk_bf16(hc.z * rs * ng.z + sk.z * bflo(xv.y), hc.w * rs * ng.w + sk.w * bfhi(xv.y));
                        *(u32x2*)(yml + tok * DM + col) = o; }
                    asm volatile("" ::: "memory"); __builtin_amdgcn_sched_barrier(0);
                }
            }
        }
        __syncthreads();
    }
}

#define XB_TMO      128
#define XB_XCNT(j)  (256  + 64 * (j))
#define XB_XSUB(j)  (1280 + 64 * (j))
#define XB_XGEN(j)  (2304 + 64 * (j))
#define XB_TOP      3328
#define XB_TOPGEN   3392
#define XCD_BAR_WORDS 3456
#define XB_SPIN_CAP (1u << 22)
__device__ __forceinline__ unsigned xb_ld(unsigned* p)              { return __hip_atomic_load(p, __ATOMIC_RELAXED, __HIP_MEMORY_SCOPE_AGENT); }
__device__ __forceinline__ unsigned xb_add(unsigned* p, unsigned v) { return __hip_atomic_fetch_add(p, v, __ATOMIC_RELAXED, __HIP_MEMORY_SCOPE_AGENT); }
__device__ __forceinline__ unsigned xb_xcc_id() { return (unsigned)__builtin_amdgcn_s_getreg((3 << 11) | 20) & 0xFu; }
#define XB_SPIN(cond, bar) do { unsigned _sp = 0; while (cond) { __builtin_amdgcn_s_sleep(1); \
    if ((++_sp & 255u) == 0u) { if (xb_ld(&(bar)[XB_TMO])) break; if (_sp > XB_SPIN_CAP) { atomicAdd(&(bar)[XB_TMO], 1u); break; } } } } while (0)
struct XcdBarrier { unsigned* bar; unsigned x; volatile LAS unsigned* st; };
__device__ __forceinline__ XcdBarrier xcd_barrier_post(unsigned* bar, volatile LAS unsigned* st) {
    XcdBarrier b; b.bar = bar; b.x = xb_xcc_id(); b.st = st;
    if (threadIdx.x == 0) (void)xb_add(&bar[XB_XCNT(b.x)], 1u);
    return b;
}
__device__ __forceinline__ void xcd_barrier_complete(unsigned* bar, unsigned x, unsigned& nloc, unsigned& nx) {
    const unsigned G = gridDim.x * gridDim.y * gridDim.z;
    unsigned sum, cnt, mine, sp = 0u;
    for (;;) {
        sum = 0u; cnt = 0u; mine = 0u;
#pragma unroll
        for (unsigned j = 0; j < 16; ++j) { const unsigned c = xb_ld(&bar[XB_XCNT(j)]); sum += c; cnt += (c > 0u) ? 1u : 0u; mine = (j == x) ? c : mine; }
        if (sum == G) break;
        __builtin_amdgcn_s_sleep(1);
        if ((++sp & 255u) == 0u) { if (xb_ld(&bar[XB_TMO])) break; if (sp > XB_SPIN_CAP) { atomicAdd(&bar[XB_TMO], 1u); break; } }
    }
    nloc = mine > 0u ? mine : 1u; nx = cnt > 0u ? cnt : 1u;
}
__device__ __forceinline__ void xcd_barrier(const XcdBarrier& b) {
    asm volatile("s_waitcnt vmcnt(0) lgkmcnt(0)" ::: "memory");
    __syncthreads();
    if (threadIdx.x == 0) {
        unsigned* bar = b.bar;
        __builtin_amdgcn_s_waitcnt(0);
        unsigned nloc = b.st[0], nx = b.st[1];
        if (nloc == 0u) { xcd_barrier_complete(bar, b.x, nloc, nx); b.st[0] = nloc; b.st[1] = nx; }
        const unsigned old = xb_add(&bar[XB_XSUB(b.x)], 1u);
        const unsigned gen = old / nloc;
        if (old + 1u == (gen + 1u) * nloc) {
            __builtin_amdgcn_fence(__ATOMIC_RELEASE, "agent");
            asm volatile("s_waitcnt vmcnt(0)" ::: "memory");
            const unsigned og = xb_add(&bar[XB_TOP], 1u);
            const unsigned tg = og / nx;
            if (og + 1u == (tg + 1u) * nx) xb_add(&bar[XB_TOPGEN], 1u);
            else XB_SPIN(xb_ld(&bar[XB_TOPGEN]) == tg, bar);
            __builtin_amdgcn_fence(__ATOMIC_ACQUIRE, "agent");
            xb_add(&bar[XB_XGEN(b.x)], 1u);
            asm volatile("s_waitcnt vmcnt(0)" ::: "memory");
        } else {
            XB_SPIN(xb_ld(&bar[XB_XGEN(b.x)]) == gen, bar);
            __builtin_amdgcn_fence(__ATOMIC_ACQUIRE, "agent");
            asm volatile("s_waitcnt vmcnt(0)" ::: "memory");
        }
    }
    __syncthreads();
}

__global__ void __launch_bounds__(512, 2) fwd_megakernel(KP p) {
    extern __shared__ __attribute__((aligned(16))) unsigned char shm[];
    LAS unsigned char* lds = (LAS unsigned char*)shm;
    cg::grid_group grid = cg::this_grid();
    { volatile LAS unsigned* st0 = (volatile LAS unsigned*)(lds + 143360); if (threadIdx.x < 4) st0[threadIdx.x] = 0u; }
    __syncthreads();
    const XcdBarrier xb = xcd_barrier_post((unsigned*)(p.ws + O_BAR), (volatile LAS unsigned*)(lds + 143360));
    if (p.out == nullptr) { asm volatile("s_waitcnt vmcnt(0) lgkmcnt(0)" ::: "memory"); grid.sync(); }
#define GSYNC() xcd_barrier(xb)
    unsigned char* ws = p.ws;
    bf16_t* BIG = (bf16_t*)(ws + O_BIG); bf16_t* XN = (bf16_t*)(ws + O_XN); bf16_t* XC = (bf16_t*)(ws + O_XC);
    bf16_t* Q = (bf16_t*)(ws + O_Q); bf16_t* KB = (bf16_t*)(ws + O_K); bf16_t* Z = (bf16_t*)(ws + O_Z); bf16_t* YS5 = (bf16_t*)(ws + O_YS5);
    float* MIXACC = (float*)(ws + O_CST); float* IFB = (float*)(ws + O_IF);
    float* xo = p.out;
    for (int l = 0; l < 4; ++l) {
        const float* xcur = (l == 0) ? p.in[0] : xo;
        for (int rep = 0; rep < REP_A; ++rep) { if (l == 0) convert_phase(p, 0, lds, 1, 0);
        rmsnorm_phase<false>(xcur, p.in[1] + l * 1024, XN, nullptr, nullptr, nullptr, lds); }
        GSYNC(); if (STOP_PHASE == 1) break;
        { pg8::Gemm g{XN, (const bf16_t*)(ws + W_GU1), MTOK, 2 * FF, 1024, 1024, 1024, 0}; pg8::EpiGated<0> e{BIG, FF}; pg8::gemm_phase(lds, g, e); }
        convert_phase(p, l, lds, l == 0 ? 2 : 4, 1);
        GSYNC(); if (STOP_PHASE == 2) break;
        { pg8::Gemm g{BIG, (const bf16_t*)(ws + W_D1), MTOK, 1024, FF, FF, FF, 0}; pg8::EpiResid e{xcur, xo, 0.5f}; pg8::gemm_phase(lds, g, e); }
        GSYNC(); if (STOP_PHASE == 3) break;
        for (int rep = 0; rep < REP_A; ++rep) { rmsnorm_phase<true>(xo, p.in[5] + l * 1024, XN, p.in[6] + (size_t)l * 1024 * INC, p.in[7] + l * 8, IFB, lds); __syncthreads(); }
        GSYNC(); if (STOP_PHASE == 4) break;
        { pg8::Gemm g{XN, (const bf16_t*)(ws + W_IN), MTOK, NPROJ, 1024, 1024, 1024, 0}; pg8::EpiBf16 e{BIG, BIG, NPROJ, 1000, 1.0f}; pg8::gemm_phase(lds, g, e); }
        if (l == 0) convert_phase(p, 0, lds, 4, 1);
        if (l < 3) convert_phase(p, l + 1, lds, 1, 1);
        GSYNC(); if (STOP_PHASE == 5) break;
        if (gridDim.x == 256) {
            s5_phase<false>(p, l, lds);
            conv_slice(p, l, (int)blockIdx.x >> 2, (int)blockIdx.x & 3);
            asm volatile("s_waitcnt vmcnt(0) lgkmcnt(0)" ::: "memory"); __syncthreads();
            { pg8::Gemm g{XC, (const bf16_t*)(ws + W_QK), MTOK, 2048, 256, 1024, 256, 256, nullptr, nullptr, 0, 1}; pg8::EpiBf16 e{Q, KB, 1024, 4, 0.0625f}; pg8::gemm_phase(lds, g, e); }
            asm volatile("s_waitcnt vmcnt(0) lgkmcnt(0)" ::: "memory"); __syncthreads();
            mlstm_s1_phase<true>(p, lds);
            GSYNC();
            s5_phase<true>(p, l, lds);
            mlstm_s2_phase(p);
            GSYNC();
            __syncthreads();
            { pg8::Gemm g{Z, (const bf16_t*)(ws + W_GLU), MTOK, 1024, 512, 512, 512, 0}; pg8::EpiGated<1> e{YS5, 1024}; pg8::gemm_phase(lds, g, e); }
            mlstm_s3_phase(p, l, lds);
            GSYNC();
        } else {
            conv_phase(p, l);
            s5_phase<false>(p, l, lds);
            GSYNC();
            { pg8::Gemm g{XC, (const bf16_t*)(ws + W_QK), MTOK, 2048, 256, 1024, 256, 256}; pg8::EpiBf16 e{Q, KB, 1024, 4, 0.0625f}; pg8::gemm_phase(lds, g, e); }
            GSYNC();
            mlstm_s1_phase<false>(p, lds);
            s5_phase<true>(p, l, lds);
            GSYNC();
            mlstm_s2_phase(p);
            { pg8::Gemm g{Z, (const bf16_t*)(ws + W_GLU), MTOK, 1024, 512, 512, 512, 0}; pg8::EpiGated<1> e{YS5, 1024}; pg8::gemm_phase(lds, g, e); }
            GSYNC();
            mlstm_s3_phase(p, l, lds);
            GSYNC();
        }
        { pg8::Gemm g{YS5, (const bf16_t*)(ws + W_BS5), MTOK, 1024, 512, 1024, 1024, 0, XN, (const bf16_t*)(ws + W_BML), 1024}; pg8::EpiMergeDual e{BIG + 3584, BIG + 4608, Q}; pg8::gemm_phase(lds, g, e); }
        GSYNC(); if (STOP_PHASE == 11) break;
        { pg8::Gemm g{Q, (const bf16_t*)(ws + W_OUT), MTOK, 1024, 1024, 1024, 1024, 0}; pg8::EpiResid e{xo, xo, 1.0f}; pg8::gemm_phase(lds, g, e); }
        GSYNC(); if (STOP_PHASE == 12) break;
        for (int rep = 0; rep < REP_A; ++rep) rmsnorm_phase<false>(xo, p.in[27] + l * 1024, XN, nullptr, nullptr, nullptr, lds);
        GSYNC(); if (STOP_PHASE == 13) break;
        { pg8::Gemm g{XN, (const bf16_t*)(ws + W_GU2), MTOK, 2 * FF, 1024, 1024, 1024, 0}; pg8::EpiGated<0> e{BIG, FF}; pg8::gemm_phase(lds, g, e); }
        if (l < 3) convert_phase(p, l + 1, lds, 2, 1);
        GSYNC(); if (STOP_PHASE == 14) break;
        { pg8::Gemm g{BIG, (const bf16_t*)(ws + W_D2), MTOK, 1024, FF, FF, FF, 0}; pg8::EpiResid e{xo, xo, 0.5f}; pg8::gemm_phase(lds, g, e); }
        GSYNC(); if (STOP_PHASE == 15) break;
    }
#ifdef DUMP_OFF
    { const int gt = blockIdx.x * 512 + opaque_tid(); const int nthr = gridDim.x * 512;
      for (int i = gt; i < MTOK * DM; i += nthr) { float v;
          if (DUMP_KIND == 5) { v = bflo((unsigned)((const bf16_t*)(ws + O_BIG))[(size_t)(i >> 10) * NPROJ + DUMP_COL + (i & 1023)]); }
          else if (DUMP_KIND == 4) { v = 0.f; if (i < 512) v = ((const float*)(ws + O_G))[i]; else if (i < 1024) v = ((const float*)(ws + O_MLOC))[i - 512]; else if (i < 1024 + 131072) v = ((const float*)(ws + O_NLOC))[i - 1024]; }
          else if (DUMP_KIND == 2 && i < 131072) v = ((const float*)(ws + O_IF))[i];
          else if (DUMP_KIND == 3) v = bflo((unsigned)((const bf16_t*)(ws + (i < 8388608 ? O_Q : O_K)))[i & 8388607]);
          else if (DUMP_KIND == 1) v = ((const float*)(ws + DUMP_OFF))[i]; else v = bflo((unsigned)((const bf16_t*)(ws + DUMP_OFF))[i]);
          xo[i] = (fabsf(v) < 1e30f) ? v : 12345.0f; } }
#else
    final_norm_phase(xo, p.in[31]);
#endif
}

extern "C" void kernel_launch(void* const* d_in, const int* in_sizes, int n_in, void* d_out, int out_size, void* d_ws, size_t ws_size, hipStream_t stream) {
    static int grid_blocks = 0;
    if (grid_blocks == 0) {
        if (n_in != 32 || ws_size < WS_END) { fprintf(stderr, "kernel_launch: unexpected n_in %d or ws_size %zu (< %zu)\n", n_in, ws_size, (size_t)WS_END); grid_blocks = -1; return; }
        int dev = 0, cus = 0, per_cu = 0;
        hipGetDevice(&dev);
        hipDeviceGetAttribute(&cus, hipDeviceAttributeMultiprocessorCount, dev);
        if (hipFuncSetAttribute((const void*)fwd_megakernel, hipFuncAttributeMaxDynamicSharedMemorySize, LDS_BYTES) != hipSuccess) { fprintf(stderr, "kernel_launch: hipFuncSetAttribute failed\n"); grid_blocks = -1; return; }
        hipOccupancyMaxActiveBlocksPerMultiprocessor(&per_cu, (const void*)fwd_megakernel, 512, LDS_BYTES);
        if (per_cu < 1) { fprintf(stderr, "kernel_launch: occupancy query says %d blocks/CU\n", per_cu); per_cu = 1; }
        (void)hipGetLastError();
        grid_blocks = cus;
    }
    if (grid_blocks < 0) return;
    if (hipMemsetAsync((unsigned char*)d_ws + O_BAR, 0, 16384, stream) != hipSuccess) { fprintf(stderr, "kernel_launch: memset of barrier words failed\n"); return; }
    KP p{};
    for (int i = 0; i < 32; ++i) p.in[i] = (const float*)d_in[i];
    p.out = (float*)d_out; p.ws = (unsigned char*)d_ws;
    void* args[] = {&p};
    hipError_t e = hipLaunchCooperativeKernel((const void*)fwd_megakernel, dim3(grid_blocks), dim3(512), args, LDS_BYTES, stream);
    if (e != hipSuccess) fprintf(stderr, "cooperative launch failed: %s (grid %d)\n", hipGetErrorString(e), grid_blocks);
}
```

```cpp
#include <hip/hip_runtime.h>
#include <hip/hip_cooperative_groups.h>
#include <cstdio>
namespace cg = cooperative_groups;

#define LAS __attribute__((address_space(3)))
typedef unsigned short bf16_t;
typedef short bf16x8 __attribute__((ext_vector_type(8)));
typedef short s16x4 __attribute__((ext_vector_type(4)));
typedef float f32x4 __attribute__((ext_vector_type(4)));
typedef float f32x2 __attribute__((ext_vector_type(2)));
typedef unsigned u32x4 __attribute__((ext_vector_type(4)));
typedef unsigned u32x2 __attribute__((ext_vector_type(2)));

constexpr int MTOK = 16384, DM = 1024, FF = 2816, NPROJ = 5632, SEQ = 8192, INC = 5640;
constexpr float EPS = 1e-6f;
constexpr int LDS_BYTES = 147456;
#ifndef STOP_PHASE
#define STOP_PHASE 99
#define REP_A 1
#define REP_G 1
#define REP_B 1
#define REP_C 1
#define REP_D 1
#endif
constexpr int VEC_OFF = 131072;

constexpr size_t W_GU1 = 0;
constexpr size_t W_D1 = W_GU1 + (size_t)5632 * 1024 * 2;
constexpr size_t W_IN = W_D1 + (size_t)1024 * 2816 * 2;
constexpr size_t W_GLU = W_IN + (size_t)5632 * 1024 * 2;
constexpr size_t W_QK = W_GLU + (size_t)1024 * 512 * 2;
constexpr size_t W_BS5 = W_QK + (size_t)2048 * 256 * 2;
constexpr size_t W_BML = W_BS5 + (size_t)1024 * 1024 * 2;
constexpr size_t W_OUT = W_BML + (size_t)1024 * 1024 * 2;
constexpr size_t W_GU2 = W_OUT + (size_t)1024 * 1024 * 2;
constexpr size_t W_D2 = W_GU2 + (size_t)5632 * 1024 * 2;
constexpr size_t W_END = W_D2 + (size_t)1024 * 2816 * 2;
constexpr size_t O_BIG = W_END;
constexpr size_t O_XN = O_BIG + (size_t)MTOK * NPROJ * 2;
constexpr size_t O_XC = O_XN + (size_t)MTOK * 1024 * 2;
constexpr size_t O_Q = O_XC + (size_t)MTOK * 1024 * 2;
constexpr size_t O_K = O_Q + (size_t)MTOK * 1024 * 2;
constexpr size_t O_Z = O_K + (size_t)MTOK * 1024 * 2;
constexpr size_t O_YS5 = O_Z + (size_t)MTOK * 512 * 2;
constexpr size_t O_CST = O_YS5 + (size_t)MTOK * 1024 * 2;
constexpr size_t O_IF = O_CST + (size_t)512 * 65536 * 2;
constexpr size_t O_S5END = O_IF + (size_t)MTOK * 8 * 4;
constexpr size_t O_G = O_S5END + (size_t)64 * 64 * 64 * 8;
constexpr size_t O_MLOC = O_G + 2048;
constexpr size_t O_MST = O_MLOC + 2048;
constexpr size_t O_NLOC = O_MST + 2048;
constexpr size_t O_NST = O_NLOC + (size_t)512 * 256 * 4;
constexpr size_t O_BAR = O_NST + (size_t)512 * 256 * 4;
constexpr size_t WS_END = O_BAR + 16384;

struct KP { const float* in[32]; float* out; unsigned char* ws; };

typedef __bf16 bf16v2_t __attribute__((ext_vector_type(2)));
__device__ __forceinline__ unsigned cvt_pk_bf16(float lo, float hi) { const f32x2 v = {lo, hi}; const bf16v2_t b = __builtin_convertvector(v, bf16v2_t); return __builtin_bit_cast(unsigned, b); }
__device__ __forceinline__ float bflo(unsigned u) { return __uint_as_float(u << 16); }
__device__ __forceinline__ float bfhi(unsigned u) { return __uint_as_float(u & 0xffff0000u); }
__device__ __forceinline__ float sigmoidf_(float x) { return __builtin_amdgcn_rcpf(1.0f + __expf(-x)); }
__device__ __forceinline__ float siluf_(float x) { return x * __builtin_amdgcn_rcpf(1.0f + __expf(-x)); }
__device__ __forceinline__ float gelu_tanh(float y) { const float v = 0.7978845608028654f * (y + 0.044715f * y * y * y); const float th = 1.0f - 2.0f * __builtin_amdgcn_rcpf(1.0f + __expf(2.0f * v)); return 0.5f * y * (1.0f + th); }
__device__ __forceinline__ float logsigmoidf_(float x) { return fminf(x, 0.f) - log1pf(__expf(-fabsf(x))); }
__device__ __forceinline__ float wave_sum(float v) {
#pragma unroll
    for (int o = 1; o < 64; o <<= 1) v += __shfl_xor(v, o);
    return v;
}
__device__ __forceinline__ int opaque_tid() { int t = threadIdx.x; asm volatile("" : "+v"(t)); return t; }
#define WAVE_LDS_SYNC() asm volatile("s_waitcnt lgkmcnt(0)" ::: "memory")
__device__ __forceinline__ void sincos_acc(float x, float& s, float& c) {
    const float k = rintf(x * 0.63661977236758134f);
    float r = fmaf(-k, 1.5703125f, x); r = fmaf(-k, 4.837512969970703125e-4f, r); r = fmaf(-k, 7.54978995489188216e-8f, r);
    const float r2 = r * r;
    const float sp = r + r * r2 * (-1.6666654611e-1f + r2 * (8.3321608736e-3f + r2 * (-1.9515295891e-4f)));
    const float cp = 1.0f - 0.5f * r2 + r2 * r2 * (4.166664568298827e-2f + r2 * (-1.388731625493765e-3f + r2 * 2.443315711809948e-5f));
    const int q = ((int)k) & 3;
    s = (q == 0) ? sp : (q == 1) ? cp : (q == 2) ? -sp : -cp;
    c = (q == 0) ? cp : (q == 1) ? -sp : (q == 2) ? -cp : sp;
}

namespace pg8 {
constexpr int BM = 256, BK = 64, HALF = 128, HTB = HALF * BK * 2, STAGE_BYTES = 8 * HTB, NXCD = 8, WGM = 8;
__host__ __device__ __forceinline__ int lds_byte(int r, int c) { const int st = (r >> 4) * 2 + (c >> 5), rr = r & 15, cc = c & 31, ob = rr * 64 + cc * 2; return st * 1024 + (ob ^ (((ob >> 9) & 1) << 5)); }
__host__ __device__ __forceinline__ void stage_rc(int b, int& R, int& C) { const int st = b / 1024, sb = b % 1024, swz = sb ^ (((sb >> 9) & 1) << 5); R = (st >> 1) * 16 + swz / 64; C = (st & 1) * 32 + (swz % 64) / 2; }
__host__ __device__ __forceinline__ int perm32(int rho) { const int n = rho >> 4, i = rho & 15; return 8 * (i >> 2) + 4 * n + (i & 3); }
struct Unit { int pm, pn; };
struct Gemm { const bf16_t* A; const bf16_t* Bt; int M, N, K, lda, ldb, ahead; const bf16_t* A2; const bf16_t* Bt2; int K2; int pairmode; };
struct StaticOrder {
    int nM, nN, nwg, G, c;
    __device__ void init(int M, int N, int G_, int c_) { nM = M / BM; nN = N / BM; nwg = nM * nN; G = G_; c = c_; }
    __device__ bool next(int i, Unit& u) const {
        const long L = (long)i * G + c; if (L >= nwg) return false;
        int wgid = (int)L; { const int q = nwg / NXCD, r = nwg % NXCD, xcd = wgid % NXCD, off = wgid / NXCD; wgid = (xcd < r ? xcd * (q + 1) : r * (q + 1) + (xcd - r) * q) + off; }
        const int nig = WGM * nN, gid = wgid / nig, fm = gid * WGM, gsz = (nM - fm) < WGM ? (nM - fm) : WGM;
        u.pm = fm + ((wgid % nig) % gsz); u.pn = (wgid % nig) / gsz; return true;
    }
};

template <class Epi>
__device__ __forceinline__ void gemm_phase(LAS unsigned char* lds, const Gemm g, const Epi& E) {
    StaticOrder S; S.init(g.M, g.N, (int)gridDim.x, (int)blockIdx.x);
    const int tid = opaque_tid(), wid = __builtin_amdgcn_readfirstlane(tid >> 6), lane = tid & 63, wr = wid >> 2, wc = wid & 3, fr = lane & 15, fq = lane >> 4;
    const int K = g.K; int nt = K / BK; int seg = 0;
    unsigned voffA[2], voffB[2];
#pragma unroll
    for (int i = 0; i < 2; ++i) { int R, C; stage_rc(tid * 16 + i * 8192, R, C); const int Rb = Epi::PERM ? ((R & ~31) + perm32(R & 31)) : R;
        voffA[i] = (unsigned)(R * g.lda + C) * 2u; voffB[i] = (unsigned)(Rb * g.ldb + C) * 2u; }
    const size_t kstep = (size_t)(BK * 2);
    const size_t hstepA = (size_t)HALF * g.lda * 2, hstepB = (size_t)HALF * g.ldb * 2;
    const size_t tstepA = 2 * hstepA, tstepB = 2 * hstepB;
    const unsigned ldsw = (unsigned)wid * 1024u;
    const int aoff = lds_byte(wr * 64 + fr, fq * 8), boff = lds_byte(wc * 32 + fr, fq * 8);
#define PG8_SA(b, h) (((b) * 2 + (h)) * HTB)
#define PG8_SB(b, h) ((4 + (b) * 2 + (h)) * HTB)
#define PG8_STAGE(bufoff, gbase, voff) do { _Pragma("unroll") for (int _i = 0; _i < 2; ++_i) \
        __builtin_amdgcn_global_load_lds((const unsigned*)((const char*)(gbase) + (voff)[_i]), (LAS unsigned*)(lds + (bufoff) + ldsw + _i * 8192), 16, 0, 0); } while (0)
#define PG8_LDA(dst, b, h) do { _Pragma("unroll") for (int m = 0; m < 4; ++m) _Pragma("unroll") for (int k = 0; k < 2; ++k) dst[m][k] = *(const LAS bf16x8*)(lds + PG8_SA(b, h) + aoff + m * 2048 + k * 1024); } while (0)
#define PG8_LDB(dst, b, h) do { _Pragma("unroll") for (int n = 0; n < 2; ++n) _Pragma("unroll") for (int k = 0; k < 2; ++k) dst[n][k] = *(const LAS bf16x8*)(lds + PG8_SB(b, h) + boff + n * 2048 + k * 1024); } while (0)
#define PG8_MMA(ai, bj, At, Bt) do { __builtin_amdgcn_s_setprio(1); _Pragma("unroll") for (int m = 0; m < 4; ++m) _Pragma("unroll") for (int n = 0; n < 2; ++n) _Pragma("unroll") for (int k = 0; k < 2; ++k) \
        acc[ai][bj][m][n] = __builtin_amdgcn_mfma_f32_16x16x32_bf16(Bt[n][k], At[m][k], acc[ai][bj][m][n], 0, 0, 0); __builtin_amdgcn_s_setprio(0); } while (0)
#define PG8_WAIT_V(n) asm volatile("s_waitcnt vmcnt(" #n ")" ::: "memory")
#define PG8_WAIT_L(n) asm volatile("s_waitcnt lgkmcnt(" #n ")" ::: "memory")
#define PG8_BAR __builtin_amdgcn_s_barrier()
#define PG8_SCHED __builtin_amdgcn_sched_barrier(0)
    auto nextu = [&](int i, Unit& u) -> bool { if (g.pairmode) { if (i >= 2) return false; u.pm = (int)blockIdx.x >> 2; u.pn = ((int)blockIdx.x & 3) + 4 * i; return true; } return S.next(i, u); };
    Unit cur, nxt; int ui = 0;
    if (!nextu(0, cur)) return;
    f32x4 acc[2][2][4][2];
#pragma unroll
    for (int a = 0; a < 2; ++a)
#pragma unroll
        for (int b = 0; b < 2; ++b)
#pragma unroll
            for (int m = 0; m < 4; ++m)
#pragma unroll
                for (int n = 0; n < 2; ++n) acc[a][b][m][n] = (f32x4){0.f, 0.f, 0.f, 0.f};
    bf16x8 At[4][2], B0[2][2], B1[2][2];
    const char* cA = (const char*)g.A + (size_t)cur.pm * tstepA + (size_t)((cur.pn & 3) * g.ahead) * 2; const char* cB = (const char*)g.Bt + (size_t)cur.pn * tstepB;
    PG8_STAGE(PG8_SB(0, 0), cB, voffB); PG8_STAGE(PG8_SA(0, 0), cA, voffA); PG8_STAGE(PG8_SB(0, 1), cB + hstepB, voffB); PG8_STAGE(PG8_SA(0, 1), cA + hstepA, voffA);
    if (wr == 1) PG8_BAR;
    PG8_WAIT_V(4); PG8_BAR;
    PG8_STAGE(PG8_SB(1, 0), cB + kstep, voffB); PG8_STAGE(PG8_SA(1, 0), cA + kstep, voffA); PG8_STAGE(PG8_SB(1, 1), cB + hstepB + kstep, voffB);
    PG8_WAIT_V(6); PG8_BAR;
    for (;;) {
        bool has_next; const char* nA; const char* nB;
        if (Epi::DUAL && seg == 0) { has_next = true; nxt = cur; nA = (const char*)g.A2 + (size_t)cur.pm * tstepA; nB = (const char*)g.Bt2 + (size_t)cur.pn * tstepB; }
        else { has_next = nextu(ui + 1, nxt);
            nA = has_next ? (const char*)g.A + (size_t)nxt.pm * tstepA + (size_t)((nxt.pn & 3) * g.ahead) * 2 : cA; nB = has_next ? (const char*)g.Bt + (size_t)nxt.pn * tstepB : cB; }
        for (int t = 0; t < nt; t += 2) {
            const bool last = (t == nt - 2);
            const char* a1 = cA + (size_t)(t + 1) * kstep;
            const char* a2 = last ? nA : cA + (size_t)(t + 2) * kstep; const char* b2 = last ? nB : cB + (size_t)(t + 2) * kstep;
            const char* a3 = a2 + kstep; const char* b3 = b2 + kstep;
            PG8_LDB(B0, 0, 0); PG8_SCHED; PG8_LDA(At, 0, 0); PG8_STAGE(PG8_SA(1, 1), a1 + hstepA, voffA);
            PG8_WAIT_L(8); PG8_BAR; PG8_WAIT_L(0); PG8_MMA(0, 0, At, B0); PG8_BAR; PG8_SCHED;
            PG8_LDB(B1, 0, 1); PG8_STAGE(PG8_SB(0, 0), b2, voffB);
            PG8_BAR; PG8_WAIT_L(0); PG8_MMA(0, 1, At, B1); PG8_BAR;
            PG8_LDA(At, 0, 1); PG8_STAGE(PG8_SA(0, 0), a2, voffA);
            PG8_BAR; PG8_WAIT_L(0); PG8_MMA(1, 0, At, B0); PG8_BAR; PG8_SCHED;
            PG8_STAGE(PG8_SB(0, 1), b2 + hstepB, voffB);
            PG8_WAIT_V(6); PG8_BAR; PG8_MMA(1, 1, At, B1); PG8_BAR;
            PG8_LDB(B0, 1, 0); PG8_SCHED; PG8_LDA(At, 1, 0); PG8_STAGE(PG8_SA(0, 1), a2 + hstepA, voffA);
            PG8_WAIT_L(8); PG8_BAR; PG8_WAIT_L(0); PG8_MMA(0, 0, At, B0); PG8_BAR; PG8_SCHED;
            PG8_LDB(B1, 1, 1); PG8_STAGE(PG8_SB(1, 0), b3, voffB);
            PG8_BAR; PG8_WAIT_L(0); PG8_MMA(0, 1, At, B1); PG8_BAR;
            PG8_LDA(At, 1, 1); PG8_STAGE(PG8_SA(1, 0), a3, voffA);
            PG8_BAR; PG8_WAIT_L(0); PG8_MMA(1, 0, At, B0); PG8_BAR; PG8_SCHED;
            PG8_STAGE(PG8_SB(1, 1), b3 + hstepB, voffB);
            PG8_WAIT_V(6); PG8_BAR; PG8_MMA(1, 1, At, B1); PG8_BAR;
        }
        if constexpr (Epi::DUAL) { if (seg == 0) { E.mid(acc, cur, wr, wc, fr, fq); seg = 1; cA = nA; cB = nB; nt = g.K2 / BK; continue; } }
        E(acc, cur, wr, wc, fr, fq);
        if (Epi::DUAL) { seg = 0; nt = K / BK; }
        if (!has_next) break;
#pragma unroll
        for (int a = 0; a < 2; ++a)
#pragma unroll
            for (int b = 0; b < 2; ++b)
#pragma unroll
                for (int m = 0; m < 4; ++m)
#pragma unroll
                    for (int n = 0; n < 2; ++n) acc[a][b][m][n] = (f32x4){0.f, 0.f, 0.f, 0.f};
        cur = nxt; cA = nA; cB = nB; ++ui;
    }
    PG8_WAIT_V(0);
    if (wr == 0) PG8_BAR;
    PG8_BAR;
#undef PG8_SA
#undef PG8_SB
#undef PG8_STAGE
#undef PG8_LDA
#undef PG8_LDB
#undef PG8_MMA
#undef PG8_WAIT_V
#undef PG8_WAIT_L
#undef PG8_BAR
#undef PG8_SCHED
}

template <int ACT> struct EpiGated {
    static constexpr bool DUAL = false;
    static constexpr bool PERM = true;
    bf16_t* O; int ldo;
    __device__ __forceinline__ void operator()(const f32x4 (&acc)[2][2][4][2], const Unit& u, int wr, int wc, int fr, int fq) const {
        const int row0 = u.pm * BM + wr * 64 + fr, col0 = u.pn * 128 + wc * 32 + 8 * fq;
#pragma unroll
        for (int ai = 0; ai < 2; ++ai)
#pragma unroll
            for (int m = 0; m < 4; ++m) {
                bf16_t* rowp = O + (size_t)(row0 + ai * HALF + m * 16) * ldo + col0;
                float r[8];
#pragma unroll
                for (int n = 0; n < 2; ++n)
#pragma unroll
                    for (int j = 0; j < 4; ++j) { const float a0 = acc[ai][0][m][n][j], a1 = acc[ai][1][m][n][j]; r[n * 4 + j] = ACT == 0 ? siluf_(a0) * a1 : a0 * sigmoidf_(a1); }
                u32x4 o; o.x = cvt_pk_bf16(r[0], r[1]); o.y = cvt_pk_bf16(r[2], r[3]); o.z = cvt_pk_bf16(r[4], r[5]); o.w = cvt_pk_bf16(r[6], r[7]);
                *(u32x4*)rowp = o;
            }
    }
};
struct EpiResid {
    static constexpr bool DUAL = false;
    static constexpr bool PERM = false;
    const float* xin; float* xout; float scale;
    __device__ __forceinline__ void operator()(const f32x4 (&acc)[2][2][4][2], const Unit& u, int wr, int wc, int fr, int fq) const {
        const int row0 = u.pm * BM + wr * 64 + fr, col0 = u.pn * BM + wc * 32 + 4 * fq;
#pragma unroll
        for (int ai = 0; ai < 2; ++ai) {
            f32x4 xv[4][2][2];
#pragma unroll
            for (int m = 0; m < 4; ++m) { const size_t ro = (size_t)(row0 + ai * HALF + m * 16) * DM + col0;
#pragma unroll
                for (int bj = 0; bj < 2; ++bj)
#pragma unroll
                    for (int n = 0; n < 2; ++n) xv[m][bj][n] = *(const f32x4*)(xin + ro + bj * HALF + n * 16); }
            asm volatile("" ::: "memory");
#pragma unroll
            for (int m = 0; m < 4; ++m) { const size_t ro = (size_t)(row0 + ai * HALF + m * 16) * DM + col0;
#pragma unroll
                for (int bj = 0; bj < 2; ++bj)
#pragma unroll
                    for (int n = 0; n < 2; ++n) *(f32x4*)(xout + ro + bj * HALF + n * 16) = xv[m][bj][n] + scale * acc[ai][bj][m][n]; }
            asm volatile("" ::: "memory");
        }
    }
};
struct EpiBf16 {
    static constexpr bool DUAL = false;
    static constexpr bool PERM = true;
    bf16_t* O; bf16_t* O2; int ldo, split; float scale1;
    __device__ __forceinline__ void operator()(const f32x4 (&acc)[2][2][4][2], const Unit& u, int wr, int wc, int fr, int fq) const {
        const int row0 = u.pm * BM + wr * 64 + fr; int pn = u.pn; bf16_t* base = O; float sc = scale1;
        if (pn >= split) { pn -= split; base = O2; sc = 1.0f; }
        const int col0 = pn * BM + wc * 32 + 8 * fq;
#pragma unroll
        for (int ai = 0; ai < 2; ++ai)
#pragma unroll
            for (int m = 0; m < 4; ++m) { bf16_t* rowp = base + (size_t)(row0 + ai * HALF + m * 16) * ldo + col0;
#pragma unroll
                for (int bj = 0; bj < 2; ++bj) { const f32x4 v0 = acc[ai][bj][m][0] * sc, v1 = acc[ai][bj][m][1] * sc;
                    u32x4 o; o.x = cvt_pk_bf16(v0[0], v0[1]); o.y = cvt_pk_bf16(v0[2], v0[3]); o.z = cvt_pk_bf16(v1[0], v1[1]); o.w = cvt_pk_bf16(v1[2], v1[3]);
                    *(u32x4*)(rowp + bj * HALF) = o; } }
    }
};
template <int SECOND> struct EpiMerge {
    static constexpr bool DUAL = false;
    static constexpr bool PERM = true;
    const bf16_t* gate; float* mixacc; bf16_t* mix;
    __device__ __forceinline__ void operator()(const f32x4 (&acc)[2][2][4][2], const Unit& u, int wr, int wc, int fr, int fq) const {
        const int row0 = u.pm * BM + wr * 64 + fr, col0 = u.pn * BM + wc * 32 + 8 * fq;
#pragma unroll
        for (int ai = 0; ai < 2; ++ai)
#pragma unroll
            for (int mp = 0; mp < 2; ++mp) {
                u32x4 gv[2][2]; f32x4 pv[2][2][2];
#pragma unroll
                for (int mi = 0; mi < 2; ++mi)
#pragma unroll
                    for (int bj = 0; bj < 2; ++bj) { const size_t row = (size_t)(row0 + ai * HALF + (mp * 2 + mi) * 16); const int col = col0 + bj * HALF;
                        gv[mi][bj] = *(const u32x4*)(gate + row * NPROJ + col);
                        if (SECOND == 1) { pv[mi][bj][0] = *(const f32x4*)(mixacc + row * DM + col); pv[mi][bj][1] = *(const f32x4*)(mixacc + row * DM + col + 4); } }
                asm volatile("" ::: "memory");
#pragma unroll
                for (int mi = 0; mi < 2; ++mi)
#pragma unroll
                    for (int bj = 0; bj < 2; ++bj) { const int m = mp * 2 + mi; const size_t row = (size_t)(row0 + ai * HALF + m * 16); const int col = col0 + bj * HALF; const u32x4 g4 = gv[mi][bj];
                        float r[8];
                        r[0] = sigmoidf_(bflo(g4.x)) * acc[ai][bj][m][0][0]; r[1] = sigmoidf_(bfhi(g4.x)) * acc[ai][bj][m][0][1];
                        r[2] = sigmoidf_(bflo(g4.y)) * acc[ai][bj][m][0][2]; r[3] = sigmoidf_(bfhi(g4.y)) * acc[ai][bj][m][0][3];
                        r[4] = sigmoidf_(bflo(g4.z)) * acc[ai][bj][m][1][0]; r[5] = sigmoidf_(bfhi(g4.z)) * acc[ai][bj][m][1][1];
                        r[6] = sigmoidf_(bflo(g4.w)) * acc[ai][bj][m][1][2]; r[7] = sigmoidf_(bfhi(g4.w)) * acc[ai][bj][m][1][3];
                        if (SECOND == 0) { float* mp_ = mixacc + row * DM + col; *(f32x4*)mp_ = (f32x4){r[0], r[1], r[2], r[3]}; *(f32x4*)(mp_ + 4) = (f32x4){r[4], r[5], r[6], r[7]}; }
                        else { const f32x4 p0 = pv[mi][bj][0], p1 = pv[mi][bj][1];
                            u32x4 o; o.x = cvt_pk_bf16(r[0] + p0[0], r[1] + p0[1]); o.y = cvt_pk_bf16(r[2] + p0[2], r[3] + p0[3]); o.z = cvt_pk_bf16(r[4] + p1[0], r[5] + p1[1]); o.w = cvt_pk_bf16(r[6] + p1[2], r[7] + p1[3]);
                            *(u32x4*)(mix + row * DM + col) = o; } }
                asm volatile("" ::: "memory");
            }
    }
};
struct EpiMergeDual {
    static constexpr bool PERM = true, DUAL = true;
    const bf16_t* gate1; const bf16_t* gate2; bf16_t* mix;
    static __device__ __forceinline__ float em(float g) { return fminf(__expf(-g), 1e30f); }
    __device__ __forceinline__ void mid(f32x4 (&acc)[2][2][4][2], const Unit& u, int wr, int wc, int fr, int fq) const {
        const int row0 = u.pm * BM + wr * 64 + fr, col0 = u.pn * BM + wc * 32 + 8 * fq;
#pragma unroll
        for (int ai = 0; ai < 2; ++ai)
#pragma unroll
            for (int mp = 0; mp < 2; ++mp) {
                u32x4 g1v[2][2], g2v[2][2];
#pragma unroll
                for (int mi = 0; mi < 2; ++mi)
#pragma unroll
                    for (int bj = 0; bj < 2; ++bj) { const size_t row = (size_t)(row0 + ai * HALF + (mp * 2 + mi) * 16); const int col = col0 + bj * HALF;
                        g1v[mi][bj] = *(const u32x4*)(gate1 + row * NPROJ + col); g2v[mi][bj] = *(const u32x4*)(gate2 + row * NPROJ + col); }
#pragma unroll
                for (int mi = 0; mi < 2; ++mi)
#pragma unroll
                    for (int bj = 0; bj < 2; ++bj) { const int m = mp * 2 + mi; const u32x4 a = g1v[mi][bj], b = g2v[mi][bj];
                        const float ga[8] = {bflo(a.x), bfhi(a.x), bflo(a.y), bfhi(a.y), bflo(a.z), bfhi(a.z), bflo(a.w), bfhi(a.w)};
                        const float gb[8] = {bflo(b.x), bfhi(b.x), bflo(b.y), bfhi(b.y), bflo(b.z), bfhi(b.z), bflo(b.w), bfhi(b.w)};
#pragma unroll
                        for (int j = 0; j < 8; ++j) acc[ai][bj][m][j >> 2][j & 3] *= (1.0f + em(gb[j])) * __builtin_amdgcn_rcpf(1.0f + em(ga[j])); }
            }
    }
    __device__ __forceinline__ void operator()(const f32x4 (&acc)[2][2][4][2], const Unit& u, int wr, int wc, int fr, int fq) const {
        const int row0 = u.pm * BM + wr * 64 + fr, col0 = u.pn * BM + wc * 32 + 8 * fq;
#pragma unroll
        for (int ai = 0; ai < 2; ++ai)
#pragma unroll
            for (int mp = 0; mp < 2; ++mp) {
                u32x4 g2v[2][2];
#pragma unroll
                for (int mi = 0; mi < 2; ++mi)
#pragma unroll
                    for (int bj = 0; bj < 2; ++bj) { const size_t row = (size_t)(row0 + ai * HALF + (mp * 2 + mi) * 16); const int col = col0 + bj * HALF;
                        g2v[mi][bj] = *(const u32x4*)(gate2 + row * NPROJ + col); }
#pragma unroll
                for (int mi = 0; mi < 2; ++mi)
#pragma unroll
                    for (int bj = 0; bj < 2; ++bj) { const int m = mp * 2 + mi; const size_t row = (size_t)(row0 + ai * HALF + m * 16); const int col = col0 + bj * HALF; const u32x4 b = g2v[mi][bj];
                        const float gb[8] = {bflo(b.x), bfhi(b.x), bflo(b.y), bfhi(b.y), bflo(b.z), bfhi(b.z), bflo(b.w), bfhi(b.w)};
                        float r[8];
#pragma unroll
                        for (int j = 0; j < 8; ++j) r[j] = acc[ai][bj][m][j >> 2][j & 3] * __builtin_amdgcn_rcpf(1.0f + em(gb[j]));
                        u32x4 o; o.x = cvt_pk_bf16(r[0], r[1]); o.y = cvt_pk_bf16(r[2], r[3]); o.z = cvt_pk_bf16(r[4], r[5]); o.w = cvt_pk_bf16(r[6], r[7]);
                        *(u32x4*)(mix + row * DM + col) = o; }
            }
    }
};
}

__device__ __forceinline__ void tr_job(const float* W, int K, int ld, int c0, int NC, bf16_t* WT, int rowbase, int rs, LAS float* scr, int gw, int nw, int lane, int ldw = 0) {
    if (ldw == 0) ldw = K;
    const int nblk = NC / 32, nitems = (K / 64) * nblk;
    for (int item = gw; item < nitems; item += nw) {
        const int kb = item / nblk, nb = item % nblk, k0 = 64 * kb, n0 = 32 * nb;
        float wv[32];
#pragma unroll
        for (int i = 0; i < 32; ++i) { const int kk = 2 * i + (lane >> 5); wv[i] = W[(size_t)(k0 + kk) * ld + c0 + n0 + (lane & 31)]; }
#pragma unroll
        for (int i = 0; i < 32; ++i) { const int kk = 2 * i + (lane >> 5); scr[kk * 33 + (lane & 31)] = wv[i]; }
        WAVE_LDS_SYNC();
        const int c = lane & 7;
#pragma unroll
        for (int j = 0; j < 4; ++j) { const int n = (lane >> 3) + 8 * j; const LAS float* s = scr + (8 * c) * 33 + n;
            u32x4 o; o.x = cvt_pk_bf16(s[0 * 33], s[1 * 33]); o.y = cvt_pk_bf16(s[2 * 33], s[3 * 33]); o.z = cvt_pk_bf16(s[4 * 33], s[5 * 33]); o.w = cvt_pk_bf16(s[6 * 33], s[7 * 33]);
            const int nn = n0 + n, drow = rowbase + (nn >> 7) * rs + (nn & 127);
            *(u32x4*)(WT + (size_t)drow * ldw + k0 + 8 * c) = o; }
        WAVE_LDS_SYNC();
    }
}
__device__ __forceinline__ void convert_phase(const KP& p, int l, LAS unsigned char* lds, int mask, int part) {
    const int tid = opaque_tid(); const int wid = tid >> 6, lane = tid & 63;
    if (part && (int)blockIdx.x < 128) return;
    const int nw = part ? ((int)gridDim.x - 128) * 8 : (int)gridDim.x * 8;
    int gw = (part ? (int)blockIdx.x - 128 : (int)blockIdx.x) * 8 + wid;
    if (nw <= 0) return;
    LAS float* scr = (LAS float*)(lds + wid * 8448);
    unsigned char* ws = p.ws;
    const size_t ffw = (size_t)l * 1024 * 2816;
    bf16_t* gu1 = (bf16_t*)(ws + W_GU1); bf16_t* d1 = (bf16_t*)(ws + W_D1);
#define ROT(n) gw = (gw + (n)) % nw
    if (mask & 1) {
        tr_job(p.in[2] + ffw, 1024, 2816, 0, 2816, gu1, 0, 256, scr, gw, nw, lane);
        tr_job(p.in[3] + ffw, 1024, 2816, 0, 2816, gu1, 128, 256, scr, gw, nw, lane);
        tr_job(p.in[4] + ffw, 2816, 1024, 0, 1024, d1, 0, 128, scr, gw, nw, lane);
    }
    if (mask & 4) {
        tr_job(p.in[28] + ffw, 1024, 2816, 0, 2816, (bf16_t*)(ws + W_GU2), 0, 256, scr, gw, nw, lane);
        tr_job(p.in[29] + ffw, 1024, 2816, 0, 2816, (bf16_t*)(ws + W_GU2), 128, 256, scr, gw, nw, lane);
        tr_job(p.in[30] + ffw, 2816, 1024, 0, 1024, (bf16_t*)(ws + W_D2), 0, 128, scr, gw, nw, lane);
    }
    if (mask & 2) {
        tr_job(p.in[6] + (size_t)l * 1024 * INC, 1024, INC, 0, 3584, (bf16_t*)(ws + W_IN), 0, 128, scr, gw, nw, lane);
        tr_job(p.in[6] + (size_t)l * 1024 * INC, 1024, INC, 3592, 2048, (bf16_t*)(ws + W_IN), 3584, 128, scr, gw, nw, lane);
        ROT(768);
        tr_job(p.in[16] + (size_t)l * 512 * 512, 512, 512, 0, 512, (bf16_t*)(ws + W_GLU), 0, 256, scr, gw, nw, lane);
        ROT(128);
        tr_job(p.in[17] + (size_t)l * 512 * 512, 512, 512, 0, 512, (bf16_t*)(ws + W_GLU), 128, 256, scr, gw, nw, lane);
        ROT(128);
        tr_job(p.in[24] + (size_t)l * 512 * 1024, 512, 1024, 0, 1024, (bf16_t*)(ws + W_BS5), 0, 128, scr, gw, nw, lane, 1024);
        ROT(256);
        tr_job(p.in[25] + (size_t)l * 1024 * 1024, 1024, 1024, 0, 1024, (bf16_t*)(ws + W_BML), 0, 128, scr, gw, nw, lane);
        ROT(512);
        tr_job(p.in[26] + (size_t)l * 1024 * 1024, 1024, 1024, 0, 1024, (bf16_t*)(ws + W_OUT), 0, 128, scr, gw, nw, lane);
        ROT(512);
        for (int h = 0; h < 4; ++h) {
            tr_job(p.in[20] + ((size_t)l * 4 + h) * 65536, 256, 256, 0, 256, (bf16_t*)(ws + W_QK), h * 256, 128, scr, gw, nw, lane);
            ROT(32);
            tr_job(p.in[21] + ((size_t)l * 4 + h) * 65536, 256, 256, 0, 256, (bf16_t*)(ws + W_QK), 1024 + h * 256, 128, scr, gw, nw, lane);
            ROT(32);
        }
    }
#undef ROT
}

template <bool WITH_IF>
__device__ __forceinline__ void rmsnorm_phase(const float* x, const float* gain, bf16_t* xn, const float* win_l, const float* bif, float* ifbuf, LAS unsigned char* lds) {
    const int tid = opaque_tid(); const int wid = tid >> 6, lane = tid & 63;
    LAS float* ifw = (LAS float*)lds;
    if (WITH_IF) {
        for (int k = tid; k < 1024; k += 512) { const f32x4 a = *(const f32x4*)(win_l + (size_t)k * INC + 3584), b = *(const f32x4*)(win_l + (size_t)k * INC + 3588);
            *(LAS f32x4*)(ifw + k * 8) = a; *(LAS f32x4*)(ifw + k * 8 + 4) = b; }
        __syncthreads();
    }
    f32x4 gv[4];
#pragma unroll
    for (int i = 0; i < 4; ++i) gv[i] = *(const f32x4*)(gain + 4 * (lane + 64 * i));
    const int nw = gridDim.x * 8;
    constexpr int RPT = WITH_IF ? 4 : 8;
    for (int row0 = blockIdx.x * 8 + wid; row0 < MTOK; row0 += RPT * nw) {
        f32x4 v[RPT][4];
#pragma unroll
        for (int q = 0; q < RPT; ++q) { const int row = (row0 + q * nw < MTOK) ? row0 + q * nw : row0;
#pragma unroll
            for (int i = 0; i < 4; ++i) v[q][i] = *(const f32x4*)(x + (size_t)row * DM + 4 * (lane + 64 * i)); }
        asm volatile("" ::: "memory");
#pragma unroll
        for (int q = 0; q < RPT; ++q) { const int row = row0 + q * nw;
            float ss = 0.f;
#pragma unroll
            for (int i = 0; i < 4; ++i) ss += (v[q][i].x * v[q][i].x + v[q][i].y * v[q][i].y) + (v[q][i].z * v[q][i].z + v[q][i].w * v[q][i].w);
            ss = wave_sum(ss);
            const float r = rsqrtf(ss * (1.0f / DM) + EPS);
            float ga[8];
            if (WITH_IF) {
#pragma unroll
                for (int j = 0; j < 8; ++j) ga[j] = 0.f;
            }
            if (row < MTOK) {
#pragma unroll
                for (int i = 0; i < 4; ++i) { const f32x4 y = v[q][i] * r * gv[i];
                    u32x2 o; o.x = cvt_pk_bf16(y.x, y.y); o.y = cvt_pk_bf16(y.z, y.w);
                    *(u32x2*)(xn + (size_t)row * DM + 4 * (lane + 64 * i)) = o;
                    if (WITH_IF) {
#pragma unroll
                        for (int e = 0; e < 4; ++e) { const int k = 4 * (lane + 64 * i) + e; const f32x4 a = *(LAS f32x4*)(ifw + k * 8), b = *(LAS f32x4*)(ifw + k * 8 + 4); const float xv = y[e];
                            ga[0] += xv * a.x; ga[1] += xv * a.y; ga[2] += xv * a.z; ga[3] += xv * a.w; ga[4] += xv * b.x; ga[5] += xv * b.y; ga[6] += xv * b.z; ga[7] += xv * b.w; }
                        asm volatile("" ::: "memory");
                    }
                }
                if (WITH_IF) {
#pragma unroll
                    for (int j = 0; j < 8; ++j) ga[j] = wave_sum(ga[j]);
                    if (lane == 0) { *(f32x4*)(ifbuf + (size_t)row * 8) = (f32x4){ga[0] + bif[0], ga[1] + bif[1], ga[2] + bif[2], ga[3] + bif[3]};
                        *(f32x4*)(ifbuf + (size_t)row * 8 + 4) = (f32x4){ga[4] + bif[4], ga[5] + bif[5], ga[6] + bif[6], ga[7] + bif[7]}; }
                }
            }
        }
    }
}
__device__ __forceinline__ void final_norm_phase(float* x, const float* gain) {
    const int tid = opaque_tid(); const int wid = tid >> 6, lane = tid & 63;
    f32x4 gv[4];
#pragma unroll
    for (int i = 0; i < 4; ++i) gv[i] = *(const f32x4*)(gain + 4 * (lane + 64 * i));
    for (int row = blockIdx.x * 8 + wid; row < MTOK; row += gridDim.x * 8) {
        float* xr = x + (size_t)row * DM;
        f32x4 v[4]; float ss = 0.f;
#pragma unroll
        for (int i = 0; i < 4; ++i) { v[i] = *(const f32x4*)(xr + 4 * (lane + 64 * i)); ss += (v[i].x * v[i].x + v[i].y * v[i].y) + (v[i].z * v[i].z + v[i].w * v[i].w); }
        ss = wave_sum(ss);
        const float r = rsqrtf(ss * (1.0f / DM) + EPS);
#pragma unroll
        for (int i = 0; i < 4; ++i) *(f32x4*)(xr + 4 * (lane + 64 * i)) = v[i] * r * gv[i];
    }
}

__device__ __forceinline__ void conv_phase(const KP& p, int l) {
    const bf16_t* proj = (const bf16_t*)(p.ws + O_BIG); bf16_t* xc = (bf16_t*)(p.ws + O_XC);
    const int gt = blockIdx.x * 512 + opaque_tid(), c8 = gt & 127;
    const float* cw = p.in[18] + (size_t)l * 4 * 1024 + c8 * 8; const float* cb = p.in[19] + (size_t)l * 1024 + c8 * 8;
    float w[4][8], bias[8];
#pragma unroll
    for (int j = 0; j < 4; ++j) { const f32x4 a = *(const f32x4*)(cw + j * 1024), b = *(const f32x4*)(cw + j * 1024 + 4); w[j][0] = a.x; w[j][1] = a.y; w[j][2] = a.z; w[j][3] = a.w; w[j][4] = b.x; w[j][5] = b.y; w[j][6] = b.z; w[j][7] = b.w; }
    { const f32x4 a = *(const f32x4*)cb, b = *(const f32x4*)(cb + 4); bias[0] = a.x; bias[1] = a.y; bias[2] = a.z; bias[3] = a.w; bias[4] = b.x; bias[5] = b.y; bias[6] = b.z; bias[7] = b.w; }
    const int nthr = gridDim.x * 512;
    for (int idx0 = gt; idx0 < MTOK * 128; idx0 += 4 * nthr) {
        u32x4 v[4][4];
#pragma unroll
        for (int q = 0; q < 4; ++q) { const int idx = idx0 + q * nthr; const int t = idx >> 7, pos = t & (SEQ - 1);
#pragma unroll
            for (int j = 0; j < 4; ++j) { v[q][j] = (u32x4){0u, 0u, 0u, 0u}; if (idx < MTOK * 128 && pos - 3 + j >= 0) v[q][j] = *(const u32x4*)(proj + (size_t)(t - 3 + j) * NPROJ + 512 + c8 * 8); } }
        asm volatile("" ::: "memory");
#pragma unroll
        for (int q = 0; q < 4; ++q) { const int idx = idx0 + q * nthr; const int t = idx >> 7;
            float y[8];
#pragma unroll
            for (int e = 0; e < 8; ++e) y[e] = bias[e];
#pragma unroll
            for (int j = 0; j < 4; ++j) { const u32x4 vv = v[q][j];
                y[0] += w[j][0] * bflo(vv.x); y[1] += w[j][1] * bfhi(vv.x); y[2] += w[j][2] * bflo(vv.y); y[3] += w[j][3] * bfhi(vv.y);
                y[4] += w[j][4] * bflo(vv.z); y[5] += w[j][5] * bfhi(vv.z); y[6] += w[j][6] * bflo(vv.w); y[7] += w[j][7] * bfhi(vv.w); }
            u32x4 o; o.x = cvt_pk_bf16(siluf_(y[0]), siluf_(y[1])); o.y = cvt_pk_bf16(siluf_(y[2]), siluf_(y[3])); o.z = cvt_pk_bf16(siluf_(y[4]), siluf_(y[5])); o.w = cvt_pk_bf16(siluf_(y[6]), siluf_(y[7]));
            if (idx < MTOK * 128) *(u32x4*)(xc + (size_t)t * DM + c8 * 8) = o; }
    }
}

__device__ __forceinline__ void conv_slice(const KP& p, int l, int pm, int head) {
    const bf16_t* proj = (const bf16_t*)(p.ws + O_BIG); bf16_t* xc = (bf16_t*)(p.ws + O_XC);
    const int tid = opaque_tid(); const int c8 = head * 32 + (tid & 31), rsub = tid >> 5;
    const float* cw = p.in[18] + (size_t)l * 4 * 1024 + c8 * 8; const float* cb = p.in[19] + (size_t)l * 1024 + c8 * 8;
    float w[4][8], bias[8];
#pragma unroll
    for (int j = 0; j < 4; ++j) { const f32x4 a = *(const f32x4*)(cw + j * 1024), b = *(const f32x4*)(cw + j * 1024 + 4); w[j][0] = a.x; w[j][1] = a.y; w[j][2] = a.z; w[j][3] = a.w; w[j][4] = b.x; w[j][5] = b.y; w[j][6] = b.z; w[j][7] = b.w; }
    { const f32x4 a = *(const f32x4*)cb, b = *(const f32x4*)(cb + 4); bias[0] = a.x; bias[1] = a.y; bias[2] = a.z; bias[3] = a.w; bias[4] = b.x; bias[5] = b.y; bias[6] = b.z; bias[7] = b.w; }
    for (int j0 = 0; j0 < 16; j0 += 4) {
        u32x4 v[4][4];
#pragma unroll
        for (int q = 0; q < 4; ++q) { const int t = pm * 256 + rsub + 16 * (j0 + q), pos = t & (SEQ - 1);
#pragma unroll
            for (int j = 0; j < 4; ++j) { v[q][j] = (u32x4){0u, 0u, 0u, 0u}; if (pos - 3 + j >= 0) v[q][j] = *(const u32x4*)(proj + (size_t)(t - 3 + j) * NPROJ + 512 + c8 * 8); } }
        asm volatile("" ::: "memory");
#pragma unroll
        for (int q = 0; q < 4; ++q) { const int t = pm * 256 + rsub + 16 * (j0 + q);
            float y[8];
#pragma unroll
            for (int e = 0; e < 8; ++e) y[e] = bias[e];
#pragma unroll
            for (int j = 0; j < 4; ++j) { const u32x4 vv = v[q][j];
                y[0] += w[j][0] * bflo(vv.x); y[1] += w[j][1] * bfhi(vv.x); y[2] += w[j][2] * bflo(vv.y); y[3] += w[j][3] * bfhi(vv.y);
                y[4] += w[j][4] * bflo(vv.z); y[5] += w[j][5] * bfhi(vv.z); y[6] += w[j][6] * bflo(vv.w); y[7] += w[j][7] * bfhi(vv.w); }
            u32x4 o; o.x = cvt_pk_bf16(siluf_(y[0]), siluf_(y[1])); o.y = cvt_pk_bf16(siluf_(y[2]), siluf_(y[3])); o.z = cvt_pk_bf16(siluf_(y[4]), siluf_(y[5])); o.w = cvt_pk_bf16(siluf_(y[6]), siluf_(y[7]));
            *(u32x4*)(xc + (size_t)t * DM + c8 * 8) = o; }
    }
}

template <bool PASSC>
__device__ __forceinline__ void s5_phase(const KP& p, int l, LAS unsigned char* lds) {
    const int tid = opaque_tid(); const int wid = tid >> 6, lane = tid & 63, fr = lane & 15, fq = lane >> 4;
    LAS float* buS = (LAS float*)(lds + wid * 12800);
    LAS unsigned char* sS = lds + wid * 12800 + 8448;
    const bf16_t* proj = (const bf16_t*)(p.ws + O_BIG); bf16_t* z = (bf16_t*)(p.ws + O_Z);
    f32x2* s5end = (f32x2*)(p.ws + O_S5END);
    for (int task = blockIdx.x * 8 + wid; task < 2048; task += gridDim.x * 8) {
        const int seq = task >> 5, c = task & 31, b = seq >> 5, g = seq & 31, n = lane, lg = l * 32 + g;
        const float dt = expf(p.in[10][lg]);
        float ar, ai;
        { const float lr = fminf(p.in[8][lg * 64 + n], -1e-4f), li = p.in[9][lg * 64 + n];
          const float mag = expf(lr * dt); float sn, cs; sincos_acc(li * dt, sn, cs); ar = mag * cs; ai = mag * sn; }
        bf16x8 bx[8];
#pragma unroll
        for (int q4 = 0; q4 < 4; ++q4) { const int n2 = q4 * 16 + fr;
            const float lr = fminf(p.in[8][lg * 64 + n2], -1e-4f), li = p.in[9][lg * 64 + n2];
            const float mag = expf(lr * dt); float sn, cs; sincos_acc(li * dt, sn, cs);
            const float a_r = mag * cs, a_i = mag * sn, den = lr * lr + li * li;
            float qr = ((a_r - 1.0f) * lr + a_i * li) / den, qi = (a_i * lr - (a_r - 1.0f) * li) / den;
            if (fq >= 2) { qr = 0.f; qi = 0.f; }
            const float* brp = p.in[11] + (size_t)(lg * 64 + n2) * 16 + (fq & 1) * 8; const float* bip = p.in[12] + (size_t)(lg * 64 + n2) * 16 + (fq & 1) * 8;
            const f32x4 br0 = *(const f32x4*)brp, br1 = *(const f32x4*)(brp + 4), bi0 = *(const f32x4*)bip, bi1 = *(const f32x4*)(bip + 4);
            const f32x4 re0 = qr * br0 - qi * bi0, re1 = qr * br1 - qi * bi1, im0 = qr * bi0 + qi * br0, im1 = qr * bi1 + qi * br1;
            u32x4 o; o.x = cvt_pk_bf16(re0.x, re0.y); o.y = cvt_pk_bf16(re0.z, re0.w); o.z = cvt_pk_bf16(re1.x, re1.y); o.w = cvt_pk_bf16(re1.z, re1.w);
            bx[q4] = __builtin_bit_cast(bf16x8, o);
            o.x = cvt_pk_bf16(im0.x, im0.y); o.y = cvt_pk_bf16(im0.z, im0.w); o.z = cvt_pk_bf16(im1.x, im1.y); o.w = cvt_pk_bf16(im1.z, im1.w);
            bx[4 + q4] = __builtin_bit_cast(bf16x8, o); }
        float sr = 0.f, si = 0.f;
        bf16x8 cm[4]; f32x4 d4 = (f32x4){0.f, 0.f, 0.f, 0.f};
        if (PASSC) {
            float xr = ar, xi = ai;
#pragma unroll
            for (int q = 0; q < 8; ++q) { const float t0 = xr * xr - xi * xi, t1 = 2.0f * xr * xi; xr = t0; xi = t1; }
            for (int c0 = 0; c0 < c; c0 += 16) {
                f32x2 ev[16];
#pragma unroll
                for (int j = 0; j < 16; ++j) { const int cc = (c0 + j < c) ? c0 + j : c - 1; ev[j] = s5end[(size_t)(seq * 32 + cc) * 64 + n]; }
#pragma unroll
                for (int j = 0; j < 16; ++j) { const bool on = c0 + j < c; const float t0 = sr * xr - si * xi + ev[j].x, t1 = sr * xi + si * xr + ev[j].y; sr = on ? t0 : sr; si = on ? t1 : si; }
            }
#pragma unroll
            for (int kb = 0; kb < 4; ++kb) { const float* src = (kb < 2 ? p.in[13] : p.in[14]) + (size_t)(lg * 16 + fr) * 64 + (kb & 1) * 32 + fq * 8;
                const f32x4 a = *(const f32x4*)src, bq = *(const f32x4*)(src + 4); const float sg = kb < 2 ? 1.0f : -1.0f;
                u32x4 o; o.x = cvt_pk_bf16(sg * a.x, sg * a.y); o.y = cvt_pk_bf16(sg * a.z, sg * a.w); o.z = cvt_pk_bf16(sg * bq.x, sg * bq.y); o.w = cvt_pk_bf16(sg * bq.z, sg * bq.w);
                cm[kb] = __builtin_bit_cast(bf16x8, o); }
            d4 = *(const f32x4*)(p.in[15] + (size_t)l * 512 + g * 16 + fq * 4);
        }
        const int tok0 = b * SEQ + c * 256;
        const bf16_t* urow0 = proj + (size_t)(tok0 + fr) * NPROJ + g * 16;
        u32x4 unext = *(const u32x4*)(urow0 + (fq & 1) * 8); u32x2 u4next = *(const u32x2*)(urow0 + fq * 4);
        for (int sub = 0; sub < 16; ++sub) {
            u32x4 uraw = unext; const u32x2 u4 = u4next;
            if (sub < 15) { const bf16_t* urow = urow0 + (size_t)(sub + 1) * 16 * NPROJ; unext = *(const u32x4*)(urow + (fq & 1) * 8); u4next = *(const u32x2*)(urow + fq * 4); }
            if (fq >= 2) uraw = (u32x4){0u, 0u, 0u, 0u};
            const bf16x8 yu = __builtin_bit_cast(bf16x8, uraw);
#pragma unroll
            for (int kb = 0; kb < 8; ++kb) { const f32x4 acc = __builtin_amdgcn_mfma_f32_16x16x32_bf16(bx[kb], yu, (f32x4){0.f, 0.f, 0.f, 0.f}, 0, 0, 0);
                *(LAS f32x4*)(buS + fr * 132 + kb * 16 + fq * 4) = acc; }
            WAVE_LDS_SYNC();
            float burv[16], buiv[16];
#pragma unroll
            for (int tt = 0; tt < 16; ++tt) { burv[tt] = buS[tt * 132 + n]; buiv[tt] = buS[tt * 132 + 64 + n]; }
#pragma unroll
            for (int tt = 0; tt < 16; ++tt) {
                const float bur = burv[tt], bui = buiv[tt];
                const float t0 = ar * sr - ai * si + bur, t1 = ar * si + ai * sr + bui; sr = t0; si = t1;
                if (PASSC) { const unsigned pk = cvt_pk_bf16(sr, si); *(LAS unsigned short*)(sS + tt * 272 + n * 2) = (unsigned short)(pk & 0xffffu); *(LAS unsigned short*)(sS + tt * 272 + 128 + n * 2) = (unsigned short)(pk >> 16); }
            }
            if (PASSC) {
                WAVE_LDS_SYNC();
                f32x4 acc = (f32x4){0.f, 0.f, 0.f, 0.f};
#pragma unroll
                for (int kb = 0; kb < 4; ++kb) { const bf16x8 yf = *(LAS bf16x8*)(sS + fr * 272 + (kb * 32 + fq * 8) * 2); acc = __builtin_amdgcn_mfma_f32_16x16x32_bf16(cm[kb], yf, acc, 0, 0, 0); }
                const f32x4 uv = (f32x4){bflo(u4.x), bfhi(u4.x), bflo(u4.y), bfhi(u4.y)};
                const f32x4 y = acc + d4 * uv;
                u32x2 o; o.x = cvt_pk_bf16(gelu_tanh(y.x), gelu_tanh(y.y)); o.y = cvt_pk_bf16(gelu_tanh(y.z), gelu_tanh(y.w));
                *(u32x2*)(z + (size_t)(tok0 + sub * 16 + fr) * 512 + g * 16 + fq * 4) = o;
            }
            WAVE_LDS_SYNC();
        }
        if (!PASSC) s5end[(size_t)(seq * 32 + c) * 64 + n] = (f32x2){sr, si};
    }
}

__device__ __forceinline__ float scan_sum128(float v, int tid, LAS float* tmp) {
    const int lane = tid & 63; float x = v;
#pragma unroll
    for (int o = 1; o < 64; o <<= 1) { const float y = __shfl_up(x, o); if (lane >= o) x += y; }
    if (tid == 63) tmp[0] = x;
    __syncthreads();
    if (tid >= 64 && tid < 128) x += tmp[0];
    return x;
}
__device__ __forceinline__ float scan_max128(float v, int tid, LAS float* tmp) {
    const int lane = tid & 63; float x = v;
#pragma unroll
    for (int o = 1; o < 64; o <<= 1) { const float y = __shfl_up(x, o); if (lane >= o) x = fmaxf(x, y); }
    if (tid == 63) tmp[1] = x;
    __syncthreads();
    if (tid >= 64 && tid < 128) x = fmaxf(x, tmp[1]);
    return x;
}
__device__ __forceinline__ bf16x8 tr_frag(LAS unsigned char* a0, int second_off) {
    const s16x4 lo = __builtin_amdgcn_ds_read_tr16_b64_v4i16((LAS s16x4*)a0);
    const s16x4 hi = __builtin_amdgcn_ds_read_tr16_b64_v4i16((LAS s16x4*)(a0 + second_off));
    return __builtin_shufflevector(lo, hi, 0, 1, 2, 3, 4, 5, 6, 7);
}
template <bool OWN> __device__ __forceinline__ void mlstm_s1_phase(const KP& p, LAS unsigned char* lds) {
    const int tid = opaque_tid(), wid = tid >> 6, lane = tid & 63, fr = lane & 15, fq = lane >> 4;
    const bf16_t* proj = (const bf16_t*)(p.ws + O_BIG); const bf16_t* kbuf = (const bf16_t*)(p.ws + O_K);
    const float* ifb = (const float*)(p.ws + O_IF); bf16_t* cst = (bf16_t*)(p.ws + O_CST);
    float* gout = (float*)(p.ws + O_G); float* mlout = (float*)(p.ws + O_MLOC); float* nloc = (float*)(p.ws + O_NLOC);
    LAS unsigned char* Ks = lds; LAS unsigned char* Vs = lds + 69632;
    LAS float* vlf = (LAS float*)(lds + VEC_OFF); LAS float* vi = vlf + 128; LAS float* vb = vlf + 256; LAS float* vdec = vlf + 384;
    const int own_pm = (int)blockIdx.x >> 2, own_bhc0 = (((own_pm >> 5) * 4 + ((int)blockIdx.x & 3)) * 64) + (own_pm & 31) * 2;
    for (int tk = OWN ? 0 : (int)blockIdx.x; tk < (OWN ? 4 : 1024); tk += OWN ? 1 : (int)gridDim.x) {
        const int task = OWN ? (((own_bhc0 + (tk >> 1)) << 1) | (tk & 1)) : tk;
        const int eh = task & 1, bhc = task >> 1, c = bhc & 63, bh = bhc >> 6, h = bh & 3, b = bh >> 2;
        const int tok0 = b * SEQ + c * 128;
        const bool newk = !OWN || eh == 0;
        u32x4 kv[8], vv[4];
        if (newk) {
#pragma unroll
            for (int it = 0; it < 8; ++it) { const int id = it * 512 + tid, s = id >> 5, ch = id & 31; kv[it] = *(const u32x4*)(kbuf + (unsigned)(tok0 + s) * DM + h * 256 + ch * 8); }
        }
#pragma unroll
        for (int it = 0; it < 4; ++it) { const int id = it * 512 + tid, s = id >> 4, ch = id & 15; vv[it] = *(const u32x4*)(proj + (unsigned)(tok0 + s) * NPROJ + 1536 + h * 256 + eh * 128 + ch * 8); }
        LAS float* tmp = vlf;
        float gg = 0.f, mloc = 0.f;
        if (newk) {
        float gi = 0.f, glf = 0.f;
        if (tid < 128) { gi = ifb[(size_t)(tok0 + tid) * 8 + h]; glf = logsigmoidf_(ifb[(size_t)(tok0 + tid) * 8 + 4 + h]); }
        const float bsum = scan_sum128(glf, tid, tmp);
        if (tid == 127) tmp[2] = bsum;
        __syncthreads();
        gg = tmp[2];
        float dec = -INFINITY;
        if (tid < 128) { dec = gg - bsum + gi; vdec[tid] = dec; }
        { float x = dec;
#pragma unroll
          for (int o = 1; o < 64; o <<= 1) x = fmaxf(x, __shfl_xor(x, o));
          if (lane == 0 && wid < 2) tmp[4 + wid] = x; }
        __syncthreads();
        mloc = fmaxf(tmp[4], tmp[5]);
        asm volatile("" ::: "memory");
#pragma unroll
        for (int it = 0; it < 8; ++it) { const int id = it * 512 + tid, s = id >> 5, ch = id & 31;
            const u32x4 v = kv[it]; const float w = __expf(vdec[s] - mloc);
            u32x4 o; o.x = cvt_pk_bf16(bflo(v.x) * w, bfhi(v.x) * w); o.y = cvt_pk_bf16(bflo(v.y) * w, bfhi(v.y) * w); o.z = cvt_pk_bf16(bflo(v.z) * w, bfhi(v.z) * w); o.w = cvt_pk_bf16(bflo(v.w) * w, bfhi(v.w) * w);
            *(LAS u32x4*)(Ks + s * 544 + ch * 16) = o; }
        }
#pragma unroll
        for (int it = 0; it < 4; ++it) { const int id = it * 512 + tid, s = id >> 4, ch = id & 15;
            *(LAS u32x4*)(Vs + s * 288 + ch * 16) = vv[it]; }
        __syncthreads();
        f32x4 acc[2][8];
#pragma unroll
        for (int a = 0; a < 2; ++a)
#pragma unroll
            for (int e = 0; e < 8; ++e) acc[a][e] = (f32x4){0.f, 0.f, 0.f, 0.f};
#pragma unroll
        for (int kb = 0; kb < 4; ++kb) {
            bf16x8 X[2];
#pragma unroll
            for (int db = 0; db < 2; ++db) X[db] = tr_frag(Ks + (kb * 32 + fq * 4 + (fr >> 2)) * 544 + (32 * wid + db * 16 + (fr & 3) * 4) * 2, 16 * 544);
#pragma unroll
            for (int eb = 0; eb < 8; ++eb) { const bf16x8 Y = tr_frag(Vs + (kb * 32 + fq * 4 + (fr >> 2)) * 288 + (eb * 16 + (fr & 3) * 4) * 2, 16 * 288);
#pragma unroll
                for (int db = 0; db < 2; ++db) acc[db][eb] = __builtin_amdgcn_mfma_f32_16x16x32_bf16(X[db], Y, acc[db][eb], 0, 0, 0); }
        }
#pragma unroll
        for (int db = 0; db < 2; ++db)
#pragma unroll
            for (int eb = 0; eb < 8; ++eb) { u32x2 o; o.x = cvt_pk_bf16(acc[db][eb][0], acc[db][eb][1]); o.y = cvt_pk_bf16(acc[db][eb][2], acc[db][eb][3]);
                *(u32x2*)(cst + (size_t)bhc * 65536 + (size_t)(eh * 128 + eb * 16 + fr) * 256 + 32 * wid + db * 16 + fq * 4) = o; }
        if (eh == 0) {
            if (tid < 256) { float sn = 0.f;
                for (int s0 = 0; s0 < 128; s0 += 16) { unsigned short tv[16];
#pragma unroll
                    for (int j = 0; j < 16; ++j) tv[j] = *(LAS unsigned short*)(Ks + (s0 + j) * 544 + tid * 2);
#pragma unroll
                    for (int j = 0; j < 16; ++j) sn += bflo((unsigned)tv[j]); }
                nloc[(size_t)bhc * 256 + tid] = sn; }
            if (tid == 0) { gout[bhc] = gg; mlout[bhc] = mloc; }
        }
        __syncthreads();
    }
}
__device__ __forceinline__ void mlstm_s2_phase(const KP& p) {
    const int tid = opaque_tid();
    bf16_t* cst = (bf16_t*)(p.ws + O_CST);
    const float* gin = (const float*)(p.ws + O_G); const float* mlin = (const float*)(p.ws + O_MLOC); float* mst = (float*)(p.ws + O_MST);
    const float* nloc = (const float*)(p.ws + O_NLOC); float* nst = (float*)(p.ws + O_NST);
    for (int slot = blockIdx.x; slot < 256; slot += gridDim.x) {
        const int bh = slot >> 5, part = slot & 31; const size_t e0 = (size_t)(part * 512 + tid) * 4;
        float m = 0.f, C0 = 0.f, C1 = 0.f, C2 = 0.f, C3 = 0.f, nv = 0.f;
        const bool do_n = (part == 0) && (tid < 256);
        for (int c8 = 0; c8 < 64; c8 += 8) {
            u32x2 loc[8]; float nl[8];
#pragma unroll
            for (int j = 0; j < 8; ++j) { loc[j] = *(const u32x2*)(cst + (size_t)(bh * 64 + c8 + j) * 65536 + e0); nl[j] = do_n ? nloc[(size_t)(bh * 64 + c8 + j) * 256 + tid] : 0.f; }
#pragma unroll
            for (int j = 0; j < 8; ++j) { const int idx = bh * 64 + c8 + j;
                const float g = gin[idx], ml = mlin[idx]; const float mnew = fmaxf(g + m, ml); const float wo = __expf(g + m - mnew), wl = __expf(ml - mnew);
                u32x2 o; o.x = cvt_pk_bf16(C0, C1); o.y = cvt_pk_bf16(C2, C3);
                *(u32x2*)(cst + (size_t)idx * 65536 + e0) = o;
                C0 = wo * C0 + wl * bflo(loc[j].x); C1 = wo * C1 + wl * bfhi(loc[j].x); C2 = wo * C2 + wl * bflo(loc[j].y); C3 = wo * C3 + wl * bfhi(loc[j].y);
                if (do_n) { nst[(size_t)idx * 256 + tid] = nv; nv = wo * nv + wl * nl[j]; if (tid == 0) mst[idx] = m; }
                m = mnew; }
        }
    }
}
__device__ __forceinline__ void mlstm_s3_phase(const KP& p, int l, LAS unsigned char* lds) {
    const int tid = opaque_tid(), wid = tid >> 6, lane = tid & 63, fr = lane & 15, fq = lane >> 4;
    const bf16_t* proj = (const bf16_t*)(p.ws + O_BIG); const bf16_t* qbuf = (const bf16_t*)(p.ws + O_Q); const bf16_t* kbuf = (const bf16_t*)(p.ws + O_K);
    const bf16_t* xc = (const bf16_t*)(p.ws + O_XC); const float* ifb = (const float*)(p.ws + O_IF); const bf16_t* cst = (const bf16_t*)(p.ws + O_CST);
    const float* mst = (const float*)(p.ws + O_MST); const float* nst = (const float*)(p.ws + O_NST); bf16_t* yml = (bf16_t*)(p.ws + O_XN);
    const float* normg = p.in[22] + (unsigned)l * 1024; const float* skipg = p.in[23] + (unsigned)l * 1024;
    LAS unsigned char* Vh = lds;
    LAS unsigned char* Qs = lds + 36864;
    LAS unsigned char* Kt = lds + 55296;
    LAS unsigned char* CTs = lds + 73728;
    LAS unsigned char* Ss = lds + 92160;
    LAS float* vlf = (LAS float*)(lds + VEC_OFF); LAS float* va = vlf + 128; LAS float* vb = vlf + 256; LAS float* vM = vlf + 384; LAS float* nvec = vlf + 512; LAS float* ngs = vlf + 768; LAS float* sks = vlf + 1024;
    for (int task = blockIdx.x; task < 512; task += gridDim.x) {
        const int bhc = task, c = bhc & 63, bh = bhc >> 6, h = bh & 3, b = bh >> 2;
        const int tok0 = b * SEQ + c * 128;
        u32x4 pq[2], pk[2], pc[2];
#define S3_LOAD(EH, DB) do { _Pragma("unroll") for (int it = 0; it < 2; ++it) { const int id = it * 512 + tid, row = id >> 3, ch = id & 7; \
                    pq[it] = *(const u32x4*)(qbuf + (unsigned)(tok0 + row) * DM + h * 256 + (DB) * 64 + ch * 8); \
                    if ((EH) == 0) pk[it] = *(const u32x4*)(kbuf + (unsigned)(tok0 + row) * DM + h * 256 + (DB) * 64 + ch * 8); \
                    pc[it] = *(const u32x4*)(cst + (unsigned)bhc * 65536 + (unsigned)((EH) * 128 + row) * 256 + (DB) * 64 + ch * 8); } } while (0)
        S3_LOAD(0, 0);
        const float m0 = mst[bhc];
        float gi = 0.f, glf = 0.f;
        if (tid < 128) { gi = ifb[(unsigned)(tok0 + tid) * 8 + h]; glf = logsigmoidf_(ifb[(unsigned)(tok0 + tid) * 8 + 4 + h]); }
        if (tid < 256) { nvec[tid] = nst[(unsigned)bhc * 256 + tid]; ngs[tid] = normg[h * 256 + tid]; sks[tid] = skipg[h * 256 + tid]; }
        const float bs = scan_sum128(glf, tid, vlf);
        const float av = (tid < 128) ? gi - bs : -INFINITY;
        const float mm = scan_max128(av, tid, vlf);
        if (tid < 128) { vb[tid] = bs; va[tid] = av; vM[tid] = fmaxf(m0, mm); }
        const int t = 16 * wid + fr;
        const unsigned tok = (unsigned)(tok0 + t);
        u32x2 hc0[8];
        float qn = 0.f, ss = 0.f, inv = 0.f, winter = 0.f;
#pragma unroll
        for (int eh = 0; eh < 2; ++eh) {
            f32x4 accS[8], accO[8];
#pragma unroll
            for (int i = 0; i < 8; ++i) { accS[i] = (f32x4){0.f, 0.f, 0.f, 0.f}; accO[i] = (f32x4){0.f, 0.f, 0.f, 0.f}; }
            for (int db4 = 0; db4 < 4; ++db4) {
                __syncthreads();
#pragma unroll
                for (int it = 0; it < 2; ++it) { const int id = it * 512 + tid, row = id >> 3, ch = id & 7;
                    *(LAS u32x4*)(Qs + row * 144 + ch * 16) = pq[it];
                    if (eh == 0) *(LAS u32x4*)(Kt + row * 144 + ch * 16) = pk[it];
                    *(LAS u32x4*)(CTs + row * 144 + ch * 16) = pc[it]; }
                if (db4 < 3) S3_LOAD(eh, db4 + 1);
                __syncthreads();
#pragma unroll
                for (int kk = 0; kk < 2; ++kk) {
                    const bf16x8 Qf = *(LAS bf16x8*)(Qs + (16 * wid + fr) * 144 + (kk * 32 + fq * 8) * 2);
                    if (eh == 0) {
                        const u32x4 qu = __builtin_bit_cast(u32x4, Qf); const LAS float* nvp = nvec + db4 * 64 + kk * 32 + fq * 8; const f32x4 n0 = *(LAS f32x4*)nvp, n1 = *(LAS f32x4*)(nvp + 4);
                        qn += bflo(qu.x) * n0.x + bfhi(qu.x) * n0.y + bflo(qu.y) * n0.z + bfhi(qu.y) * n0.w + bflo(qu.z) * n1.x + bfhi(qu.z) * n1.y + bflo(qu.w) * n1.z + bfhi(qu.w) * n1.w;
#pragma unroll
                        for (int sb = 0; sb < 8; ++sb) { if (sb <= wid) { const bf16x8 Kf = *(LAS bf16x8*)(Kt + (sb * 16 + fr) * 144 + (kk * 32 + fq * 8) * 2); accS[sb] = __builtin_amdgcn_mfma_f32_16x16x32_bf16(Kf, Qf, accS[sb], 0, 0, 0); } if ((sb & 3) == 3) { asm volatile("" ::: "memory"); __builtin_amdgcn_sched_barrier(0); } }
                    }
#pragma unroll
                    for (int eb = 0; eb < 8; ++eb) { const bf16x8 Cf = *(LAS bf16x8*)(CTs + (eb * 16 + fr) * 144 + (kk * 32 + fq * 8) * 2); accO[eb] = __builtin_amdgcn_mfma_f32_16x16x32_bf16(Cf, Qf, accO[eb], 0, 0, 0); if ((eb & 3) == 3) { asm volatile("" ::: "memory"); __builtin_amdgcn_sched_barrier(0); } }
                }
            }
            if (eh == 0) S3_LOAD(1, 0);
            u32x4 vt[4];
#pragma unroll
            for (int it = 0; it < 4; ++it) { const int id = it * 512 + tid, s = id >> 4, ch = id & 15; vt[it] = *(const u32x4*)(proj + (unsigned)(tok0 + s) * NPROJ + 1536 + h * 256 + eh * 128 + ch * 8); }
            asm volatile("" ::: "memory");
#pragma unroll
            for (int it = 0; it < 4; ++it) { const int id = it * 512 + tid, s = id >> 4, ch = id & 15; *(LAS u32x4*)(Vh + s * 288 + ch * 16) = vt[it]; }
            if (eh == 0) {
                const float Mt = vM[t]; winter = __expf(m0 - Mt);
                float rowsum = 0.f;
#pragma unroll
                for (int sb = 0; sb < 8; ++sb) if (sb <= (wid | 1)) {
                    const f32x4 a4 = *(LAS f32x4*)(va + sb * 16 + fq * 4);
                    float sv[4];
#pragma unroll
                    for (int j = 0; j < 4; ++j) { const int s = sb * 16 + fq * 4 + j; const float v0 = accS[sb][j] * __expf(fminf(a4[j] - Mt, 0.f)); const float v = (s <= t) ? v0 : 0.f; sv[j] = v; rowsum += v; }
                    u32x2 o; o.x = cvt_pk_bf16(sv[0], sv[1]); o.y = cvt_pk_bf16(sv[2], sv[3]);
                    *(LAS u32x2*)(Ss + t * 272 + (sb * 16 + fq * 4) * 2) = o;
                }
                rowsum += __shfl_xor(rowsum, 16); rowsum += __shfl_xor(rowsum, 32);
                qn += __shfl_xor(qn, 16); qn += __shfl_xor(qn, 32);
                const float den = winter * qn + rowsum, mt = vb[t] + Mt;
                inv = 1.0f / fmaxf(fabsf(den), __expf(-mt));
            }
#pragma unroll
            for (int eb = 0; eb < 8; ++eb) accO[eb] = accO[eb] * winter;
            __syncthreads();
            for (int kb = 0; kb <= (wid >> 1); ++kb) {
                const s16x4 s0 = *(LAS s16x4*)(Ss + t * 272 + (kb * 32 + fq * 4) * 2), s1 = *(LAS s16x4*)(Ss + t * 272 + (kb * 32 + 16 + fq * 4) * 2);
                const bf16x8 Sf = __builtin_shufflevector(s0, s1, 0, 1, 2, 3, 4, 5, 6, 7);
#pragma unroll
                for (int eb = 0; eb < 8; ++eb) { const bf16x8 Vf = tr_frag(Vh + (kb * 32 + fq * 4 + (fr >> 2)) * 288 + (eb * 16 + (fr & 3) * 4) * 2, 16 * 288);
                    accO[eb] = __builtin_amdgcn_mfma_f32_16x16x32_bf16(Vf, Sf, accO[eb], 0, 0, 0); if ((eb & 3) == 3) { asm volatile("" ::: "memory"); __builtin_amdgcn_sched_barrier(0); } }
            }
            u32x2 ovv[8];
#pragma unroll
            for (int eb = 0; eb < 8; ++eb) ovv[eb] = *(const u32x2*)(proj + tok * NPROJ + 2560 + h * 256 + eh * 128 + eb * 16 + fq * 4);
            asm volatile("" ::: "memory");
#pragma unroll
            for (int eb = 0; eb < 8; ++eb) { const u32x2 ov = ovv[eb];
                f32x4 hc; hc.x = sigmoidf_(bflo(ov.x)) * accO[eb].x * inv; hc.y = sigmoidf_(bfhi(ov.x)) * accO[eb].y * inv; hc.z = sigmoidf_(bflo(ov.y)) * accO[eb].z * inv; hc.w = sigmoidf_(bfhi(ov.y)) * accO[eb].w * inv;
                ss += (hc.x * hc.x + hc.y * hc.y) + (hc.z * hc.z + hc.w * hc.w);
                if (eh == 0) { hc0[eb].x = cvt_pk_bf16(hc.x, hc.y); hc0[eb].y = cvt_pk_bf16(hc.z, hc.w); } else accO[eb] = hc;
                if ((eb & 3) == 3) { asm volatile("" ::: "memory"); __builtin_amdgcn_sched_barrier(0); } }
            if (eh == 1) {
                ss += __shfl_xor(ss, 16); ss += __shfl_xor(ss, 32);
                const float rs = rsqrtf(ss * (1.0f / 256.0f) + EPS);
#pragma unroll
                for (int e4 = 0; e4 < 4; ++e4) {
                    u32x2 xvv[4];
#pragma unroll
                    for (int q = 0; q < 4; ++q) { const int col = h * 256 + (e4 * 4 + q) * 16 + fq * 4; xvv[q] = *(const u32x2*)(xc + tok * DM + col); }
                    asm volatile("" ::: "memory");
#pragma unroll
                    for (int q = 0; q < 4; ++q) { const int e2 = e4 * 4 + q, col = h * 256 + e2 * 16 + fq * 4;
                        const f32x4 ng = *(LAS f32x4*)(ngs + e2 * 16 + fq * 4), sk = *(LAS f32x4*)(sks + e2 * 16 + fq * 4); const u32x2 xv = xvv[q];
                        f32x4 hc; if (e2 < 8) { const u32x2 hp = hc0[e2 & 7]; hc = (f32x4){bflo(hp.x), bfhi(hp.x), bflo(hp.y), bfhi(hp.y)}; } else hc = accO[e2 & 7];
                        u32x2 o; o.x = cvt_pk_bf16(hc.x * rs * ng.x + sk.x * bflo(xv.x), hc.y * rs * ng.y + sk.y * bfhi(xv.x)); o.y = cvt_pk_bf16(hc.z * rs * ng.z + sk.z * bflo(xv.y), hc.w * rs * ng.w + sk.w * bfhi(xv.y));
                        *(u32x2*)(yml + tok * DM + col) = o; }
                    asm volatile("" ::: "memory"); __builtin_amdgcn_sched_barrier(0);
                }
            }
        }
        __syncthreads();
    }
}

#define XB_TMO      128
#define XB_XCNT(j)  (256  + 64 * (j))
#define XB_XSUB(j)  (1280 + 64 * (j))
#define XB_XGEN(j)  (2304 + 64 * (j))
#define XB_TOP      3328
#define XB_TOPGEN   3392
#define XCD_BAR_WORDS 3456
#define XB_SPIN_CAP (1u << 22)
__device__ __forceinline__ unsigned xb_ld(unsigned* p)              { return __hip_atomic_load(p, __ATOMIC_RELAXED, __HIP_MEMORY_SCOPE_AGENT); }
__device__ __forceinline__ unsigned xb_add(unsigned* p, unsigned v) { return __hip_atomic_fetch_add(p, v, __ATOMIC_RELAXED, __HIP_MEMORY_SCOPE_AGENT); }
__device__ __forceinline__ unsigned xb_xcc_id() { return (unsigned)__builtin_amdgcn_s_getreg((3 << 11) | 20) & 0xFu; }
#define XB_SPIN(cond, bar) do { unsigned _sp = 0; while (cond) { __builtin_amdgcn_s_sleep(1); \
    if ((++_sp & 255u) == 0u) { if (xb_ld(&(bar)[XB_TMO])) break; if (_sp > XB_SPIN_CAP) { atomicAdd(&(bar)[XB_TMO], 1u); break; } } } } while (0)
struct XcdBarrier { unsigned* bar; unsigned x; volatile LAS unsigned* st; };
__device__ __forceinline__ XcdBarrier xcd_barrier_post(unsigned* bar, volatile LAS unsigned* st) {
    XcdBarrier b; b.bar = bar; b.x = xb_xcc_id(); b.st = st;
    if (threadIdx.x == 0) (void)xb_add(&bar[XB_XCNT(b.x)], 1u);
    return b;
}
__device__ __forceinline__ void xcd_barrier_complete(unsigned* bar, unsigned x, unsigned& nloc, unsigned& nx) {
    const unsigned G = gridDim.x * gridDim.y * gridDim.z;
    unsigned sum, cnt, mine, sp = 0u;
    for (;;) {
        sum = 0u; cnt = 0u; mine = 0u;
#pragma unroll
        for (unsigned j = 0; j < 16; ++j) { const unsigned c = xb_ld(&bar[XB_XCNT(j)]); sum += c; cnt += (c > 0u) ? 1u : 0u; mine = (j == x) ? c : mine; }
        if (sum == G) break;
        __builtin_amdgcn_s_sleep(1);
        if ((++sp & 255u) == 0u) { if (xb_ld(&bar[XB_TMO])) break; if (sp > XB_SPIN_CAP) { atomicAdd(&bar[XB_TMO], 1u); break; } }
    }
    nloc = mine > 0u ? mine : 1u; nx = cnt > 0u ? cnt : 1u;
}
__device__ __forceinline__ void xcd_barrier(const XcdBarrier& b) {
    asm volatile("s_waitcnt vmcnt(0) lgkmcnt(0)" ::: "memory");
    __syncthreads();
    if (threadIdx.x == 0) {
        unsigned* bar = b.bar;
        __builtin_amdgcn_s_waitcnt(0);
        unsigned nloc = b.st[0], nx = b.st[1];
        if (nloc == 0u) { xcd_barrier_complete(bar, b.x, nloc, nx); b.st[0] = nloc; b.st[1] = nx; }
        const unsigned old = xb_add(&bar[XB_XSUB(b.x)], 1u);
        const unsigned gen = old / nloc;
        if (old + 1u == (gen + 1u) * nloc) {
            __builtin_amdgcn_fence(__ATOMIC_RELEASE, "agent");
            asm volatile("s_waitcnt vmcnt(0)" ::: "memory");
            const unsigned og = xb_add(&bar[XB_TOP], 1u);
            const unsigned tg = og / nx;
            if (og + 1u == (tg + 1u) * nx) xb_add(&bar[XB_TOPGEN], 1u);
            else XB_SPIN(xb_ld(&bar[XB_TOPGEN]) == tg, bar);
            __builtin_amdgcn_fence(__ATOMIC_ACQUIRE, "agent");
            xb_add(&bar[XB_XGEN(b.x)], 1u);
            asm volatile("s_waitcnt vmcnt(0)" ::: "memory");
        } else {
            XB_SPIN(xb_ld(&bar[XB_XGEN(b.x)]) == gen, bar);
            __builtin_amdgcn_fence(__ATOMIC_ACQUIRE, "agent");
            asm volatile("s_waitcnt vmcnt(0)" ::: "memory");
        }
    }
    __syncthreads();
}

__global__ void __launch_bounds__(512, 2) fwd_megakernel(KP p) {
    extern __shared__ __attribute__((aligned(16))) unsigned char shm[];
    LAS unsigned char* lds = (LAS unsigned char*)shm;
    cg::grid_group grid = cg::this_grid();
    { volatile LAS unsigned* st0 = (volatile LAS unsigned*)(lds + 143360); if (threadIdx.x < 4) st0[threadIdx.x] = 0u; }
    __syncthreads();
    const XcdBarrier xb = xcd_barrier_post((unsigned*)(p.ws + O_BAR), (volatile LAS unsigned*)(lds + 143360));
    if (p.out == nullptr) { asm volatile("s_waitcnt vmcnt(0) lgkmcnt(0)" ::: "memory"); grid.sync(); }
#define GSYNC() xcd_barrier(xb)
    unsigned char* ws = p.ws;
    bf16_t* BIG = (bf16_t*)(ws + O_BIG); bf16_t* XN = (bf16_t*)(ws + O_XN); bf16_t* XC = (bf16_t*)(ws + O_XC);
    bf16_t* Q = (bf16_t*)(ws + O_Q); bf16_t* KB = (bf16_t*)(ws + O_K); bf16_t* Z = (bf16_t*)(ws + O_Z); bf16_t* YS5 = (bf16_t*)(ws + O_YS5);
    float* MIXACC = (float*)(ws + O_CST); float* IFB = (float*)(ws + O_IF);
    float* xo = p.out;
    for (int l = 0; l < 4; ++l) {
        const float* xcur = (l == 0) ? p.in[0] : xo;
        for (int rep = 0; rep < REP_A; ++rep) { if (l == 0) convert_phase(p, 0, lds, 1, 0);
        rmsnorm_phase<false>(xcur, p.in[1] + l * 1024, XN, nullptr, nullptr, nullptr, lds); }
        GSYNC(); if (STOP_PHASE == 1) break;
        { pg8::Gemm g{XN, (const bf16_t*)(ws + W_GU1), MTOK, 2 * FF, 1024, 1024, 1024, 0}; pg8::EpiGated<0> e{BIG, FF}; pg8::gemm_phase(lds, g, e); }
        convert_phase(p, l, lds, l == 0 ? 2 : 4, 1);
        GSYNC(); if (STOP_PHASE == 2) break;
        { pg8::Gemm g{BIG, (const bf16_t*)(ws + W_D1), MTOK, 1024, FF, FF, FF, 0}; pg8::EpiResid e{xcur, xo, 0.5f}; pg8::gemm_phase(lds, g, e); }
        GSYNC(); if (STOP_PHASE == 3) break;
        for (int rep = 0; rep < REP_A; ++rep) { rmsnorm_phase<true>(xo, p.in[5] + l * 1024, XN, p.in[6] + (size_t)l * 1024 * INC, p.in[7] + l * 8, IFB, lds); __syncthreads(); }
        GSYNC(); if (STOP_PHASE == 4) break;
        { pg8::Gemm g{XN, (const bf16_t*)(ws + W_IN), MTOK, NPROJ, 1024, 1024, 1024, 0}; pg8::EpiBf16 e{BIG, BIG, NPROJ, 1000, 1.0f}; pg8::gemm_phase(lds, g, e); }
        if (l == 0) convert_phase(p, 0, lds, 4, 1);
        if (l < 3) convert_phase(p, l + 1, lds, 1, 1);
        GSYNC(); if (STOP_PHASE == 5) break;
        if (gridDim.x == 256) {
            s5_phase<false>(p, l, lds);
            conv_slice(p, l, (int)blockIdx.x >> 2, (int)blockIdx.x & 3);
            asm volatile("s_waitcnt vmcnt(0) lgkmcnt(0)" ::: "memory"); __syncthreads();
            { pg8::Gemm g{XC, (const bf16_t*)(ws + W_QK), MTOK, 2048, 256, 1024, 256, 256, nullptr, nullptr, 0, 1}; pg8::EpiBf16 e{Q, KB, 1024, 4, 0.0625f}; pg8::gemm_phase(lds, g, e); }
            asm volatile("s_waitcnt vmcnt(0) lgkmcnt(0)" ::: "memory"); __syncthreads();
            mlstm_s1_phase<true>(p, lds);
            GSYNC();
            s5_phase<true>(p, l, lds);
            mlstm_s2_phase(p);
            GSYNC();
            __syncthreads();
            { pg8::Gemm g{Z, (const bf16_t*)(ws + W_GLU), MTOK, 1024, 512, 512, 512, 0}; pg8::EpiGated<1> e{YS5, 1024}; pg8::gemm_phase(lds, g, e); }
            mlstm_s3_phase(p, l, lds);
            GSYNC();
        } else {
            conv_phase(p, l);
            s5_phase<false>(p, l, lds);
            GSYNC();
            { pg8::Gemm g{XC, (const bf16_t*)(ws + W_QK), MTOK, 2048, 256, 1024, 256, 256}; pg8::EpiBf16 e{Q, KB, 1024, 4, 0.0625f}; pg8::gemm_phase(lds, g, e); }
            GSYNC();
            mlstm_s1_phase<false>(p, lds);
            s5_phase<true>(p, l, lds);
            GSYNC();
            mlstm_s2_phase(p);
            { pg8::Gemm g{Z, (const bf16_t*)(ws + W_GLU), MTOK, 1024, 512, 512, 512, 0}; pg8::EpiGated<1> e{YS5, 1024}; pg8::gemm_phase(lds, g, e); }
            GSYNC();
            mlstm_s3_phase(p, l, lds);
            GSYNC();
        }
        { pg8::Gemm g{YS5, (const bf16_t*)(ws + W_BS5), MTOK, 1024, 512, 1024, 1024, 0, XN, (const bf16_t*)(ws + W_BML), 1024}; pg8::EpiMergeDual e{BIG + 3584, BIG + 4608, Q}; pg8::gemm_phase(lds, g, e); }
        GSYNC(); if (STOP_PHASE == 11) break;
        { pg8::Gemm g{Q, (const bf16_t*)(ws + W_OUT), MTOK, 1024, 1024, 1024, 1024, 0}; pg8::EpiResid e{xo, xo, 1.0f}; pg8::gemm_phase(lds, g, e); }
        GSYNC(); if (STOP_PHASE == 12) break;
        for (int rep = 0; rep < REP_A; ++rep) rmsnorm_phase<false>(xo, p.in[27] + l * 1024, XN, nullptr, nullptr, nullptr, lds);
        GSYNC(); if (STOP_PHASE == 13) break;
        { pg8::Gemm g{XN, (const bf16_t*)(ws + W_GU2), MTOK, 2 * FF, 1024, 1024, 1024, 0}; pg8::EpiGated<0> e{BIG, FF}; pg8::gemm_phase(lds, g, e); }
        if (l < 3) convert_phase(p, l + 1, lds, 2, 1);
        GSYNC(); if (STOP_PHASE == 14) break;
        { pg8::Gemm g{BIG, (const bf16_t*)(ws + W_D2), MTOK, 1024, FF, FF, FF, 0}; pg8::EpiResid e{xo, xo, 0.5f}; pg8::gemm_phase(lds, g, e); }
        GSYNC(); if (STOP_PHASE == 15) break;
    }
#ifdef DUMP_OFF
    { const int gt = blockIdx.x * 512 + opaque_tid(); const int nthr = gridDim.x * 512;
      for (int i = gt; i < MTOK * DM; i += nthr) { float v;
          if (DUMP_KIND == 5) { v = bflo((unsigned)((const bf16_t*)(ws + O_BIG))[(size_t)(i >> 10) * NPROJ + DUMP_COL + (i & 1023)]); }
          else if (DUMP_KIND == 4) { v = 0.f; if (i < 512) v = ((const float*)(ws + O_G))[i]; else if (i < 1024) v = ((const float*)(ws + O_MLOC))[i - 512]; else if (i < 1024 + 131072) v = ((const float*)(ws + O_NLOC))[i - 1024]; }
          else if (DUMP_KIND == 2 && i < 131072) v = ((const float*)(ws + O_IF))[i];
          else if (DUMP_KIND == 3) v = bflo((unsigned)((const bf16_t*)(ws + (i < 8388608 ? O_Q : O_K)))[i & 8388607]);
          else if (DUMP_KIND == 1) v = ((const float*)(ws + DUMP_OFF))[i]; else v = bflo((unsigned)((const bf16_t*)(ws + DUMP_OFF))[i]);
          xo[i] = (fabsf(v) < 1e30f) ? v : 12345.0f; } }
#else
    final_norm_phase(xo, p.in[31]);
#endif
}

extern "C" void kernel_launch(void* const* d_in, const int* in_sizes, int n_in, void* d_out, int out_size, void* d_ws, size_t ws_size, hipStream_t stream) {
    static int grid_blocks = 0;
    if (grid_blocks == 0) {
        if (n_in != 32 || ws_size < WS_END) { fprintf(stderr, "kernel_launch: unexpected n_in %d or ws_size %zu (< %zu)\n", n_in, ws_size, (size_t)WS_END); grid_blocks = -1; return; }
        int dev = 0, cus = 0, per_cu = 0;
        hipGetDevice(&dev);
        hipDeviceGetAttribute(&cus, hipDeviceAttributeMultiprocessorCount, dev);
        if (hipFuncSetAttribute((const void*)fwd_megakernel, hipFuncAttributeMaxDynamicSharedMemorySize, LDS_BYTES) != hipSuccess) { fprintf(stderr, "kernel_launch: hipFuncSetAttribute failed\n"); grid_blocks = -1; return; }
        hipOccupancyMaxActiveBlocksPerMultiprocessor(&per_cu, (const void*)fwd_megakernel, 512, LDS_BYTES);
        if (per_cu < 1) { fprintf(stderr, "kernel_launch: occupancy query says %d blocks/CU\n", per_cu); per_cu = 1; }
        (void)hipGetLastError();
        grid_blocks = cus;
    }
    if (grid_blocks < 0) return;
    if (hipMemsetAsync((unsigned char*)d_ws + O_BAR, 0, 16384, stream) != hipSuccess) { fprintf(stderr, "kernel_launch: memset of barrier words failed\n"); return; }
    KP p{};
    for (int i = 0; i < 32; ++i) p.in[i] = (const float*)d_in[i];
    p.out = (float*)d_out; p.ws = (unsigned char*)d_ws;
    void* args[] = {&p};
    hipError_t e = hipLaunchCooperativeKernel((const void*)fwd_megakernel, dim3(grid_blocks), dim3(512), args, LDS_BYTES, stream);
    if (e != hipSuccess) fprintf(stderr, "cooperative launch failed: %s (grid %d)\n", hipGetErrorString(e), grid_blocks);
}
```
